# Optimizing an MI355X kernel written in HIP

```python
import math
import jax, jax.numpy as jnp
from jax import lax
import numpy as np

D_MODEL = 1024
BATCH = 2
SEQ = 16384
DEPTH = 2

CHUNK = 64
N_MIXERS = 4
HEAD_DIM = 64
GROUP_WIDTH = D_MODEL // N_MIXERS
HEADS_PER_GROUP = GROUP_WIDTH // HEAD_DIM
LEFT_CHUNKS = 8
BAND = (LEFT_CHUNKS + 1) * CHUNK
REL_CLIP = 128
CONV_WIDTH = 4
DIFF_QK_DIM = HEAD_DIM // 2
Q_BLOCK = 128
D_FF = 2816
EPS = 1e-6
NEG = -1e30

IN_PROJ_SIZES = [GROUP_WIDTH, GROUP_WIDTH, GROUP_WIDTH,
                 2 * GROUP_WIDTH, GROUP_WIDTH, GROUP_WIDTH,
                 HEADS_PER_GROUP, HEADS_PER_GROUP,
                 GROUP_WIDTH, GROUP_WIDTH, GROUP_WIDTH,
                 GROUP_WIDTH, GROUP_WIDTH, GROUP_WIDTH]
IN_COLS = sum(IN_PROJ_SIZES)
IN_PROJ_OFFSETS = [int(o) for o in np.cumsum(IN_PROJ_SIZES)[:-1]]

kernel_name = "hybrid_chunk_causal_encoder"


def rms_norm(x, g):
    xf = x.astype(jnp.float32)
    y = xf * lax.rsqrt(jnp.mean(xf * xf, axis=-1, keepdims=True) + EPS)
    return (y * g.astype(jnp.float32)).astype(x.dtype)


def swiglu(x, wg, wu, wd):
    return (jax.nn.silu(x @ wg) * (x @ wu)) @ wd


def split_heads(t, n_heads):
    b, s, w = t.shape
    return t.reshape(b, s, n_heads, w // n_heads).transpose(0, 2, 1, 3)


def merge_heads(t):
    b, h, s, d = t.shape
    return t.transpose(0, 2, 1, 3).reshape(b, s, h * d)


def causal_depthwise_conv(x, w, bias):
    width = w.shape[0]
    s = x.shape[1]
    xp = jnp.pad(x, ((0, 0), (width - 1, 0), (0, 0)))
    acc = bias
    for j in range(width):
        acc = acc + xp[:, j:j + s] * w[j]
    return acc


def chunk_relpos_attention(q, k, v, gq, gk, rel_bias):
    b, h, s, d = q.shape
    nc = s // CHUNK
    pad = LEFT_CHUNKS * CHUNK
    q = rms_norm(q, gq)
    k = rms_norm(k, gk)
    kp = jnp.pad(k, ((0, 0), (0, 0), (pad, 0), (0, 0))).reshape(b, h, nc + LEFT_CHUNKS, CHUNK, d)
    vp = jnp.pad(v, ((0, 0), (0, 0), (pad, 0), (0, 0))).reshape(b, h, nc + LEFT_CHUNKS, CHUNK, d)
    kb = jnp.concatenate([kp[:, :, i:i + nc] for i in range(LEFT_CHUNKS + 1)], axis=3)
    vb = jnp.concatenate([vp[:, :, i:i + nc] for i in range(LEFT_CHUNKS + 1)], axis=3)
    qc = q.reshape(b, h, nc, CHUNK, d)
    scores = jnp.einsum("bhcid,bhcjd->bhcij", qc, kb).astype(jnp.float32) * (d ** -0.5)
    rel = pad + jnp.arange(CHUNK)[:, None] - jnp.arange(BAND)[None, :]
    idx = jnp.clip(rel, -REL_CLIP, REL_CLIP) + REL_CLIP
    bias = rel_bias[:, idx].astype(jnp.float32)
    key_pos = jnp.arange(nc)[:, None] * CHUNK - pad + jnp.arange(BAND)[None, :]
    valid = key_pos >= 0
    scores = jnp.where(valid[None, None, :, None, :], scores + bias[None, :, None], NEG)
    probs = jax.nn.softmax(scores, axis=-1).astype(v.dtype)
    out = jnp.einsum("bhcij,bhcjd->bhcid", probs, vb)
    return out.reshape(b, h, s, d)


def mlstm_chunkwise(q, k, v, i_pre, f_pre):
    b, h, s, d = q.shape
    nc = s // CHUNK
    f32 = jnp.float32
    q = q.astype(f32)
    k = k.astype(f32) * (d ** -0.5)
    v = v.astype(f32)
    i_pre = i_pre.astype(f32)
    log_f = jax.nn.log_sigmoid(f_pre.astype(f32))

    def chunks(t):
        return jnp.moveaxis(t.reshape(b, h, nc, CHUNK, *t.shape[3:]), 2, 0)

    causal = jnp.tril(jnp.ones((CHUNK, CHUNK), dtype=bool))

    def step(carry, xs):
        c_mat, n_vec, m = carry
        qc, kc, vc, ic, lfc = xs
        bcum = jnp.cumsum(lfc, axis=-1)
        dmat = jnp.where(causal, bcum[..., :, None] - bcum[..., None, :] + ic[..., None, :], -jnp.inf)
        inter = bcum + m[..., None]
        m_t = jnp.maximum(inter, jnp.max(dmat, axis=-1))
        w_intra = jnp.exp(dmat - m_t[..., None])
        s_inter = jnp.exp(inter - m_t)
        qk = jnp.einsum("bhtd,bhsd->bhts", qc, kc) * w_intra
        num = s_inter[..., None] * jnp.einsum("bhtd,bhde->bhte", qc, c_mat) + jnp.einsum("bhts,bhse->bhte", qk, vc)
        den = s_inter * jnp.einsum("bhtd,bhd->bht", qc, n_vec) + jnp.sum(qk, axis=-1)
        h_out = num / jnp.maximum(jnp.abs(den), jnp.exp(-m_t))[..., None]
        b_tot = bcum[..., -1]
        g = b_tot[..., None] - bcum + ic
        m_new = jnp.maximum(b_tot + m, jnp.max(g, axis=-1))
        a = jnp.exp(b_tot + m - m_new)
        wg = jnp.exp(g - m_new[..., None])
        c_new = a[..., None, None] * c_mat + jnp.einsum("bhs,bhsd,bhse->bhde", wg, kc, vc)
        n_new = a[..., None] * n_vec + jnp.einsum("bhs,bhsd->bhd", wg, kc)
        return (c_new, n_new, m_new), h_out

    init = (jnp.zeros((b, h, d, d), f32), jnp.zeros((b, h, d), f32), jnp.zeros((b, h), f32))
    _, hs = lax.scan(step, init, (chunks(q), chunks(k), chunks(v), chunks(i_pre), chunks(log_f)))
    return jnp.moveaxis(hs, 0, 2).reshape(b, h, s, d)


def diff_attention(q, k, v, lam):
    b, h, _, s, dq = q.shape
    nb = s // Q_BLOCK
    qb = jnp.moveaxis(q.reshape(b, h, 2, nb, Q_BLOCK, dq), 3, 0)
    k_chunk = jnp.arange(s) // CHUNK

    def block(args):
        qblk, bi = args
        sc = jnp.einsum("bhmqd,bhmkd->bhmqk", qblk, k).astype(jnp.float32) * (dq ** -0.5)
        q_chunk = (bi * Q_BLOCK + jnp.arange(Q_BLOCK)) // CHUNK
        mask = k_chunk[None, :] <= q_chunk[:, None]
        p = jax.nn.softmax(jnp.where(mask, sc, NEG), axis=-1)
        w = p[:, :, 0] - lam * p[:, :, 1]
        return jnp.einsum("bhqk,bhke->bhqe", w.astype(v.dtype), v)

    out = lax.map(block, (qb, jnp.arange(nb)))
    return jnp.moveaxis(out, 0, 2).reshape(b, h, s, v.shape[-1])


def stick_breaking_attention(q, k, v):
    b, h, s, d = q.shape
    nb = s // Q_BLOCK
    qb = jnp.moveaxis(q.reshape(b, h, nb, Q_BLOCK, d), 2, 0)
    k_pos = jnp.arange(s)

    def block(args):
        qblk, bi = args
        z = jnp.einsum("bhqd,bhkd->bhqk", qblk, k).astype(jnp.float32) * (d ** -0.5)
        q_pos = bi * Q_BLOCK + jnp.arange(Q_BLOCK)
        before = k_pos[None, :] < q_pos[:, None]
        log_keep = jnp.where(before, jax.nn.log_sigmoid(-z), 0.0)
        between = lax.cumsum(log_keep, axis=3, reverse=True) - log_keep
        a = jnp.where(before, jnp.exp(jax.nn.log_sigmoid(z) + between), 0.0)
        return jnp.einsum("bhqk,bhke->bhqe", a.astype(v.dtype), v)

    out = lax.map(block, (qb, jnp.arange(nb)))
    return jnp.moveaxis(out, 0, 2).reshape(b, h, s, d)


def hybrid_mix(h, w_in, a_q_norm, a_k_norm, a_rel_bias, b_conv_w, b_conv_b, b_gate_bias,
               b_out_norm, c_q_norm, c_k_norm, c_lambda, c_out_norm, lam_init):
    nh = HEADS_PER_GROUP
    p = h @ w_in
    (aq, ak, av, bqk, bv, bo, bi, bf, cq, ck, cv, dq, dk, dv) = jnp.split(p, IN_PROJ_OFFSETS, axis=-1)
    b, s, _ = h.shape

    ya = merge_heads(chunk_relpos_attention(split_heads(aq, nh), split_heads(ak, nh), split_heads(av, nh),
                                            a_q_norm, a_k_norm, a_rel_bias))

    bqk = jax.nn.silu(causal_depthwise_conv(bqk, b_conv_w, b_conv_b))
    bq, bk = jnp.split(bqk, 2, axis=-1)
    i_pre = (bi + b_gate_bias[0]).transpose(0, 2, 1)
    f_pre = (bf + b_gate_bias[1]).transpose(0, 2, 1)
    hb = mlstm_chunkwise(split_heads(bq, nh), split_heads(bk, nh), split_heads(bv, nh), i_pre, f_pre)
    hb = rms_norm(hb, b_out_norm[:, None, :])
    yb = merge_heads(hb).astype(h.dtype) * jax.nn.sigmoid(bo)

    cq = cq.reshape(b, s, nh, 2, DIFF_QK_DIM).transpose(0, 2, 3, 1, 4)
    ck = ck.reshape(b, s, nh, 2, DIFF_QK_DIM).transpose(0, 2, 3, 1, 4)
    lv = c_lambda.astype(jnp.float32)
    lam = jnp.exp(jnp.sum(lv[0] * lv[1])) - jnp.exp(jnp.sum(lv[2] * lv[3])) + lam_init
    hc = diff_attention(rms_norm(cq, c_q_norm), rms_norm(ck, c_k_norm), split_heads(cv, nh), lam)
    yc = merge_heads(rms_norm(hc, c_out_norm) * (1.0 - lam_init))

    yd = merge_heads(stick_breaking_attention(split_heads(dq, nh), split_heads(dk, nh), split_heads(dv, nh)))

    return jnp.concatenate([ya, yb, yc, yd], axis=-1)


def setup_inputs(seed: int = 0) -> dict:
    key = jax.random.key(seed)
    ks = jax.random.split(key, 32)
    f32 = jnp.float32

    def nrm(k, shape, scale):
        return jax.random.normal(k, shape, f32) * scale

    def gain(k, shape):
        return 1.0 + 0.05 * jax.random.normal(k, shape, f32)

    i_bias = nrm(ks[13], (DEPTH, HEADS_PER_GROUP), 0.1)
    f_bias = jnp.linspace(3.0, 6.0, HEADS_PER_GROUP, dtype=f32)[None, :] + nrm(ks[14], (DEPTH, HEADS_PER_GROUP), 0.1)
    return {
        "x": jax.random.normal(ks[0], (BATCH, SEQ, D_MODEL), f32),
        "ffn1_norm": gain(ks[1], (DEPTH, D_MODEL)),
        "ffn1_wg": nrm(ks[2], (DEPTH, D_MODEL, D_FF), D_MODEL ** -0.5),
        "ffn1_wu": nrm(ks[3], (DEPTH, D_MODEL, D_FF), D_MODEL ** -0.5),
        "ffn1_wd": nrm(ks[4], (DEPTH, D_FF, D_MODEL), D_FF ** -0.5),
        "mix_norm": gain(ks[5], (DEPTH, D_MODEL)),
        "w_in": nrm(ks[6], (DEPTH, D_MODEL, IN_COLS), D_MODEL ** -0.5),
        "a_q_norm": gain(ks[7], (DEPTH, HEAD_DIM)),
        "a_k_norm": gain(ks[8], (DEPTH, HEAD_DIM)),
        "a_rel_bias": nrm(ks[9], (DEPTH, HEADS_PER_GROUP, 2 * REL_CLIP + 1), 0.2),
        "b_conv_w": nrm(ks[10], (DEPTH, CONV_WIDTH, 2 * GROUP_WIDTH), CONV_WIDTH ** -0.5),
        "b_conv_b": nrm(ks[11], (DEPTH, 2 * GROUP_WIDTH), 0.02),
        "b_gate_bias": jnp.stack([i_bias, f_bias], axis=1),
        "b_out_norm": gain(ks[12], (DEPTH, HEADS_PER_GROUP, HEAD_DIM)),
        "c_q_norm": gain(ks[15], (DEPTH, DIFF_QK_DIM)),
        "c_k_norm": gain(ks[16], (DEPTH, DIFF_QK_DIM)),
        "c_lambda": nrm(ks[17], (DEPTH, 4, DIFF_QK_DIM), 0.1),
        "c_out_norm": gain(ks[18], (DEPTH, HEAD_DIM)),
        "w_out": nrm(ks[19], (DEPTH, D_MODEL, D_MODEL), D_MODEL ** -0.5),
        "ffn2_norm": gain(ks[20], (DEPTH, D_MODEL)),
        "ffn2_wg": nrm(ks[21], (DEPTH, D_MODEL, D_FF), D_MODEL ** -0.5),
        "ffn2_wu": nrm(ks[22], (DEPTH, D_MODEL, D_FF), D_MODEL ** -0.5),
        "ffn2_wd": nrm(ks[23], (DEPTH, D_FF, D_MODEL), D_FF ** -0.5),
    }


def reference(x, ffn1_norm, ffn1_wg, ffn1_wu, ffn1_wd, mix_norm, w_in, a_q_norm, a_k_norm, a_rel_bias,
              b_conv_w, b_conv_b, b_gate_bias, b_out_norm, c_q_norm, c_k_norm, c_lambda, c_out_norm,
              w_out, ffn2_norm, ffn2_wg, ffn2_wu, ffn2_wd):
    for l in range(DEPTH):
        lam_init = 0.8 - 0.6 * math.exp(-0.3 * l)
        x = x + 0.5 * swiglu(rms_norm(x, ffn1_norm[l]), ffn1_wg[l], ffn1_wu[l], ffn1_wd[l])
        h = rms_norm(x, mix_norm[l])
        y = hybrid_mix(h, w_in[l], a_q_norm[l], a_k_norm[l], a_rel_bias[l], b_conv_w[l], b_conv_b[l],
                       b_gate_bias[l], b_out_norm[l], c_q_norm[l], c_k_norm[l], c_lambda[l], c_out_norm[l],
                       lam_init)
        x = x + y @ w_out[l]
        x = x + 0.5 * swiglu(rms_norm(x, ffn2_norm[l]), ffn2_wg[l], ffn2_wu[l], ffn2_wd[l])
    return x
```

```cpp
#include <hip/hip_runtime.h>
#include <hip/hip_cooperative_groups.h>
#include <cstdio>
#include <cstdint>
namespace cg = cooperative_groups;

namespace pg8 {
#define PG8_LAS __attribute__((address_space(3)))
typedef unsigned short bf16_t;
typedef short bf16x8 __attribute__((ext_vector_type(8)));
typedef float f32x4 __attribute__((ext_vector_type(4)));
typedef unsigned u32x4 __attribute__((ext_vector_type(4)));
constexpr int BM = 256, BK = 64, HALF = 128, HTB = HALF * BK * 2  , STAGE_BYTES = 8 * HTB, NXCD = 8, WGM = 4;

__host__ __device__ __forceinline__ int lds_byte(int r, int c) { const int st = (r >> 4) * 2 + (c >> 5), rr = r & 15, cc = c & 31, ob = rr * 64 + cc * 2; return st * 1024 + (ob ^ (((ob >> 9) & 1) << 5)); }
__host__ __device__ __forceinline__ void stage_rc(int b, int& R, int& C) { const int st = b / 1024, sb = b % 1024, swz = sb ^ (((sb >> 9) & 1) << 5); R = (st >> 1) * 16 + swz / 64; C = (st & 1) * 32 + (swz % 64) / 2; }
__host__ __device__ __forceinline__ int perm32(int rho) { const int n = rho >> 4, i = rho & 15; return 8 * (i >> 2) + 4 * n + (i & 3); }

struct Unit { int pm, pn; };
struct Gemm { const bf16_t* A; const bf16_t* Bt; int M, N, K; };

struct StaticOrder {
    int nM, nN, nwg, G, c;
    __host__ __device__ void init(int M, int N, int G_, int c_) { nM = M / BM; nN = N / BM; nwg = nM * nN; G = G_; c = c_; }
    __host__ __device__ bool next(int i, Unit& u) const {
        const long L = (long)i * G + c; if (L >= nwg) return false;
        int wgid = (int)L; { const int q = nwg / NXCD, r = nwg % NXCD, xcd = wgid % NXCD, off = wgid / NXCD; wgid = (xcd < r ? xcd * (q + 1) : r * (q + 1) + (xcd - r) * q) + off; }
        const int nig = WGM * nN, gid = wgid / nig, fm = gid * WGM, gsz = (nM - fm) < WGM ? (nM - fm) : WGM;
        u.pm = fm + ((wgid % nig) % gsz); u.pn = (wgid % nig) / gsz; return true;
    }
    __device__ __forceinline__ void a_ready(const Unit&) const {}
    __device__ __forceinline__ void done(const Unit&) const {}
};


typedef float f32x2_t __attribute__((ext_vector_type(2))); typedef __bf16 bf16x2_t __attribute__((ext_vector_type(2)));
__device__ __forceinline__ unsigned cvt_pk_bf16(float lo, float hi) { f32x2_t v = {lo, hi}; bf16x2_t b = __builtin_convertvector(v, bf16x2_t); return __builtin_bit_cast(unsigned, b); }
__device__ __forceinline__ float silu_f(float x) { return x * __builtin_amdgcn_rcpf(1.0f + __builtin_amdgcn_exp2f(-1.4426950408889634f * x)); }

struct EpiBf16Lim {
    static constexpr bool PERM = true, AFTER_DRAIN = false;
    bf16_t* O; int ldc; int ncols; const float* ss;
    __device__ __forceinline__ void operator()(const f32x4 (&acc)[2][2][4][2], const Unit& u, int wr, int wc, int fr, int fq) const {
        const int row0 = u.pm * BM + wr * 64 + fr; const int col0 = u.pn * BM + wc * 32 + 8 * fq;
        float rsv[2][4];
#pragma unroll
        for (int ai = 0; ai < 2; ++ai)
#pragma unroll
            for (int m = 0; m < 4; ++m) rsv[ai][m] = ss[row0 + ai * HALF + m * 16];
#pragma unroll
        for (int ai = 0; ai < 2; ++ai)
#pragma unroll
            for (int m = 0; m < 4; ++m) { bf16_t* rowp = O + (size_t)(row0 + ai * HALF + m * 16) * ldc + col0;
                const float rs = __builtin_amdgcn_rsqf(rsv[ai][m] * (1.0f / 1024.0f) + 1e-6f);
#pragma unroll
                for (int bj = 0; bj < 2; ++bj) { const f32x4 v0 = acc[ai][bj][m][0] * rs, v1 = acc[ai][bj][m][1] * rs;
                    u32x4 w; w.x = cvt_pk_bf16(v0[0], v0[1]); w.y = cvt_pk_bf16(v0[2], v0[3]); w.z = cvt_pk_bf16(v1[0], v1[1]); w.w = cvt_pk_bf16(v1[2], v1[3]);
                    if (col0 + bj * HALF < ncols) *(u32x4*)(rowp + bj * HALF) = w; } }
    }
};
struct EpiSwiGLU {
    static constexpr bool PERM = true, AFTER_DRAIN = false;
    bf16_t* O; int ldc; const float* ss;
    __device__ __forceinline__ void operator()(const f32x4 (&acc)[2][2][4][2], const Unit& u, int wr, int wc, int fr, int fq) const {
        const int row0 = u.pm * BM + wr * 64 + fr; const int col0 = u.pn * HALF + wc * 32 + 8 * fq;
        float rsv[2][4];
#pragma unroll
        for (int ai = 0; ai < 2; ++ai)
#pragma unroll
            for (int m = 0; m < 4; ++m) rsv[ai][m] = ss[row0 + ai * HALF + m * 16];
#pragma unroll
        for (int ai = 0; ai < 2; ++ai)
#pragma unroll
            for (int m = 0; m < 4; ++m) { bf16_t* rowp = O + (size_t)(row0 + ai * HALF + m * 16) * ldc + col0;
                const float rs = __builtin_amdgcn_rsqf(rsv[ai][m] * (1.0f / 1024.0f) + 1e-6f);
                const f32x4 g0 = acc[ai][0][m][0] * rs, g1 = acc[ai][0][m][1] * rs, u0 = acc[ai][1][m][0] * rs, u1 = acc[ai][1][m][1] * rs;
                u32x4 w;
                w.x = cvt_pk_bf16(silu_f(g0[0]) * u0[0], silu_f(g0[1]) * u0[1]); w.y = cvt_pk_bf16(silu_f(g0[2]) * u0[2], silu_f(g0[3]) * u0[3]);
                w.z = cvt_pk_bf16(silu_f(g1[0]) * u1[0], silu_f(g1[1]) * u1[1]); w.w = cvt_pk_bf16(silu_f(g1[2]) * u1[2], silu_f(g1[3]) * u1[3]);
                *(u32x4*)rowp = w; }
    }
};
typedef unsigned u32x2v __attribute__((ext_vector_type(2)));
struct EpiResid {
    static constexpr bool PERM = true, AFTER_DRAIN = false;
    const float* base; float* out; int ldc; float alpha; bf16_t* xb; float* ss;
    __device__ __forceinline__ void operator()(const f32x4 (&acc)[2][2][4][2], const Unit& u, int wr, int wc, int fr, int fq) const {
        const int row0 = u.pm * BM + wr * 64 + fr; const int col0 = u.pn * BM + wc * 32 + 8 * fq;
#pragma unroll
        for (int ai = 0; ai < 2; ++ai) {
            f32x4 pre[4][2][2];
#pragma unroll
            for (int m = 0; m < 4; ++m) { const size_t off = (size_t)(row0 + ai * HALF + m * 16) * ldc + col0;
#pragma unroll
                for (int bj = 0; bj < 2; ++bj)
#pragma unroll
                    for (int n = 0; n < 2; ++n) pre[m][bj][n] = *(const f32x4*)(base + off + bj * HALF + n * 4); }
#pragma unroll
            for (int m = 0; m < 4; ++m) { const size_t off = (size_t)(row0 + ai * HALF + m * 16) * ldc + col0; float q = 0.f;
#pragma unroll
                for (int bj = 0; bj < 2; ++bj) { const f32x4 o0 = pre[m][bj][0] + acc[ai][bj][m][0] * alpha, o1 = pre[m][bj][1] + acc[ai][bj][m][1] * alpha;
                    *(f32x4*)(out + off + bj * HALF) = o0; *(f32x4*)(out + off + bj * HALF + 4) = o1;
                    if (xb) { q += ((o0[0] * o0[0] + o0[1] * o0[1]) + (o0[2] * o0[2] + o0[3] * o0[3])) + ((o1[0] * o1[0] + o1[1] * o1[1]) + (o1[2] * o1[2] + o1[3] * o1[3]));
                        u32x4 w; w.x = cvt_pk_bf16(o0[0], o0[1]); w.y = cvt_pk_bf16(o0[2], o0[3]); w.z = cvt_pk_bf16(o1[0], o1[1]); w.w = cvt_pk_bf16(o1[2], o1[3]); *(u32x4*)(xb + off + bj * HALF) = w; } }
                if (xb) { q += __shfl_xor(q, 16); q += __shfl_xor(q, 32); if (fq == 0) atomicAdd(ss + row0 + ai * HALF + m * 16, q); } }
        }
    }
};

template <class Epi, class Sched, bool ALIGN_EPI = false, bool SP2 = false>
__device__ __forceinline__ void gemm_phase(PG8_LAS unsigned char* lds, const Gemm g, const Sched& S, const Epi& E, int tid_in) {
    int tid_l = tid_in; asm volatile("" : "+v"(tid_l)); const int tid = tid_l, wid = __builtin_amdgcn_readfirstlane(tid >> 6), lane = tid & 63, wr = wid >> 2, wc = wid & 3, fr = lane & 15, fq = lane >> 4;
    const int K = g.K, nt = K / BK;
    unsigned voffA[2], voffB[2];
#pragma unroll
    for (int i = 0; i < 2; ++i) { int R, C; stage_rc(tid * 16 + i * 8192, R, C); const int Rb = Epi::PERM ? ((R & ~31) + perm32(R & 31)) : R;
        voffA[i] = (unsigned)(R * K + C) * 2u; voffB[i] = (unsigned)(Rb * K + C) * 2u; }
    const size_t kstep = (size_t)(BK * 2);
    const size_t hstep = (size_t)HALF * K * 2;
    const size_t tstep = 2 * hstep;
    const unsigned ldsw = (unsigned)wid * 1024u;
    const int aoff = lds_byte(wr * 64 + fr, fq * 8), boff = lds_byte(wc * 32 + fr, fq * 8);
#define PG8_SA(b, h) (((b) * 2 + (h)) * HTB)
#define PG8_SB(b, h) ((4 + (b) * 2 + (h)) * HTB)
#define PG8_STAGE(bufoff, gbase, voff) do { _Pragma("unroll") for (int _i = 0; _i < 2; ++_i) \
        __builtin_amdgcn_global_load_lds((const unsigned*)((const char*)(gbase) + (voff)[_i]), (PG8_LAS unsigned*)(lds + (bufoff) + ldsw + _i * 8192), 16, 0, 0); } while (0)
#define PG8_LDA(dst, b, h) do { _Pragma("unroll") for (int m = 0; m < 4; ++m) _Pragma("unroll") for (int k = 0; k < 2; ++k) dst[m][k] = *(const PG8_LAS bf16x8*)(lds + PG8_SA(b, h) + aoff + m * 2048 + k * 1024); } while (0)
#define PG8_LDB(dst, b, h) do { _Pragma("unroll") for (int n = 0; n < 2; ++n) _Pragma("unroll") for (int k = 0; k < 2; ++k) dst[n][k] = *(const PG8_LAS bf16x8*)(lds + PG8_SB(b, h) + boff + n * 2048 + k * 1024); } while (0)
#define PG8_MMA(ai, bj, At, Bt) do { __builtin_amdgcn_s_setprio(1); _Pragma("unroll") for (int m = 0; m < 4; ++m) _Pragma("unroll") for (int n = 0; n < 2; ++n) _Pragma("unroll") for (int k = 0; k < 2; ++k) \
        acc[ai][bj][m][n] = __builtin_amdgcn_mfma_f32_16x16x32_bf16(Bt[n][k], At[m][k], acc[ai][bj][m][n], 0, 0, 0); __builtin_amdgcn_s_setprio(0); } while (0)
#define PG8_WAIT_V(n) asm volatile("s_waitcnt vmcnt(" #n ")" ::: "memory")
#define PG8_WAIT_L(n) asm volatile("s_waitcnt lgkmcnt(" #n ")" ::: "memory")
#define PG8_BAR __builtin_amdgcn_s_barrier()
#define PG8_SCHED __builtin_amdgcn_sched_barrier(0)
    Unit cur, nxt; int ui = 0;
    if (!S.next(0, cur)) return;
    f32x4 acc[2][2][4][2];
#pragma unroll
    for (int a = 0; a < 2; ++a)
#pragma unroll
        for (int b = 0; b < 2; ++b)
#pragma unroll
            for (int m = 0; m < 4; ++m)
#pragma unroll
                for (int n = 0; n < 2; ++n) acc[a][b][m][n] = (f32x4){0.f, 0.f, 0.f, 0.f};
    bf16x8 At[4][2], B0[2][2], B1[2][2];
    const char* cA = (const char*)g.A + (size_t)cur.pm * tstep; const char* cB = (const char*)g.Bt + (size_t)cur.pn * tstep;
    S.a_ready(cur);
    if constexpr (SP2) {
        PG8_STAGE(PG8_SB(0, 0), cB, voffB); PG8_STAGE(PG8_SB(0, 1), cB + hstep, voffB); PG8_STAGE(PG8_SA(0, 0), cA, voffA); PG8_STAGE(PG8_SA(0, 1), cA + hstep, voffA);
        if (wr == 1) PG8_BAR;
        PG8_WAIT_V(2); PG8_BAR;
        PG8_STAGE(PG8_SB(1, 0), cB + kstep, voffB); PG8_STAGE(PG8_SA(1, 0), cA + kstep, voffA); PG8_STAGE(PG8_SB(1, 1), cB + hstep + kstep, voffB);
        PG8_WAIT_V(6); PG8_BAR;
    } else {
        PG8_STAGE(PG8_SB(0, 0), cB, voffB); PG8_STAGE(PG8_SA(0, 0), cA, voffA); PG8_STAGE(PG8_SB(0, 1), cB + hstep, voffB); PG8_STAGE(PG8_SA(0, 1), cA + hstep, voffA);
        if (wr == 1) PG8_BAR;
        PG8_WAIT_V(4); PG8_BAR;
        PG8_STAGE(PG8_SB(1, 0), cB + kstep, voffB); PG8_STAGE(PG8_SA(1, 0), cA + kstep, voffA); PG8_STAGE(PG8_SB(1, 1), cB + hstep + kstep, voffB);
        PG8_WAIT_V(6); PG8_BAR;
    }
    for (;;) {
        const bool has_next = S.next(ui + 1, nxt);
        const char* nA = has_next ? (const char*)g.A + (size_t)nxt.pm * tstep : cA; const char* nB = has_next ? (const char*)g.Bt + (size_t)nxt.pn * tstep : cB;
        for (int t = 0; t < nt; t += 2) {
            const bool last = (t == nt - 2);
            const char* a1 = cA + (size_t)(t + 1) * kstep;
            const char* a2 = last ? nA : cA + (size_t)(t + 2) * kstep; const char* b2 = last ? nB : cB + (size_t)(t + 2) * kstep;
            const char* a3 = a2 + kstep; const char* b3 = b2 + kstep;
            if (last && has_next) S.a_ready(nxt);
            if constexpr (SP2) {
            PG8_LDB(B0, 0, 0); PG8_LDB(B1, 0, 1); PG8_SCHED; PG8_LDA(At, 0, 0); PG8_STAGE(PG8_SA(1, 1), a1 + hstep, voffA);
            PG8_WAIT_V(8); PG8_WAIT_L(0); PG8_BAR; PG8_MMA(0, 0, At, B0); PG8_MMA(0, 1, At, B1); PG8_BAR; PG8_SCHED;
            PG8_LDA(At, 0, 1); PG8_STAGE(PG8_SB(0, 0), b2, voffB); PG8_STAGE(PG8_SB(0, 1), b2 + hstep, voffB); PG8_STAGE(PG8_SA(0, 0), a2, voffA);
            PG8_WAIT_V(8); PG8_WAIT_L(0); PG8_BAR; PG8_MMA(1, 0, At, B0); PG8_MMA(1, 1, At, B1); PG8_BAR; PG8_SCHED;
            PG8_LDB(B0, 1, 0); PG8_LDB(B1, 1, 1); PG8_SCHED; PG8_LDA(At, 1, 0); PG8_STAGE(PG8_SA(0, 1), a2 + hstep, voffA);
            PG8_WAIT_V(8); PG8_WAIT_L(0); PG8_BAR; PG8_MMA(0, 0, At, B0); PG8_MMA(0, 1, At, B1); PG8_BAR; PG8_SCHED;
            PG8_LDA(At, 1, 1); PG8_STAGE(PG8_SB(1, 0), b3, voffB); PG8_STAGE(PG8_SB(1, 1), b3 + hstep, voffB); PG8_STAGE(PG8_SA(1, 0), a3, voffA);
            PG8_WAIT_V(8); PG8_WAIT_L(0); PG8_BAR; PG8_MMA(1, 0, At, B0); PG8_MMA(1, 1, At, B1); PG8_BAR; PG8_SCHED;
            } else {
            PG8_LDB(B0, 0, 0); PG8_SCHED; PG8_LDA(At, 0, 0); PG8_STAGE(PG8_SA(1, 1), a1 + hstep, voffA);
            PG8_WAIT_L(8); PG8_BAR; PG8_WAIT_L(0); PG8_MMA(0, 0, At, B0); PG8_BAR; PG8_SCHED;
            PG8_LDB(B1, 0, 1); PG8_STAGE(PG8_SB(0, 0), b2, voffB);
            PG8_BAR; PG8_WAIT_L(0); PG8_MMA(0, 1, At, B1); PG8_BAR;
            PG8_LDA(At, 0, 1); PG8_STAGE(PG8_SA(0, 0), a2, voffA);
            PG8_BAR; PG8_WAIT_L(0); PG8_MMA(1, 0, At, B0); PG8_BAR; PG8_SCHED;
            PG8_STAGE(PG8_SB(0, 1), b2 + hstep, voffB);
            PG8_WAIT_V(6); PG8_BAR; PG8_MMA(1, 1, At, B1); PG8_BAR;
            PG8_LDB(B0, 1, 0); PG8_SCHED; PG8_LDA(At, 1, 0); PG8_STAGE(PG8_SA(0, 1), a2 + hstep, voffA);
            PG8_WAIT_L(8); PG8_BAR; PG8_WAIT_L(0); PG8_MMA(0, 0, At, B0); PG8_BAR; PG8_SCHED;
            PG8_LDB(B1, 1, 1); PG8_STAGE(PG8_SB(1, 0), b3, voffB);
            PG8_BAR; PG8_WAIT_L(0); PG8_MMA(0, 1, At, B1); PG8_BAR;
            PG8_LDA(At, 1, 1); PG8_STAGE(PG8_SA(1, 0), a3, voffA);
            PG8_BAR; PG8_WAIT_L(0); PG8_MMA(1, 0, At, B0); PG8_BAR; PG8_SCHED;
            PG8_STAGE(PG8_SB(1, 1), b3 + hstep, voffB);
            PG8_WAIT_V(6); PG8_BAR; PG8_MMA(1, 1, At, B1); PG8_BAR;
            }
        }
        if constexpr (ALIGN_EPI) { if (wr == 0) PG8_BAR; }
        if constexpr (!Epi::AFTER_DRAIN) { E(acc, cur, wr, wc, fr, fq); S.done(cur); }
        if (!has_next) break;
#pragma unroll
        for (int a = 0; a < 2; ++a)
#pragma unroll
            for (int b = 0; b < 2; ++b)
#pragma unroll
                for (int m = 0; m < 4; ++m)
#pragma unroll
                    for (int n = 0; n < 2; ++n) acc[a][b][m][n] = (f32x4){0.f, 0.f, 0.f, 0.f};
        cur = nxt; cA = nA; cB = nB; ++ui;
        if constexpr (ALIGN_EPI) { if (wr == 1) PG8_BAR; }
    }
    PG8_WAIT_V(0);
    if constexpr (!ALIGN_EPI) { if (wr == 0) PG8_BAR; }
    PG8_BAR;
    if constexpr (Epi::AFTER_DRAIN) { E.fused(acc, cur, wr, wc, fr, fq, lds, wid, lane); S.done(cur); }
#undef PG8_SA
#undef PG8_SB
#undef PG8_STAGE
#undef PG8_LDA
#undef PG8_LDB
#undef PG8_MMA
#undef PG8_WAIT_V
#undef PG8_WAIT_L
#undef PG8_BAR
#undef PG8_SCHED
}
}

typedef unsigned short bf16_t;
typedef short bf16x8 __attribute__((ext_vector_type(8)));
typedef short s16x4 __attribute__((ext_vector_type(4)));
typedef float f32x4 __attribute__((ext_vector_type(4)));
typedef float f32x16 __attribute__((ext_vector_type(16)));
typedef unsigned u32x4 __attribute__((ext_vector_type(4)));
typedef unsigned u32x2 __attribute__((ext_vector_type(2)));
#define DI __device__ __forceinline__
#define LAUNDER(x) asm volatile("" : "+v"(x))

constexpr int T_ = 32768, DM = 1024, FF = 2816, SEQ = 16384, NLAYER = 2;
constexpr int INC = 3336, INP = 3584, PLD = 3344;
constexpr int C_AQ = 0, C_AK = 256, C_AV = 512, C_BQ = 768, C_BK = 1024, C_BV = 1280, C_BO = 1536, C_CQ = 1792, C_CK = 2048, C_CV = 2304, C_DQ = 2560, C_DK = 2816, C_DV = 3072, C_GI = 3328, C_GF = 3332;
constexpr float LOG2E = 1.4426950408889634f, EPS_ = 1e-6f;
#ifndef D_EARLY
#define D_EARLY 1
#endif

constexpr size_t SZ_WGU = (size_t)2 * FF * DM * 2, SZ_WD = (size_t)DM * FF * 2, SZ_WIN = (size_t)INP * DM * 2, SZ_WOUT = (size_t)DM * DM * 2;
constexpr size_t LW_WGU1 = 0, LW_WD1 = LW_WGU1 + SZ_WGU, LW_WIN = LW_WD1 + SZ_WD, LW_WOUT = LW_WIN + SZ_WIN, LW_WGU2 = LW_WOUT + SZ_WOUT, LW_WD2 = LW_WGU2 + SZ_WGU, LW_SIZE = LW_WD2 + SZ_WD;
constexpr size_t WS_CTL = 0, WS_W = 8192, WS_XN = WS_W + NLAYER * LW_SIZE, WS_HP = WS_XN + (size_t)T_ * DM * 2, WS_BQ = WS_HP + (size_t)T_ * PLD * 2,
                 WS_BK = WS_BQ + (size_t)T_ * 256 * 2, WS_BKT = WS_BK + (size_t)T_ * 256 * 2, WS_VT = WS_BKT + (size_t)T_ * 256 * 2, WS_DC = WS_VT + (size_t)4 * T_ * 256 * 2,
                 WS_SC = WS_DC + (size_t)8 * 256 * 4160 * 4, WS_SS = WS_SC + 3 * 8 * 256 * 4, WS_END = WS_SS + (size_t)7 * T_ * 4;
static_assert(WS_XN % 256 == 0 && WS_HP % 256 == 0 && WS_BQ % 256 == 0 && WS_DC % 256 == 0 && (size_t)T_ * FF * 2 <= (size_t)T_ * PLD * 2, "ws map");
constexpr int LDS_BYTES = pg8::STAGE_BYTES + 1024;

DI unsigned pk2(float a, float b) { return pg8::cvt_pk_bf16(a, b); }
DI float bf2f(bf16_t h) { return __uint_as_float((unsigned)h << 16); }
DI float bflo(unsigned w) { return __uint_as_float(w << 16); }
DI float bfhi(unsigned w) { return __uint_as_float(w & 0xffff0000u); }
DI float ex2(float x) { return __builtin_amdgcn_exp2f(x); }
DI float lg2(float x) { return __builtin_amdgcn_logf(x); }
DI float rcpf_(float x) { return __builtin_amdgcn_rcpf(x); }
DI int crow(int r, int hi) { return (r & 3) + 8 * (r >> 2) + 4 * hi; }
#define MFMA32(a, b, c) __builtin_amdgcn_mfma_f32_32x32x16_bf16((a), (b), (c), 0, 0, 0)
DI f32x16 splat16(float v) { f32x16 r;
#pragma unroll
  for (int i = 0; i < 16; ++i) r[i] = v; return r; }
DI bf16x8 pack8(const f32x16& s, int kk) {
  u32x4 p; p.x = pk2(s[8 * kk], s[8 * kk + 1]); p.y = pk2(s[8 * kk + 2], s[8 * kk + 3]); p.z = pk2(s[8 * kk + 4], s[8 * kk + 5]); p.w = pk2(s[8 * kk + 6], s[8 * kk + 7]);
  return __builtin_bit_cast(bf16x8, p); }
DI bf16x8 cat4(s16x4 lo, s16x4 hi) { return __builtin_shufflevector(lo, hi, 0, 1, 2, 3, 4, 5, 6, 7); }

struct Args { const float* in[23]; float* out; unsigned char* ws; };

struct TDesc { const float* W0; const float* W1; const float* gk; bf16_t* WT; int kind, K, N, kt, nt; };
DI TDesc tt_decode(const Args& a, int it) {
  constexpr int I_GU = 16 * 88, I_D = 44 * 16, I_IN = 16 * 56, I_OUT = 16 * 16, I_L = 2 * I_GU + 2 * I_D + I_IN + I_OUT;
  const int l = it / I_L; int r = it % I_L; unsigned char* wl = a.ws + WS_W + (size_t)l * LW_SIZE; TDesc d;
  if (r < I_GU) { d.W0 = a.in[2] + (size_t)l * DM * FF; d.W1 = a.in[3] + (size_t)l * DM * FF; d.gk = a.in[1] + l * DM; d.WT = (bf16_t*)(wl + LW_WGU1); d.kind = 0; d.K = DM; d.N = FF; d.kt = r / 88; d.nt = r % 88; return d; } r -= I_GU;
  if (r < I_D) { d.W0 = a.in[4] + (size_t)l * FF * DM; d.W1 = nullptr; d.gk = nullptr; d.WT = (bf16_t*)(wl + LW_WD1); d.kind = 1; d.K = FF; d.N = DM; d.kt = r / 16; d.nt = r % 16; return d; } r -= I_D;
  if (r < I_IN) { d.W0 = a.in[6] + (size_t)l * DM * INC; d.W1 = nullptr; d.gk = a.in[5] + l * DM; d.WT = (bf16_t*)(wl + LW_WIN); d.kind = 2; d.K = DM; d.N = INC; d.kt = r / 56; d.nt = r % 56; return d; } r -= I_IN;
  if (r < I_OUT) { d.W0 = a.in[18] + (size_t)l * DM * DM; d.W1 = nullptr; d.gk = nullptr; d.WT = (bf16_t*)(wl + LW_WOUT); d.kind = 1; d.K = DM; d.N = DM; d.kt = r / 16; d.nt = r % 16; return d; } r -= I_OUT;
  if (r < I_GU) { d.W0 = a.in[20] + (size_t)l * DM * FF; d.W1 = a.in[21] + (size_t)l * DM * FF; d.gk = a.in[19] + l * DM; d.WT = (bf16_t*)(wl + LW_WGU2); d.kind = 0; d.K = DM; d.N = FF; d.kt = r / 88; d.nt = r % 88; return d; } r -= I_GU;
  d.W0 = a.in[22] + (size_t)l * FF * DM; d.W1 = nullptr; d.gk = nullptr; d.WT = (bf16_t*)(wl + LW_WD2); d.kind = 1; d.K = FF; d.N = DM; d.kt = r / 16; d.nt = r % 16; return d;
}
DI void tt_load(const TDesc& d, f32x4 (&v)[2], int tid) {
  const int n4 = tid & 15, np = d.nt * 64 + 4 * n4, k0 = d.kt * 64; const float* src = d.W0; int col;
  if (d.kind == 0) { const int pn = np >> 8, r = np & 255; src = (r < 128) ? d.W0 : d.W1; col = 128 * pn + (r & 127); }
  else if (d.kind == 1) col = np;
  else col = (np < 1792) ? np : (np < 3328) ? np + 8 : (np < 3336) ? 1792 + (np - 3328) : -1;
#pragma unroll
  for (int p = 0; p < 2; ++p) { const int kk = (tid >> 4) + 32 * p;
    v[p] = (col >= 0) ? *(const f32x4*)(src + (size_t)(k0 + kk) * d.N + col) * (d.gk ? d.gk[k0 + kk] : 1.f) : (f32x4){0.f, 0.f, 0.f, 0.f}; }
}
DI void prologue_weights(const Args& a, unsigned char* lds, int tid) {
  LAUNDER(tid);
  constexpr int NI = 6, NITEMS = NLAYER * (2 * 16 * 88 + 2 * 44 * 16 + 16 * 56 + 16 * 16);
  for (int it0 = blockIdx.x; it0 < NITEMS; it0 += NI * gridDim.x) {
    f32x4 v[NI][2]; TDesc d[NI];
#pragma unroll
    for (int q = 0; q < NI; ++q) { const int it = it0 + q * gridDim.x; if (it < NITEMS) { d[q] = tt_decode(a, it); tt_load(d[q], v[q], tid); } }
#pragma unroll
    for (int q = 0; q < NI; ++q) { float* scr = (float*)lds + q * (64 * 65);
#pragma unroll
      for (int p = 0; p < 2; ++p) { float* w = scr + ((tid >> 4) + 32 * p) * 65 + 4 * (tid & 15); w[0] = v[q][p].x; w[1] = v[q][p].y; w[2] = v[q][p].z; w[3] = v[q][p].w; } }
    __syncthreads();
#pragma unroll
    for (int q = 0; q < NI; ++q) { const int it = it0 + q * gridDim.x; if (it < NITEMS) {
      const int n = tid >> 3, kc = tid & 7; const float* sp = (const float*)lds + q * (64 * 65) + (8 * kc) * 65 + n;
      u32x4 o; o.x = pk2(sp[0], sp[65]); o.y = pk2(sp[2 * 65], sp[3 * 65]); o.z = pk2(sp[4 * 65], sp[5 * 65]); o.w = pk2(sp[6 * 65], sp[7 * 65]);
      *(u32x4*)(d[q].WT + (size_t)(d[q].nt * 64 + n) * d[q].K + d[q].kt * 64 + 8 * kc) = o; } }
    __syncthreads();
  }
}

DI float wave_sum(float v) {
#pragma unroll
  for (int o = 1; o < 64; o <<= 1) v += __shfl_xor(v, o);
  return v; }
DI float wave_max(float v) {
#pragma unroll
  for (int o = 1; o < 64; o <<= 1) v = fmaxf(v, __shfl_xor(v, o));
  return v; }
DI void cast_phase(const float* x, bf16_t* xb, float* ss, int tid) {
  LAUNDER(tid);
  const int lane = tid & 63, gw = blockIdx.x * 8 + (tid >> 6), ngw = gridDim.x * 8;
  for (int i = blockIdx.x * 512 + tid; i < 6 * T_; i += gridDim.x * 512) ss[T_ + i] = 0.f;
  for (int m0 = gw; m0 < T_; m0 += 2 * ngw) {
    f32x4 v[2][4];
#pragma unroll
    for (int r = 0; r < 2; ++r) { const int m = m0 + r * ngw; if (m < T_) { const f32x4* xr = (const f32x4*)(x + (size_t)m * DM) + lane;
#pragma unroll
      for (int j = 0; j < 4; ++j) v[r][j] = xr[64 * j]; } }
#pragma unroll
    for (int r = 0; r < 2; ++r) { const int m = m0 + r * ngw; if (m < T_) { float q = 0.f;
#pragma unroll
      for (int j = 0; j < 4; ++j) q += (v[r][j].x * v[r][j].x + v[r][j].y * v[r][j].y) + (v[r][j].z * v[r][j].z + v[r][j].w * v[r][j].w);
      q = wave_sum(q); if (lane == 0) ss[m] = q;
      u32x2* o = (u32x2*)(xb + (size_t)m * DM) + lane;
#pragma unroll
      for (int j = 0; j < 4; ++j) { u32x2 w; w.x = pk2(v[r][j].x, v[r][j].y); w.y = pk2(v[r][j].z, v[r][j].w); o[64 * j] = w; } } }
  }
}

struct PrepParams { const float *aqg, *akg, *cqg, *ckg, *convw, *convb; };
DI void prep_phase(bf16_t* P, bf16_t* BQ, bf16_t* BK, bf16_t* BKt, bf16_t* Vt, const PrepParams& pp, unsigned char* lds, int tid) {
  LAUNDER(tid);
  float* gt = (float*)lds;
  if (tid < 64) { gt[tid] = pp.aqg[tid]; gt[64 + tid] = pp.akg[tid]; gt[128 + tid] = pp.cqg[tid & 31]; gt[192 + tid] = pp.ckg[tid & 31]; gt[256 + tid] = 1.f; }
  __syncthreads();
  for (int tile = blockIdx.x; tile < T_ / 64; tile += gridDim.x) {
    const int tok0 = tile * 64, b = tok0 / SEQ, s0 = tok0 % SEQ;
    for (int id0 = tid; id0 < 64 * 160; id0 += 10 * 512) {
      u32x4 w4[10]; bf16_t* p4[10];
#pragma unroll
      for (int u = 0; u < 10; ++u) { const int id = id0 + 512 * u, tk = id / 160, ci = id % 160, seg = ci >> 5, within = (ci & 31) * 8;
        const int colb = (seg == 0) ? C_AQ : (seg == 1) ? C_AK : (seg == 2) ? C_CQ : (seg == 3) ? C_CK : C_DQ;
        p4[u] = P + (size_t)(tok0 + tk) * PLD + colb + within; w4[u] = *(const u32x4*)p4[u]; }
#pragma unroll
      for (int u = 0; u < 10; ++u) { const int id = id0 + 512 * u, ci = id % 160, seg = ci >> 5, within = (ci & 31) * 8;
        const u32x4 w = w4[u]; float v[8];
        v[0] = bflo(w.x); v[1] = bfhi(w.x); v[2] = bflo(w.y); v[3] = bfhi(w.y); v[4] = bflo(w.z); v[5] = bfhi(w.z); v[6] = bflo(w.w); v[7] = bfhi(w.w);
        float ss = 0.f;
#pragma unroll
        for (int j = 0; j < 8; ++j) ss += v[j] * v[j];
        ss += __shfl_xor(ss, 1); ss += __shfl_xor(ss, 2);
        const float ss32 = ss; ss += __shfl_xor(ss, 4);
        float sc;
        if (seg < 2) { sc = rsqrtf(ss * (1.f / 64.f) + EPS_) * (seg == 0 ? 0.125f * LOG2E : 1.f); }
        else if (seg < 4) { sc = rsqrtf(ss32 * (1.f / 32.f) + EPS_) * (seg == 2 ? 0.17677669529663687f * LOG2E : 1.f); }
        else { sc = 0.125f * LOG2E; }
        const float* gp = gt + seg * 64 + (within & 63);
        const f32x4 ga = *(const f32x4*)gp, gb = *(const f32x4*)(gp + 4);
        u32x4 o; o.x = pk2(v[0] * sc * ga.x, v[1] * sc * ga.y); o.y = pk2(v[2] * sc * ga.z, v[3] * sc * ga.w); o.z = pk2(v[4] * sc * gb.x, v[5] * sc * gb.y); o.w = pk2(v[6] * sc * gb.z, v[7] * sc * gb.w);
        *(u32x4*)p4[u] = o; }
    }
    bf16_t* Lin = (bf16_t*)(lds + 2048); bf16_t* Lout = Lin + 67 * 264;
    u32x4 r[5];
#define PREP_LOAD_GROUP(G) do { const int col0_ = ((G) == 0) ? C_AV : ((G) == 1) ? C_BV : ((G) == 2) ? C_CV : ((G) == 3) ? C_DV : ((G) == 4) ? C_BQ : C_BK; \
      _Pragma("unroll") for (int u = 0; u < 5; ++u) { const int idx = tid + 512 * u, row = idx >> 5, pc = idx & 31, srow = s0 - 3 + row; \
        r[u] = (u32x4){0u, 0u, 0u, 0u}; \
        if (idx < 67 * 32 && srow >= 0) r[u] = *(const u32x4*)(P + (size_t)(b * SEQ + srow) * PLD + col0_ + 8 * pc); } } while (0)
    PREP_LOAD_GROUP(0);
#pragma unroll
    for (int g = 0; g < 6; ++g) {
      __syncthreads();
#pragma unroll
      for (int u = 0; u < 5; ++u) { const int idx = tid + 512 * u, row = idx >> 5, pc = idx & 31; if (idx < 67 * 32) *(u32x4*)(Lin + row * 264 + 8 * pc) = r[u]; }
      __syncthreads();
      if (g + 1 < 6) PREP_LOAD_GROUP(g + 1);
      const int c = tid & 255, th = tid >> 8; const bf16_t* colp = Lin + (32 * th) * 264 + c;
      if (g < 4) {
        unsigned w[16];
#pragma unroll
        for (int q = 0; q < 16; ++q) { const int p = 2 * q, i = (p & ~12) | ((p & 4) << 1) | ((p & 8) >> 1);
          w[q] = (unsigned)colp[(3 + i) * 264] | ((unsigned)colp[(3 + i + 1) * 264] << 16); }
        bf16_t* vd = Vt + (size_t)g * T_ * 256 + (((size_t)(b * 4 + (c >> 6)) * 256 + (s0 >> 6)) * 64 + (c & 63)) * 64 + 32 * th;
#pragma unroll
        for (int q4 = 0; q4 < 4; ++q4) { u32x4 o; o.x = w[4 * q4]; o.y = w[4 * q4 + 1]; o.z = w[4 * q4 + 2]; o.w = w[4 * q4 + 3]; *(u32x4*)(vd + 8 * q4) = o; }
      } else {
        const int cq = (g - 4) * 256 + c;
        const float w0 = pp.convw[cq], w1 = pp.convw[512 + cq], w2 = pp.convw[1024 + cq], w3 = pp.convw[1536 + cq], bb = pp.convb[cq], sc = (g == 4) ? 1.f : 0.125f;
        float x[35];
#pragma unroll
        for (int i = 0; i < 35; ++i) x[i] = bf2f(colp[i * 264]);
        unsigned short yb[32];
#pragma unroll
        for (int i = 0; i < 32; ++i) { const float y = bb + x[i] * w0 + x[i + 1] * w1 + x[i + 2] * w2 + x[i + 3] * w3; yb[i] = (unsigned short)(pk2(pg8::silu_f(y) * sc, 0.f) & 0xffffu); Lout[(32 * th + i) * 264 + c] = yb[i]; }
        if (g == 5) {
          bf16_t* kd = BKt + (((size_t)(b * 4 + (c >> 6)) * 256 + (s0 >> 6)) * 64 + (c & 63)) * 64 + 32 * th;
#pragma unroll
          for (int q4 = 0; q4 < 4; ++q4) { unsigned w[4];
#pragma unroll
            for (int q = 0; q < 4; ++q) { const int p = 2 * (4 * q4 + q), i = (p & ~12) | ((p & 4) << 1) | ((p & 8) >> 1); w[q] = (unsigned)yb[i] | ((unsigned)yb[i + 1] << 16); }
            u32x4 o; o.x = w[0]; o.y = w[1]; o.z = w[2]; o.w = w[3]; *(u32x4*)(kd + 8 * q4) = o; }
        }
        __syncthreads();
        bf16_t* dst = (g == 4) ? BQ : BK;
#pragma unroll
        for (int u = 0; u < 4; ++u) { const int idx = tid + 512 * u, row = idx >> 5, pc = idx & 31; *(u32x4*)(dst + (size_t)(tok0 + row) * 256 + 8 * pc) = *(const u32x4*)(Lout + row * 264 + 8 * pc); }
      }
    }
    __syncthreads();
  }
}

#undef PREP_LOAD_GROUP
DI float wave_scan_add(float v, int lane) {
#pragma unroll
  for (int o = 1; o < 64; o <<= 1) { const float t = __shfl_up(v, o); if (lane >= o) v += t; }
  return v; }
DI float wave_scan_max(float v, int lane) {
#pragma unroll
  for (int o = 1; o < 64; o <<= 1) { const float t = __shfl_up(v, o); if (lane >= o) v = fmaxf(v, t); }
  return v; }
DI float fexp(float x) { return ex2(x * LOG2E); }
DI float log_sigmoid_f(float x) { return fminf(x, 0.f) - lg2(1.0f + fexp(-fabsf(x))) * 0.6931471805599453f; }
DI void lds_wave_sync() { asm volatile("s_waitcnt lgkmcnt(0)" ::: "memory"); __builtin_amdgcn_wave_barrier(); }

DI void b1_phase(const bf16_t* P, const bf16_t* BKt, const bf16_t* VtB, float* DC, float* SC, const float* gate_bias, unsigned char* lds, int tid) {
  LAUNDER(tid);
  const int lane = tid & 63, wave = tid >> 6, r32 = lane & 31, hi = lane >> 5;
  float* wsc = (float*)(lds + wave * 1024);
  for (int item = blockIdx.x * 8 + wave; item < 2048; item += gridDim.x * 8) {
    const int bh = item >> 8, c = item & 255, b = bh >> 2, h = bh & 3, s0 = c * 64; const size_t tok0 = (size_t)b * SEQ + s0;
    const float gf = bf2f(P[(tok0 + lane) * PLD + C_GF + h]) + gate_bias[4 + h], gi = bf2f(P[(tok0 + lane) * PLD + C_GI + h]) + gate_bias[h];
    const float lf = log_sigmoid_f(gf), bcum = wave_scan_add(lf, lane), btot = __shfl(bcum, 63);
    const float g = btot - bcum + gi, mloc = wave_max(g), w = fexp(g - mloc);
    wsc[lane] = w; lds_wave_sync();
    f32x16 acc[2][2];
#pragma unroll
    for (int i = 0; i < 2; ++i)
#pragma unroll
      for (int j = 0; j < 2; ++j) acc[i][j] = splat16(0.f);
    float dn[2] = {0.f, 0.f};
#pragma unroll
    for (int ks = 0; ks < 4; ++ks) {
      const f32x4 wa = *(const f32x4*)(wsc + 16 * ks + 4 * hi), wb = *(const f32x4*)(wsc + 16 * ks + 8 + 4 * hi);
      bf16x8 vf[2], kf[2];
#pragma unroll
      for (int eb = 0; eb < 2; ++eb) {
        vf[eb] = *(const bf16x8*)(VtB + (((size_t)bh * 256 + c) * 64 + 32 * eb + r32) * 64 + 16 * ks + 8 * hi);
        const u32x4 kw = *(const u32x4*)(BKt + (((size_t)bh * 256 + c) * 64 + 32 * eb + r32) * 64 + 16 * ks + 8 * hi);
        const float k0 = bflo(kw.x) * wa.x, k1 = bfhi(kw.x) * wa.y, k2 = bflo(kw.y) * wa.z, k3 = bfhi(kw.y) * wa.w, k4 = bflo(kw.z) * wb.x, k5 = bfhi(kw.z) * wb.y, k6 = bflo(kw.w) * wb.z, k7 = bfhi(kw.w) * wb.w;
        dn[eb] += ((k0 + k1) + (k2 + k3)) + ((k4 + k5) + (k6 + k7));
        u32x4 o; o.x = pk2(k0, k1); o.y = pk2(k2, k3); o.z = pk2(k4, k5); o.w = pk2(k6, k7); kf[eb] = __builtin_bit_cast(bf16x8, o);
      }
#pragma unroll
      for (int eb = 0; eb < 2; ++eb)
#pragma unroll
        for (int db = 0; db < 2; ++db) acc[eb][db] = MFMA32(vf[eb], kf[db], acc[eb][db]);
    }
    float* dc = DC + ((size_t)bh * 256 + c) * 4160;
#pragma unroll
    for (int eb = 0; eb < 2; ++eb)
#pragma unroll
      for (int db = 0; db < 2; ++db)
#pragma unroll
        for (int i = 0; i < 16; ++i) dc[(32 * eb + crow(i, hi)) * 64 + 32 * db + r32] = acc[eb][db][i];
#pragma unroll
    for (int db = 0; db < 2; ++db) { const float t = dn[db] + __shfl_xor(dn[db], 32); if (hi == 0) dc[4096 + 32 * db + r32] = t; }
    if (lane == 0) { SC[bh * 256 + c] = btot; SC[2048 + bh * 256 + c] = mloc; }
    lds_wave_sync();
  }
}

DI void b2_item(float* DC, float* SC, int j, unsigned char* lds, int tid) {
  LAUNDER(tid);
  float* L = (float*)lds;
  const int ge = j * 512 + tid, bh0 = (j * 512) / 1040, bh1 = (j * 512 + 511) / 1040;
  { const int slot = tid >> 8, c = tid & 255, bh = slot ? bh1 : bh0;
    if (bh < 8) { L[slot * 1024 + c] = SC[bh * 256 + c]; L[slot * 1024 + 256 + c] = SC[2048 + bh * 256 + c]; } }
  __syncthreads();
  if ((tid & 63) == 0 && (tid >> 6) < 2) { const int slot = tid >> 6, bh = slot ? bh1 : bh0;
    if (bh < 8 && (slot == 0 || bh1 != bh0)) { float* q = L + slot * 1024; float m = 0.f; const bool wr = (j * 512 <= bh * 1040) && (bh * 1040 < j * 512 + 512);
      for (int c = 0; c < 256; ++c) { const float b = q[c], l = q[256 + c], mn = fmaxf(b + m, l); q[512 + c] = fexp(b + m - mn); q[768 + c] = fexp(l - mn); if (wr) SC[4096 + bh * 256 + c] = m; m = mn; } } }
  __syncthreads();
  if (ge < 8 * 1040) {
    const int bh = ge / 1040, el = (ge % 1040) * 4; const float* q = L + ((bh == bh0) ? 0 : 1024);
    float* p = DC + (size_t)bh * 256 * 4160 + el; float z0 = 0.f; LAUNDER(z0); f32x4 C = {z0, z0, z0, z0};
    for (int c0 = 0; c0 < 256; c0 += 8) {
      f32x4 d[8];
#pragma unroll
      for (int u = 0; u < 8; ++u) d[u] = *(const f32x4*)(p + (size_t)(c0 + u) * 4160);
#pragma unroll
      for (int u = 0; u < 8; ++u) { *(f32x4*)(p + (size_t)(c0 + u) * 4160) = C; C = C * q[512 + c0 + u] + d[u] * q[768 + c0 + u]; }
    }
  }
}

DI void b3_phase(const bf16_t* P, const bf16_t* BQ, const bf16_t* BK, const bf16_t* VtB, const float* DC, const float* SC, const float* gate_bias, const float* onorm, bf16_t* Y, unsigned char* lds, int tid) {
  LAUNDER(tid);
  const int lane = tid & 63, wave = tid >> 6, r32 = lane & 31, hi = lane >> 5;
  float* R = (float*)(lds + wave * 2048); float* MU = R + 64; float* SI = R + 128; float* EM = R + 192; float* NV = R + 256;
  for (int item = blockIdx.x * 8 + wave; item < 2048; item += gridDim.x * 8) {
    const int bh = item >> 8, c = item & 255, b = bh >> 2, h = bh & 3, s0 = c * 64; const size_t tok0 = (size_t)b * SEQ + s0;
    const float* dc = DC + ((size_t)bh * 256 + c) * 4160;
    {
      const float gf = bf2f(P[(tok0 + lane) * PLD + C_GF + h]) + gate_bias[4 + h], gi = bf2f(P[(tok0 + lane) * PLD + C_GI + h]) + gate_bias[h];
      const float lf = log_sigmoid_f(gf), bcum = wave_scan_add(lf, lane), r = gi - bcum, pmax = wave_scan_max(r, lane);
      const float m_in = SC[4096 + bh * 256 + c], mu = fmaxf(m_in, pmax);
      R[lane] = r; MU[lane] = mu; SI[lane] = fexp(m_in - mu); EM[lane] = fexp(-bcum - mu); NV[lane] = dc[4096 + lane];
    }
    lds_wave_sync();
#pragma unroll
    for (int tq = 0; tq < 2; ++tq) {
      const int t = 32 * tq + r32; const float mu_t = MU[t], si_t = SI[t], em_t = EM[t];
      bf16x8 qf[4]; float qn = 0.f;
#pragma unroll
      for (int ks = 0; ks < 4; ++ks) {
        const u32x4 qw = *(const u32x4*)(BQ + (tok0 + t) * 256 + h * 64 + 16 * ks + 8 * hi); qf[ks] = __builtin_bit_cast(bf16x8, qw);
        const f32x4 na = *(const f32x4*)(NV + 16 * ks + 8 * hi), nb = *(const f32x4*)(NV + 16 * ks + 8 * hi + 4);
        qn += bflo(qw.x) * na.x + bfhi(qw.x) * na.y + bflo(qw.y) * na.z + bfhi(qw.y) * na.w + bflo(qw.z) * nb.x + bfhi(qw.z) * nb.y + bflo(qw.w) * nb.z + bfhi(qw.w) * nb.w;
      }
      qn += __shfl_xor(qn, 32);
      f32x16 G[2], num[2];
#pragma unroll
      for (int eb = 0; eb < 2; ++eb) { G[eb] = splat16(0.f); num[eb] = splat16(0.f);
#pragma unroll
        for (int ks = 0; ks < 4; ++ks) { const float* cp = dc + (32 * eb + r32) * 64 + 16 * ks + 8 * hi; const f32x4 ca = *(const f32x4*)cp, cb = *(const f32x4*)(cp + 4);
          u32x4 o; o.x = pk2(ca.x, ca.y); o.y = pk2(ca.z, ca.w); o.z = pk2(cb.x, cb.y); o.w = pk2(cb.z, cb.w);
          G[eb] = MFMA32(__builtin_bit_cast(bf16x8, o), qf[ks], G[eb]); }
        asm volatile("" ::: "memory"); }
      float dsum = 0.f;
#pragma unroll
      for (int tk = 0; tk < 2; ++tk) {
        if (tk <= tq) {
          f32x16 S = splat16(0.f);
#pragma unroll
          for (int ks = 0; ks < 4; ++ks) { const bf16x8 kf = *(const bf16x8*)(BK + (tok0 + 32 * tk + r32) * 256 + h * 64 + 16 * ks + 8 * hi); S = MFMA32(kf, qf[ks], S); }
          asm volatile("" ::: "memory");
#pragma unroll
          for (int g4 = 0; g4 < 4; ++g4) { const f32x4 rv = *(const f32x4*)(R + 32 * tk + 8 * g4 + 4 * hi);
#pragma unroll
            for (int j = 0; j < 4; ++j) { const int s = 32 * tk + 8 * g4 + 4 * hi + j; const float w = (s <= t) ? fexp(rv[j] - mu_t) : 0.f; const float val = S[4 * g4 + j] * w; dsum += val; S[4 * g4 + j] = val; } }
#pragma unroll
          for (int kk = 0; kk < 2; ++kk) { const bf16x8 pf = pack8(S, kk);
#pragma unroll
            for (int eb = 0; eb < 2; ++eb) { const bf16_t* vp = VtB + (((size_t)bh * 256 + c) * 64 + 32 * eb + r32) * 64 + 32 * tk + 16 * kk + 8 * hi;
              const bf16x8 vf = *(const bf16x8*)vp; num[eb] = MFMA32(vf, pf, num[eb]); } }
          asm volatile("" ::: "memory");
        }
      }
      dsum += __shfl_xor(dsum, 32);
      const float den = si_t * qn + dsum, inv = 1.0f / fmaxf(fabsf(den), em_t);
      float ss = 0.f;
#pragma unroll
      for (int eb = 0; eb < 2; ++eb)
#pragma unroll
        for (int i = 0; i < 16; ++i) { const float hv = (num[eb][i] + si_t * G[eb][i]) * inv; num[eb][i] = hv; ss += hv * hv; }
      ss += __shfl_xor(ss, 32);
      const float rstd = rsqrtf(ss * (1.f / 64.f) + EPS_);
      const bf16_t* bo = P + (tok0 + t) * PLD + C_BO + h * 64; bf16_t* yo = Y + (tok0 + t) * DM + 256 + h * 64;
#pragma unroll
      for (int eb = 0; eb < 2; ++eb)
#pragma unroll
        for (int g4 = 0; g4 < 4; ++g4) { const int e = 32 * eb + 8 * g4 + 4 * hi; const u32x2 bw = *(const u32x2*)(bo + e); const f32x4 gn = *(const f32x4*)(onorm + h * 64 + e);
          const float o0 = num[eb][4 * g4] * rstd * gn.x * rcpf_(1.f + fexp(-bflo(bw.x))), o1 = num[eb][4 * g4 + 1] * rstd * gn.y * rcpf_(1.f + fexp(-bfhi(bw.x)));
          const float o2 = num[eb][4 * g4 + 2] * rstd * gn.z * rcpf_(1.f + fexp(-bflo(bw.y))), o3 = num[eb][4 * g4 + 3] * rstd * gn.w * rcpf_(1.f + fexp(-bfhi(bw.y)));
          u32x2 ow; ow.x = pk2(o0, o1); ow.y = pk2(o2, o3); *(u32x2*)(yo + e) = ow; }
    }
    lds_wave_sync();
  }
}

struct AttnParams { const bf16_t* P; const bf16_t* Vt; bf16_t* Y; const float* biasL; float negM; float lam; float oscale; const float* cgain; };
constexpr int NCH = 1;
template <int MODE>
DI void attn_unit(unsigned char* lds, const AttnParams& ap, int b, int h, int qb, int tid) {
  LAUNDER(tid);
  const int wave = tid >> 6, lane = tid & 63, r32 = lane & 31, hi = lane >> 5, bh = b * 4 + h;
  constexpr int qcol0 = (MODE == 0) ? C_AQ : (MODE == 1) ? C_CQ : C_DQ, kcol0 = (MODE == 0) ? C_AK : (MODE == 1) ? C_CK : C_DK, ycol0 = (MODE == 0) ? 0 : (MODE == 1) ? 512 : 768;
  const bf16_t* Vt = ap.Vt + (size_t)((MODE == 0) ? 0 : (MODE == 1) ? 2 : 3) * T_ * 256;
  const size_t tokb = (size_t)b * SEQ;
  const int qpos = qb * 256 + wave * 32 + r32, cw = qb * 4 + (wave >> 1);
  bf16x8 qf[4];
  { const bf16_t* qp = ap.P + (tokb + qpos) * PLD + qcol0 + h * 64 + 8 * hi;
#pragma unroll
    for (int ks = 0; ks < 4; ++ks) qf[ks] = *(const bf16x8*)(qp + 16 * ks); }
  bf16_t* Ks0 = (bf16_t*)lds; bf16_t* Vs0 = Ks0 + NCH * 64 * 72; volatile int* flags = (volatile int*)(lds + 2 * NCH * 64 * 72 * 2);
  const int jhi = 4 * qb + 3, jlo = (MODE == 0) ? ((4 * qb - 8 > 0) ? 4 * qb - 8 : 0) : 0, ntiles = jhi - jlo + 1;
  const int lrow = tid >> 3, lch = tid & 7;
  const bf16_t* kg = ap.P + (tokb + lrow) * PLD + kcol0 + h * 64 + 8 * lch;
  const bf16_t* vg = Vt + (size_t)bh * 256 * 4096 + lrow * 64 + 8 * lch;
  const int j0 = (MODE == 2) ? jhi : jlo;
  u32x4 kreg[NCH], vreg[NCH];
#pragma unroll
  for (int c = 0; c < NCH; ++c) { const int jc = (MODE == 2) ? j0 - c : j0 + c; kreg[c] = *(const u32x4*)(kg + (size_t)jc * 64 * PLD); vreg[c] = *(const u32x4*)(vg + (size_t)jc * 4096); }
  f32x16 O0[2], O1[2]; float l0 = 0.f, l1 = 0.f, cum = 0.f;
#pragma unroll
  for (int eb = 0; eb < 2; ++eb) { O0[eb] = splat16(0.f); O1[eb] = splat16(0.f); }
  bool wdone = false;
  if (MODE == 2 && D_EARLY) { if (tid < 8) flags[tid] = 0; }
  for (int n = 0; n < ntiles; n += NCH) {
    const int jb = (MODE == 2) ? jhi - n : jlo + n;
    __syncthreads();
    if (MODE == 2 && D_EARLY) { int alld = 1;
#pragma unroll
      for (int w = 0; w < 8; ++w) alld &= flags[w];
      if (alld) break; }
#pragma unroll
    for (int c = 0; c < NCH; ++c) { *(u32x4*)(Ks0 + (c * 64 + lrow) * 72 + 8 * lch) = kreg[c]; *(u32x4*)(Vs0 + (c * 64 + lrow) * 72 + 8 * lch) = vreg[c]; }
    __syncthreads();
    if (n + NCH < ntiles) {
#pragma unroll
      for (int c = 0; c < NCH; ++c) { const int jn = (MODE == 2) ? jb - NCH - c : jb + NCH + c; kreg[c] = *(const u32x4*)(kg + (size_t)jn * 64 * PLD); vreg[c] = *(const u32x4*)(vg + (size_t)jn * 4096); } }
#pragma unroll
    for (int c = 0; c < NCH; ++c) {
    const int j = (MODE == 2) ? jb - c : jb + c;
    const bf16_t* Ks = Ks0 + c * 64 * 72; const bf16_t* Vs = Vs0 + c * 64 * 72;
    const bool active = (j <= cw) && (MODE != 0 || j >= cw - 8);
    if (!active) continue;
    if (MODE == 2 && D_EARLY && wdone) continue;
    if (MODE == 1) {
#pragma unroll
      for (int kh = 0; kh < 2; ++kh) {
        const bf16_t* kb = Ks + (32 * kh + r32) * 72 + 8 * hi;
        bf16x8 p0[2], p1[2];
        { f32x16 s0 = splat16(ap.negM);
          s0 = MFMA32(*(const bf16x8*)(kb), qf[0], s0); s0 = MFMA32(*(const bf16x8*)(kb + 16), qf[1], s0);
#pragma unroll
          for (int i = 0; i < 16; ++i) { s0[i] = ex2(s0[i]); l0 += s0[i]; }
          p0[0] = pack8(s0, 0); p0[1] = pack8(s0, 1); }
        { f32x16 s1 = splat16(ap.negM);
          s1 = MFMA32(*(const bf16x8*)(kb + 32), qf[2], s1); s1 = MFMA32(*(const bf16x8*)(kb + 48), qf[3], s1);
#pragma unroll
          for (int i = 0; i < 16; ++i) { s1[i] = ex2(s1[i]); l1 += s1[i]; }
          p1[0] = pack8(s1, 0); p1[1] = pack8(s1, 1); }
#pragma unroll
        for (int kk = 0; kk < 2; ++kk) {
#pragma unroll
          for (int eb = 0; eb < 2; ++eb) { const bf16_t* vb = Vs + (32 * eb + r32) * 72 + 32 * kh + 16 * kk + 8 * hi; const bf16x8 vf = *(const bf16x8*)vb;
            O0[eb] = MFMA32(vf, p0[kk], O0[eb]); O1[eb] = MFMA32(vf, p1[kk], O1[eb]); } }
      }
    } else if (MODE == 0) {
      const int dch = cw - j; const float binit = ap.negM + ((dch >= 3) ? ap.biasL[256] : 0.f);
#pragma unroll
      for (int kh = 0; kh < 2; ++kh) {
        const bf16_t* kb = Ks + (32 * kh + r32) * 72 + 8 * hi;
        f32x16 s0 = splat16(binit);
#pragma unroll
        for (int ks = 0; ks < 4; ++ks) s0 = MFMA32(*(const bf16x8*)(kb + 16 * ks), qf[ks], s0);
        if (dch < 3) {
#pragma unroll
          for (int i = 0; i < 16; ++i) { int rel = qpos - (64 * j + 32 * kh + crow(i, hi)); rel = rel > 128 ? 128 : (rel < -128 ? -128 : rel); s0[i] += ap.biasL[rel + 128]; } }
#pragma unroll
        for (int i = 0; i < 16; ++i) { s0[i] = ex2(s0[i]); l0 += s0[i]; }
#pragma unroll
        for (int kk = 0; kk < 2; ++kk) { const bf16x8 p0 = pack8(s0, kk);
#pragma unroll
          for (int eb = 0; eb < 2; ++eb) { const bf16_t* vb = Vs + (32 * eb + r32) * 72 + 32 * kh + 16 * kk + 8 * hi; const bf16x8 vf = *(const bf16x8*)vb;
            O0[eb] = MFMA32(vf, p0, O0[eb]); } }
      }
    } else {
      f32x16 z[2];
#pragma unroll
      for (int kh = 0; kh < 2; ++kh) { const bf16_t* kb = Ks + (32 * kh + r32) * 72 + 8 * hi; z[kh] = splat16(0.f);
#pragma unroll
        for (int ks = 0; ks < 4; ++ks) z[kh] = MFMA32(*(const bf16x8*)(kb + 16 * ks), qf[ks], z[kh]); }
      const bool diag = (j == cw); f32x16 sp[2]; float bs[8], ob[8];
#pragma unroll
      for (int kh = 0; kh < 2; ++kh)
#pragma unroll
        for (int g4 = 0; g4 < 4; ++g4) { float t = 0.f;
#pragma unroll
          for (int jj = 0; jj < 4; ++jj) { const int i = 4 * g4 + jj; const bool before = !diag || (64 * j + 32 * kh + crow(i, hi) < qpos);
            const float v = before ? lg2(1.0f + ex2(z[kh][i])) : 0.f; sp[kh][i] = v; t += v; }
          bs[4 * kh + g4] = t; }
#pragma unroll
      for (int p = 0; p < 8; ++p) ob[p] = __shfl_xor(bs[p], 32);
      float Rr = 0.f, saf[8];
#pragma unroll
      for (int p = 7; p >= 0; --p) { const float ev = hi ? ob[p] : bs[p], od = hi ? bs[p] : ob[p]; saf[p] = Rr + (hi ? 0.f : od); Rr += ev + od; }
#pragma unroll
      for (int kh = 0; kh < 2; ++kh)
#pragma unroll
        for (int g4 = 0; g4 < 4; ++g4) { float e = saf[4 * kh + g4];
#pragma unroll
          for (int jj = 3; jj >= 0; --jj) { const int i = 4 * g4 + jj; const bool before = !diag || (64 * j + 32 * kh + crow(i, hi) < qpos);
            const float a = before ? ex2(z[kh][i] - sp[kh][i] - e + cum) : 0.f; e += sp[kh][i]; z[kh][i] = a; } }
      cum -= Rr;
#pragma unroll
      for (int kh = 0; kh < 2; ++kh)
#pragma unroll
        for (int kk = 0; kk < 2; ++kk) { const bf16x8 p0 = pack8(z[kh], kk);
#pragma unroll
          for (int eb = 0; eb < 2; ++eb) { const bf16_t* vb = Vs + (32 * eb + r32) * 72 + 32 * kh + 16 * kk + 8 * hi; const bf16x8 vf = *(const bf16x8*)vb;
            O0[eb] = MFMA32(vf, p0, O0[eb]); } }
      if (D_EARLY) { const int done = __all(cum <= -151.0f); if (lane == 0) flags[wave] = done; wdone = (done != 0); }
    }
    }
  }
  bf16_t* yo = ap.Y + (tokb + qpos) * DM + ycol0 + h * 64;
  if (MODE == 0) { l0 += __shfl_xor(l0, 32); const float inv = 1.0f / l0;
#pragma unroll
    for (int eb = 0; eb < 2; ++eb)
#pragma unroll
      for (int i = 0; i < 16; ++i) O0[eb][i] *= inv;
  } else if (MODE == 1) { l0 += __shfl_xor(l0, 32); l1 += __shfl_xor(l1, 32); const float i0 = 1.0f / l0, i1 = ap.lam / l1; float ss = 0.f;
#pragma unroll
    for (int eb = 0; eb < 2; ++eb)
#pragma unroll
      for (int i = 0; i < 16; ++i) { const float o = O0[eb][i] * i0 - O1[eb][i] * i1; O0[eb][i] = o; ss += o * o; }
    ss += __shfl_xor(ss, 32); const float rstd = rsqrtf(ss * (1.f / 64.f) + EPS_) * ap.oscale;
#pragma unroll
    for (int eb = 0; eb < 2; ++eb)
#pragma unroll
      for (int i = 0; i < 16; ++i) O0[eb][i] *= rstd * ap.cgain[32 * eb + crow(i, hi)];
  }
#pragma unroll
  for (int eb = 0; eb < 2; ++eb)
#pragma unroll
    for (int g4 = 0; g4 < 4; ++g4) { u32x2 ow; ow.x = pk2(O0[eb][4 * g4], O0[eb][4 * g4 + 1]); ow.y = pk2(O0[eb][4 * g4 + 2], O0[eb][4 * g4 + 3]); *(u32x2*)(yo + 32 * eb + 8 * g4 + 4 * hi) = ow; }
}

struct MixParams { AttnParams ap; float* DC; float* SC; const float* relb; const float *aqg, *akg, *cqg, *ckg, *clam, *cog; float lam_init; unsigned* ctr; };
DI void mix_phase(unsigned char* lds, const MixParams& mp, int tid) {
  LAUNDER(tid);
  volatile int* misc = (volatile int*)(lds + pg8::STAGE_BYTES);
  float* biasT = (float*)(lds + 81920);
  float* red = (float*)(lds + 81920 + 4 * 260 * 4);
  for (int i = tid; i < 4 * 257; i += 512) biasT[(i / 257) * 260 + (i % 257)] = mp.relb[i] * LOG2E;
  if (tid < 64) {
    const int lane = tid;
    const float aq = wave_max(fabsf(mp.aqg[lane])), ak = wave_max(fabsf(mp.akg[lane]));
    const float cq = wave_max(fabsf(mp.cqg[lane & 31])), ck = wave_max(fabsf(mp.ckg[lane & 31]));
    const float d1 = wave_sum(lane < 32 ? mp.clam[lane] * mp.clam[32 + lane] : 0.f), d2 = wave_sum(lane < 32 ? mp.clam[64 + lane] * mp.clam[96 + lane] : 0.f);
    if (lane == 0) { red[0] = 8.0f * aq * ak * LOG2E * 1.02f; red[1] = 5.656854249f * cq * ck * LOG2E * 1.02f; red[2] = fexp(d1) - fexp(d2) + mp.lam_init; }
  }
  __syncthreads();
  if (tid < 4) { float m = -1e30f; for (int i = 0; i < 257; ++i) m = fmaxf(m, biasT[tid * 260 + i]); red[4 + tid] = m; }
  __syncthreads();
  const float MA = red[0], MC = red[1], lam = red[2];
  AttnParams ap = mp.ap;
  for (;;) {
    __syncthreads();
    if (tid == 0) misc[0] = (int)atomicAdd(mp.ctr, 1u);
    __syncthreads();
    const int it = misc[0];
    constexpr int NB2 = 17;
    if (it >= NB2 + 3 * 512) break;
    if (it < NB2) { b2_item(mp.DC, mp.SC, it, lds, tid); continue; }
    const int r = (it - NB2) & 511, kind = (it - NB2) >> 9, qb = 63 - (r >> 3), bh = r & 7, b = bh >> 2, h = bh & 3;
    if (kind == 0) { ap.negM = -MC; ap.lam = lam; ap.oscale = 1.0f - mp.lam_init; ap.cgain = mp.cog; attn_unit<1>(lds, ap, b, h, qb, tid); }
    else if (kind == 1) { attn_unit<2>(lds, ap, b, h, qb, tid); }
    else { ap.negM = -(MA + red[4 + h]); ap.biasL = biasT + h * 260; attn_unit<0>(lds, ap, b, h, qb, tid); }
  }
}

DI const float* ldp(const unsigned char* lds, int i) {
  const volatile unsigned* t = (const volatile unsigned*)(lds + pg8::STAGE_BYTES + 64);
  const unsigned lo = __builtin_amdgcn_readfirstlane(t[2 * i]), hi = __builtin_amdgcn_readfirstlane(t[2 * i + 1]);
  return (const float*)(((unsigned long long)hi << 32) | lo); }
DI int fresh_tid(int wave_s) { int lane; asm volatile("v_mbcnt_lo_u32_b32 %0, -1, 0\n\tv_mbcnt_hi_u32_b32 %0, -1, %0" : "=v"(lane)); return wave_s * 64 + lane; }

DI void gbar(unsigned* bw, unsigned& k, int tid) {
  ++k;
  asm volatile("s_waitcnt vmcnt(0)" ::: "memory");
  __syncthreads();
  if (tid == 0) {
    __builtin_amdgcn_fence(__ATOMIC_RELEASE, "agent");
    const unsigned G = gridDim.x, x = blockIdx.x & 7u, nloc = (G - x + 7u) >> 3, ngrp = G < 8u ? G : 8u;
    unsigned* xcnt = bw + 64 * x; unsigned* xgen = bw + 64 * (8 + x); unsigned* top = bw + 64 * 16; unsigned* topgen = bw + 64 * 17;
    const unsigned old = __hip_atomic_fetch_add(xcnt, 1u, __ATOMIC_RELAXED, __HIP_MEMORY_SCOPE_AGENT);
    if (old + 1u == k * nloc) {
      const unsigned o2 = __hip_atomic_fetch_add(top, 1u, __ATOMIC_RELAXED, __HIP_MEMORY_SCOPE_AGENT);
      if (o2 + 1u == k * ngrp) __hip_atomic_store(topgen, k, __ATOMIC_RELAXED, __HIP_MEMORY_SCOPE_AGENT);
      else while (__hip_atomic_load(topgen, __ATOMIC_RELAXED, __HIP_MEMORY_SCOPE_AGENT) < k) __builtin_amdgcn_s_sleep(1);
      __hip_atomic_store(xgen, k, __ATOMIC_RELAXED, __HIP_MEMORY_SCOPE_AGENT);
    } else {
      while (__hip_atomic_load(xgen, __ATOMIC_RELAXED, __HIP_MEMORY_SCOPE_AGENT) < k) __builtin_amdgcn_s_sleep(1);
    }
    __builtin_amdgcn_fence(__ATOMIC_ACQUIRE, "agent");
  }
  __syncthreads();
}
#define WSP(off) ((unsigned char*)ldp(lds, 24) + (off))
__global__ void __launch_bounds__(512) fwd_kernel(Args a) {
  extern __shared__ __attribute__((aligned(16))) unsigned char lds[];
  cg::grid_group grid = cg::this_grid();
  const int wave_s = __builtin_amdgcn_readfirstlane(threadIdx.x >> 6);
  if (threadIdx.x == 0) {
    const float** t = (const float**)(lds + pg8::STAGE_BYTES + 64);
#pragma unroll
    for (int i = 0; i < 23; ++i) t[i] = a.in[i];
    t[23] = a.out; t[24] = (const float*)a.ws;
  }
  if (blockIdx.x == 0) { unsigned* ctl = (unsigned*)(a.ws + WS_CTL); for (int i = threadIdx.x; i < 2048; i += 512) ctl[i] = 0u; }
  __syncthreads();
  unsigned bk = 0u;
  PG8_LAS unsigned char* ldsL = (PG8_LAS unsigned char*)lds;
  typedef pg8::StaticOrder SO;

  { Args a2;
#pragma unroll
    for (int i = 0; i < 23; ++i) a2.in[i] = ldp(lds, i);
    a2.out = nullptr; a2.ws = WSP(0);
    prologue_weights(a2, lds, fresh_tid(wave_s)); }
  cast_phase(ldp(lds, 0), (bf16_t*)WSP(WS_XN), (float*)WSP(WS_SS), fresh_tid(wave_s));
  grid.sync();
  for (int l = 0; l < NLAYER; ++l) {
    const size_t wlo = WS_W + (size_t)l * LW_SIZE;
    { const float* xin = (l == 0) ? ldp(lds, 0) : ldp(lds, 23); (void)xin;
      pg8::Gemm g{(bf16_t*)WSP(WS_XN), (const bf16_t*)WSP(wlo + LW_WGU1), T_, 2 * FF, DM}; SO S; S.init(T_, 2 * FF, gridDim.x, blockIdx.x); pg8::EpiSwiGLU E{(bf16_t*)WSP(WS_HP), FF, (const float*)WSP(WS_SS) + (size_t)(3 * l) * T_};
      pg8::gemm_phase<pg8::EpiSwiGLU, SO, true, true>(ldsL, g, S, E, fresh_tid(wave_s)); }
    gbar((unsigned*)WSP(WS_CTL) + 64, bk, fresh_tid(wave_s));
    { const float* xin = (l == 0) ? ldp(lds, 0) : ldp(lds, 23);
      pg8::Gemm g{(bf16_t*)WSP(WS_HP), (const bf16_t*)WSP(wlo + LW_WD1), T_, DM, FF}; SO S; S.init(T_, DM, gridDim.x, blockIdx.x); pg8::EpiResid E{xin, (float*)ldp(lds, 23), DM, 0.5f, (bf16_t*)WSP(WS_XN), (float*)WSP(WS_SS) + (size_t)(3 * l + 1) * T_};
      pg8::gemm_phase<pg8::EpiResid, SO, true, true>(ldsL, g, S, E, fresh_tid(wave_s)); }
    gbar((unsigned*)WSP(WS_CTL) + 64, bk, fresh_tid(wave_s));
    { pg8::Gemm g{(bf16_t*)WSP(WS_XN), (const bf16_t*)WSP(wlo + LW_WIN), T_, INP, DM}; SO S; S.init(T_, INP, gridDim.x, blockIdx.x); pg8::EpiBf16Lim E{(bf16_t*)WSP(WS_HP), PLD, PLD, (const float*)WSP(WS_SS) + (size_t)(3 * l + 1) * T_};
      pg8::gemm_phase<pg8::EpiBf16Lim, SO, true, true>(ldsL, g, S, E, fresh_tid(wave_s)); }
    gbar((unsigned*)WSP(WS_CTL) + 64, bk, fresh_tid(wave_s));
    { PrepParams pp{ldp(lds, 7) + l * 64, ldp(lds, 8) + l * 64, ldp(lds, 14) + l * 32, ldp(lds, 15) + l * 32, ldp(lds, 10) + l * 2048, ldp(lds, 11) + l * 512};
      prep_phase((bf16_t*)WSP(WS_HP), (bf16_t*)WSP(WS_BQ), (bf16_t*)WSP(WS_BK), (bf16_t*)WSP(WS_BKT), (bf16_t*)WSP(WS_VT), pp, lds, fresh_tid(wave_s)); }
    gbar((unsigned*)WSP(WS_CTL) + 64, bk, fresh_tid(wave_s));
    b1_phase((bf16_t*)WSP(WS_HP), (bf16_t*)WSP(WS_BKT), (bf16_t*)WSP(WS_VT) + (size_t)T_ * 256, (float*)WSP(WS_DC), (float*)WSP(WS_SC), ldp(lds, 12) + l * 8, lds, fresh_tid(wave_s));
    gbar((unsigned*)WSP(WS_CTL) + 64, bk, fresh_tid(wave_s));
    { const float lam_init = (l == 0) ? 0.2f : (0.8f - 0.6f * 0.7408182206817179f);
      MixParams mp; mp.ap.P = (bf16_t*)WSP(WS_HP); mp.ap.Vt = (bf16_t*)WSP(WS_VT); mp.ap.Y = (bf16_t*)WSP(WS_XN); mp.ap.biasL = nullptr; mp.ap.negM = 0.f; mp.ap.lam = 0.f; mp.ap.oscale = 1.f; mp.ap.cgain = nullptr;
      mp.DC = (float*)WSP(WS_DC); mp.SC = (float*)WSP(WS_SC); mp.relb = ldp(lds, 9) + l * 4 * 257; mp.aqg = ldp(lds, 7) + l * 64; mp.akg = ldp(lds, 8) + l * 64; mp.cqg = ldp(lds, 14) + l * 32; mp.ckg = ldp(lds, 15) + l * 32;
      mp.clam = ldp(lds, 16) + l * 128; mp.cog = ldp(lds, 17) + l * 64; mp.lam_init = lam_init; mp.ctr = (unsigned*)WSP(WS_CTL) + l;
      mix_phase(lds, mp, fresh_tid(wave_s)); }
    gbar((unsigned*)WSP(WS_CTL) + 64, bk, fresh_tid(wave_s));
    b3_phase((bf16_t*)WSP(WS_HP), (bf16_t*)WSP(WS_BQ), (bf16_t*)WSP(WS_BK), (bf16_t*)WSP(WS_VT) + (size_t)T_ * 256, (float*)WSP(WS_DC), (float*)WSP(WS_SC), ldp(lds, 12) + l * 8, ldp(lds, 13) + l * 256, (bf16_t*)WSP(WS_XN), lds, fresh_tid(wave_s));
    gbar((unsigned*)WSP(WS_CTL) + 64, bk, fresh_tid(wave_s));
    { float* xo = (float*)ldp(lds, 23);
      pg8::Gemm g{(bf16_t*)WSP(WS_XN), (const bf16_t*)WSP(wlo + LW_WOUT), T_, DM, DM}; SO S; S.init(T_, DM, gridDim.x, blockIdx.x); pg8::EpiResid E{xo, xo, DM, 1.0f, (bf16_t*)WSP(WS_BQ), (float*)WSP(WS_SS) + (size_t)(3 * l + 2) * T_};
      pg8::gemm_phase<pg8::EpiResid, SO, true, true>(ldsL, g, S, E, fresh_tid(wave_s)); }
    gbar((unsigned*)WSP(WS_CTL) + 64, bk, fresh_tid(wave_s));
    { pg8::Gemm g{(bf16_t*)WSP(WS_BQ), (const bf16_t*)WSP(wlo + LW_WGU2), T_, 2 * FF, DM}; SO S; S.init(T_, 2 * FF, gridDim.x, blockIdx.x); pg8::EpiSwiGLU E{(bf16_t*)WSP(WS_HP), FF, (const float*)WSP(WS_SS) + (size_t)(3 * l + 2) * T_};
      pg8::gemm_phase<pg8::EpiSwiGLU, SO, true, true>(ldsL, g, S, E, fresh_tid(wave_s)); }
    gbar((unsigned*)WSP(WS_CTL) + 64, bk, fresh_tid(wave_s));
    { float* xo = (float*)ldp(lds, 23);
      pg8::Gemm g{(bf16_t*)WSP(WS_HP), (const bf16_t*)WSP(wlo + LW_WD2), T_, DM, FF}; SO S; S.init(T_, DM, gridDim.x, blockIdx.x); pg8::EpiResid E{xo, xo, DM, 0.5f, (l + 1 < NLAYER) ? (bf16_t*)WSP(WS_XN) : nullptr, (float*)WSP(WS_SS) + (size_t)(3 * l + 3) * T_};
      pg8::gemm_phase<pg8::EpiResid, SO, true, true>(ldsL, g, S, E, fresh_tid(wave_s)); }
    if (l + 1 < NLAYER) gbar((unsigned*)WSP(WS_CTL) + 64, bk, fresh_tid(wave_s));
  }
}

extern "C" void kernel_launch(void* const* d_in, const int* in_sizes, int n_in, void* d_out, int out_size, void* d_ws, size_t ws_size, hipStream_t stream) {
  static int grid = 0;
  if (grid == 0) {
    if (n_in != 23 || out_size != T_ * DM || ws_size < WS_END) { fprintf(stderr, "kernel_launch: unexpected problem (n_in %d out %d ws %zu need %zu)\n", n_in, out_size, ws_size, (size_t)WS_END); grid = -1; return; }
    int dev = 0, cus = 0, per_cu = 0;
    hipGetDevice(&dev); hipDeviceGetAttribute(&cus, hipDeviceAttributeMultiprocessorCount, dev);
    if (hipFuncSetAttribute((const void*)fwd_kernel, hipFuncAttributeMaxDynamicSharedMemorySize, LDS_BYTES) != hipSuccess) fprintf(stderr, "kernel_launch: hipFuncSetAttribute failed\n");
    if (hipOccupancyMaxActiveBlocksPerMultiprocessor(&per_cu, (const void*)fwd_kernel, 512, LDS_BYTES) != hipSuccess || per_cu < 1) { fprintf(stderr, "kernel_launch: occupancy query gave %d\n", per_cu); per_cu = 1; }
    (void)hipGetLastError();
    grid = cus * per_cu;
  }
  if (grid < 0) return;
  Args a{};
  for (int i = 0; i < 23; ++i) a.in[i] = (const float*)d_in[i];
  a.out = (float*)d_out; a.ws = (unsigned char*)d_ws;
  void* args[] = {&a};
  hipError_t e = hipLaunchCooperativeKernel((const void*)fwd_kernel, dim3(grid), dim3(512), args, LDS_BYTES, stream);
  if (e != hipSuccess) fprintf(stderr, "cooperative launch failed: %s (grid %d)\n", hipGetErrorString(e), grid);
}
```

```cpp
#include <hip/hip_runtime.h>
#include <hip/hip_cooperative_groups.h>
#include <cstdio>
#include <cstdint>
namespace cg = cooperative_groups;

namespace pg8 {
#define PG8_LAS __attribute__((address_space(3)))
typedef unsigned short bf16_t;
typedef short bf16x8 __attribute__((ext_vector_type(8)));
typedef float f32x4 __attribute__((ext_vector_type(4)));
typedef unsigned u32x4 __attribute__((ext_vector_type(4)));
constexpr int BM = 256, BK = 64, HALF = 128, HTB = HALF * BK * 2  , STAGE_BYTES = 8 * HTB, NXCD = 8, WGM = 4;

__host__ __device__ __forceinline__ int lds_byte(int r, int c) { const int st = (r >> 4) * 2 + (c >> 5), rr = r & 15, cc = c & 31, ob = rr * 64 + cc * 2; return st * 1024 + (ob ^ (((ob >> 9) & 1) << 5)); }
__host__ __device__ __forceinline__ void stage_rc(int b, int& R, int& C) { const int st = b / 1024, sb = b % 1024, swz = sb ^ (((sb >> 9) & 1) << 5); R = (st >> 1) * 16 + swz / 64; C = (st & 1) * 32 + (swz % 64) / 2; }
__host__ __device__ __forceinline__ int perm32(int rho) { const int n = rho >> 4, i = rho & 15; return 8 * (i >> 2) + 4 * n + (i & 3); }

struct Unit { int pm, pn; };
struct Gemm { const bf16_t* A; const bf16_t* Bt; int M, N, K; };

struct StaticOrder {
    int nM, nN, nwg, G, c;
    __host__ __device__ void init(int M, int N, int G_, int c_) { nM = M / BM; nN = N / BM; nwg = nM * nN; G = G_; c = c_; }
    __host__ __device__ bool next(int i, Unit& u) const {
        const long L = (long)i * G + c; if (L >= nwg) return false;
        int wgid = (int)L; { const int q = nwg / NXCD, r = nwg % NXCD, xcd = wgid % NXCD, off = wgid / NXCD; wgid = (xcd < r ? xcd * (q + 1) : r * (q + 1) + (xcd - r) * q) + off; }
        const int nig = WGM * nN, gid = wgid / nig, fm = gid * WGM, gsz = (nM - fm) < WGM ? (nM - fm) : WGM;
        u.pm = fm + ((wgid % nig) % gsz); u.pn = (wgid % nig) / gsz; return true;
    }
    __device__ __forceinline__ void a_ready(const Unit&) const {}
    __device__ __forceinline__ void done(const Unit&) const {}
};


typedef float f32x2_t __attribute__((ext_vector_type(2))); typedef __bf16 bf16x2_t __attribute__((ext_vector_type(2)));
__device__ __forceinline__ unsigned cvt_pk_bf16(float lo, float hi) { f32x2_t v = {lo, hi}; bf16x2_t b = __builtin_convertvector(v, bf16x2_t); return __builtin_bit_cast(unsigned, b); }
__device__ __forceinline__ float silu_f(float x) { return x * __builtin_amdgcn_rcpf(1.0f + __builtin_amdgcn_exp2f(-1.4426950408889634f * x)); }

struct EpiBf16Lim {
    static constexpr bool PERM = true, AFTER_DRAIN = false;
    bf16_t* O; int ldc; int ncols; const float* ss;
    __device__ __forceinline__ void operator()(const f32x4 (&acc)[2][2][4][2], const Unit& u, int wr, int wc, int fr, int fq) const {
        const int row0 = u.pm * BM + wr * 64 + fr; const int col0 = u.pn * BM + wc * 32 + 8 * fq;
        float rsv[2][4];
#pragma unroll
        for (int ai = 0; ai < 2; ++ai)
#pragma unroll
            for (int m = 0; m < 4; ++m) rsv[ai][m] = ss[row0 + ai * HALF + m * 16];
#pragma unroll
        for (int ai = 0; ai < 2; ++ai)
#pragma unroll
            for (int m = 0; m < 4; ++m) { bf16_t* rowp = O + (size_t)(row0 + ai * HALF + m * 16) * ldc + col0;
                const float rs = __builtin_amdgcn_rsqf(rsv[ai][m] * (1.0f / 1024.0f) + 1e-6f);
#pragma unroll
                for (int bj = 0; bj < 2; ++bj) { const f32x4 v0 = acc[ai][bj][m][0] * rs, v1 = acc[ai][bj][m][1] * rs;
                    u32x4 w; w.x = cvt_pk_bf16(v0[0], v0[1]); w.y = cvt_pk_bf16(v0[2], v0[3]); w.z = cvt_pk_bf16(v1[0], v1[1]); w.w = cvt_pk_bf16(v1[2], v1[3]);
                    if (col0 + bj * HALF < ncols) *(u32x4*)(rowp + bj * HALF) = w; } }
    }
};
struct EpiSwiGLU {
    static constexpr bool PERM = true, AFTER_DRAIN = false;
    bf16_t* O; int ldc; const float* ss;
    __device__ __forceinline__ void operator()(const f32x4 (&acc)[2][2][4][2], const Unit& u, int wr, int wc, int fr, int fq) const {
        const int row0 = u.pm * BM + wr * 64 + fr; const int col0 = u.pn * HALF + wc * 32 + 8 * fq;
        float rsv[2][4];
#pragma unroll
        for (int ai = 0; ai < 2; ++ai)
#pragma unroll
            for (int m = 0; m < 4; ++m) rsv[ai][m] = ss[row0 + ai * HALF + m * 16];
#pragma unroll
        for (int ai = 0; ai < 2; ++ai)
#pragma unroll
            for (int m = 0; m < 4; ++m) { bf16_t* rowp = O + (size_t)(row0 + ai * HALF + m * 16) * ldc + col0;
                const float rs = __builtin_amdgcn_rsqf(rsv[ai][m] * (1.0f / 1024.0f) + 1e-6f);
                const f32x4 g0 = acc[ai][0][m][0] * rs, g1 = acc[ai][0][m][1] * rs, u0 = acc[ai][1][m][0] * rs, u1 = acc[ai][1][m][1] * rs;
                u32x4 w;
                w.x = cvt_pk_bf16(silu_f(g0[0]) * u0[0], silu_f(g0[1]) * u0[1]); w.y = cvt_pk_bf16(silu_f(g0[2]) * u0[2], silu_f(g0[3]) * u0[3]);
                w.z = cvt_pk_bf16(silu_f(g1[0]) * u1[0], silu_f(g1[1]) * u1[1]); w.w = cvt_pk_bf16(silu_f(g1[2]) * u1[2], silu_f(g1[3]) * u1[3]);
                *(u32x4*)rowp = w; }
    }
};
typedef unsigned u32x2v __attribute__((ext_vector_type(2)));
struct EpiResid {
    static constexpr bool PERM = true, AFTER_DRAIN = false;
    const float* base; float* out; int ldc; float alpha; bf16_t* xb; float* ss;
    __device__ __forceinline__ void operator()(const f32x4 (&acc)[2][2][4][2], const Unit& u, int wr, int wc, int fr, int fq) const {
        const int row0 = u.pm * BM + wr * 64 + fr; const int col0 = u.pn * BM + wc * 32 + 8 * fq;
#pragma unroll
        for (int ai = 0; ai < 2; ++ai) {
            f32x4 pre[4][2][2];
#pragma unroll
            for (int m = 0; m < 4; ++m) { const size_t off = (size_t)(row0 + ai * HALF + m * 16) * ldc + col0;
#pragma unroll
                for (int bj = 0; bj < 2; ++bj)
#pragma unroll
                    for (int n = 0; n < 2; ++n) pre[m][bj][n] = *(const f32x4*)(base + off + bj * HALF + n * 4); }
#pragma unroll
            for (int m = 0; m < 4; ++m) { const size_t off = (size_t)(row0 + ai * HALF + m * 16) * ldc + col0; float q = 0.f;
#pragma unroll
                for (int bj = 0; bj < 2; ++bj) { const f32x4 o0 = pre[m][bj][0] + acc[ai][bj][m][0] * alpha, o1 = pre[m][bj][1] + acc[ai][bj][m][1] * alpha;
                    *(f32x4*)(out + off + bj * HALF) = o0; *(f32x4*)(out + off + bj * HALF + 4) = o1;
                    if (xb) { q += ((o0[0] * o0[0] + o0[1] * o0[1]) + (o0[2] * o0[2] + o0[3] * o0[3])) + ((o1[0] * o1[0] + o1[1] * o1[1]) + (o1[2] * o1[2] + o1[3] * o1[3]));
                        u32x4 w; w.x = cvt_pk_bf16(o0[0], o0[1]); w.y = cvt_pk_bf16(o0[2], o0[3]); w.z = cvt_pk_bf16(o1[0], o1[1]); w.w = cvt_pk_bf16(o1[2], o1[3]); *(u32x4*)(xb + off + bj * HALF) = w; } }
                if (xb) { q += __shfl_xor(q, 16); q += __shfl_xor(q, 32); if (fq == 0) atomicAdd(ss + row0 + ai * HALF + m * 16, q); } }
        }
    }
};

template <class Epi, class Sched, bool ALIGN_EPI = false, bool SP2 = false>
__device__ __forceinline__ void gemm_phase(PG8_LAS unsigned char* lds, const Gemm g, const Sched& S, const Epi& E, int tid_in) {
    int tid_l = tid_in; asm volatile("" : "+v"(tid_l)); const int tid = tid_l, wid = __builtin_amdgcn_readfirstlane(tid >> 6), lane = tid & 63, wr = wid >> 2, wc = wid & 3, fr = lane & 15, fq = lane >> 4;
    const int K = g.K, nt = K / BK;
    unsigned voffA[2], voffB[2];
#pragma unroll
    for (int i = 0; i < 2; ++i) { int R, C; stage_rc(tid * 16 + i * 8192, R, C); const int Rb = Epi::PERM ? ((R & ~31) + perm32(R & 31)) : R;
        voffA[i] = (unsigned)(R * K + C) * 2u; voffB[i] = (unsigned)(Rb * K + C) * 2u; }
    const size_t kstep = (size_t)(BK * 2);
    const size_t hstep = (size_t)HALF * K * 2;
    const size_t tstep = 2 * hstep;
    const unsigned ldsw = (unsigned)wid * 1024u;
    const int aoff = lds_byte(wr * 64 + fr, fq * 8), boff = lds_byte(wc * 32 + fr, fq * 8);
#define PG8_SA(b, h) (((b) * 2 + (h)) * HTB)
#define PG8_SB(b, h) ((4 + (b) * 2 + (h)) * HTB)
#define PG8_STAGE(bufoff, gbase, voff) do { _Pragma("unroll") for (int _i = 0; _i < 2; ++_i) \
        __builtin_amdgcn_global_load_lds((const unsigned*)((const char*)(gbase) + (voff)[_i]), (PG8_LAS unsigned*)(lds + (bufoff) + ldsw + _i * 8192), 16, 0, 0); } while (0)
#define PG8_LDA(dst, b, h) do { _Pragma("unroll") for (int m = 0; m < 4; ++m) _Pragma("unroll") for (int k = 0; k < 2; ++k) dst[m][k] = *(const PG8_LAS bf16x8*)(lds + PG8_SA(b, h) + aoff + m * 2048 + k * 1024); } while (0)
#define PG8_LDB(dst, b, h) do { _Pragma("unroll") for (int n = 0; n < 2; ++n) _Pragma("unroll") for (int k = 0; k < 2; ++k) dst[n][k] = *(const PG8_LAS bf16x8*)(lds + PG8_SB(b, h) + boff + n * 2048 + k * 1024); } while (0)
#define PG8_MMA(ai, bj, At, Bt) do { __builtin_amdgcn_s_setprio(1); _Pragma("unroll") for (int m = 0; m < 4; ++m) _Pragma("unroll") for (int n = 0; n < 2; ++n) _Pragma("unroll") for (int k = 0; k < 2; ++k) \
        acc[ai][bj][m][n] = __builtin_amdgcn_mfma_f32_16x16x32_bf16(Bt[n][k], At[m][k], acc[ai][bj][m][n], 0, 0, 0); __builtin_amdgcn_s_setprio(0); } while (0)
#define PG8_WAIT_V(n) asm volatile("s_waitcnt vmcnt(" #n ")" ::: "memory")
#define PG8_WAIT_L(n) asm volatile("s_waitcnt lgkmcnt(" #n ")" ::: "memory")
#define PG8_BAR __builtin_amdgcn_s_barrier()
#define PG8_SCHED __builtin_amdgcn_sched_barrier(0)
    Unit cur, nxt; int ui = 0;
    if (!S.next(0, cur)) return;
    f32x4 acc[2][2][4][2];
#pragma unroll
    for (int a = 0; a < 2; ++a)
#pragma unroll
        for (int b = 0; b < 2; ++b)
#pragma unroll
            for (int m = 0; m < 4; ++m)
#pragma unroll
                for (int n = 0; n < 2; ++n) acc[a][b][m][n] = (f32x4){0.f, 0.f, 0.f, 0.f};
    bf16x8 At[4][2], B0[2][2], B1[2][2];
    const char* cA = (const char*)g.A + (size_t)cur.pm * tstep; const char* cB = (const char*)g.Bt + (size_t)cur.pn * tstep;
    S.a_ready(cur);
    if constexpr (SP2) {
        PG8_STAGE(PG8_SB(0, 0), cB, voffB); PG8_STAGE(PG8_SB(0, 1), cB + hstep, voffB); PG8_STAGE(PG8_SA(0, 0), cA, voffA); PG8_STAGE(PG8_SA(0, 1), cA + hstep, voffA);
        if (wr == 1) PG8_BAR;
        PG8_WAIT_V(2); PG8_BAR;
        PG8_STAGE(PG8_SB(1, 0), cB + kstep, voffB); PG8_STAGE(PG8_SA(1, 0), cA + kstep, voffA); PG8_STAGE(PG8_SB(1, 1), cB + hstep + kstep, voffB);
        PG8_WAIT_V(6); PG8_BAR;
    } else {
        PG8_STAGE(PG8_SB(0, 0), cB, voffB); PG8_STAGE(PG8_SA(0, 0), cA, voffA); PG8_STAGE(PG8_SB(0, 1), cB + hstep, voffB); PG8_STAGE(PG8_SA(0, 1), cA + hstep, voffA);
        if (wr == 1) PG8_BAR;
        PG8_WAIT_V(4); PG8_BAR;
        PG8_STAGE(PG8_SB(1, 0), cB + kstep, voffB); PG8_STAGE(PG8_SA(1, 0), cA + kstep, voffA); PG8_STAGE(PG8_SB(1, 1), cB + hstep + kstep, voffB);
        PG8_WAIT_V(6); PG8_BAR;
    }
    for (;;) {
        const bool has_next = S.next(ui + 1, nxt);
        const char* nA = has_next ? (const char*)g.A + (size_t)nxt.pm * tstep : cA; const char* nB = has_next ? (const char*)g.Bt + (size_t)nxt.pn * tstep : cB;
        for (int t = 0; t < nt; t += 2) {
            const bool last = (t == nt - 2);
            const char* a1 = cA + (size_t)(t + 1) * kstep;
            const char* a2 = last ? nA : cA + (size_t)(t + 2) * kstep; const char* b2 = last ? nB : cB + (size_t)(t + 2) * kstep;
            const char* a3 = a2 + kstep; const char* b3 = b2 + kstep;
            if (last && has_next) S.a_ready(nxt);
            if constexpr (SP2) {
            PG8_LDB(B0, 0, 0); PG8_LDB(B1, 0, 1); PG8_SCHED; PG8_LDA(At, 0, 0); PG8_STAGE(PG8_SA(1, 1), a1 + hstep, voffA);
            PG8_WAIT_V(8); PG8_WAIT_L(0); PG8_BAR; PG8_MMA(0, 0, At, B0); PG8_MMA(0, 1, At, B1); PG8_BAR; PG8_SCHED;
            PG8_LDA(At, 0, 1); PG8_STAGE(PG8_SB(0, 0), b2, voffB); PG8_STAGE(PG8_SB(0, 1), b2 + hstep, voffB); PG8_STAGE(PG8_SA(0, 0), a2, voffA);
            PG8_WAIT_V(8); PG8_WAIT_L(0); PG8_BAR; PG8_MMA(1, 0, At, B0); PG8_MMA(1, 1, At, B1); PG8_BAR; PG8_SCHED;
            PG8_LDB(B0, 1, 0); PG8_LDB(B1, 1, 1); PG8_SCHED; PG8_LDA(At, 1, 0); PG8_STAGE(PG8_SA(0, 1), a2 + hstep, voffA);
            PG8_WAIT_V(8); PG8_WAIT_L(0); PG8_BAR; PG8_MMA(0, 0, At, B0); PG8_MMA(0, 1, At, B1); PG8_BAR; PG8_SCHED;
            PG8_LDA(At, 1, 1); PG8_STAGE(PG8_SB(1, 0), b3, voffB); PG8_STAGE(PG8_SB(1, 1), b3 + hstep, voffB); PG8_STAGE(PG8_SA(1, 0), a3, voffA);
            PG8_WAIT_V(8); PG8_WAIT_L(0); PG8_BAR; PG8_MMA(1, 0, At, B0); PG8_MMA(1, 1, At, B1); PG8_BAR; PG8_SCHED;
            } else {
            PG8_LDB(B0, 0, 0); PG8_SCHED; PG8_LDA(At, 0, 0); PG8_STAGE(PG8_SA(1, 1), a1 + hstep, voffA);
            PG8_WAIT_L(8); PG8_BAR; PG8_WAIT_L(0); PG8_MMA(0, 0, At, B0); PG8_BAR; PG8_SCHED;
            PG8_LDB(B1, 0, 1); PG8_STAGE(PG8_SB(0, 0), b2, voffB);
            PG8_BAR; PG8_WAIT_L(0); PG8_MMA(0, 1, At, B1); PG8_BAR;
            PG8_LDA(At, 0, 1); PG8_STAGE(PG8_SA(0, 0), a2, voffA);
            PG8_BAR; PG8_WAIT_L(0); PG8_MMA(1, 0, At, B0); PG8_BAR; PG8_SCHED;
            PG8_STAGE(PG8_SB(0, 1), b2 + hstep, voffB);
            PG8_WAIT_V(6); PG8_BAR; PG8_MMA(1, 1, At, B1); PG8_BAR;
            PG8_LDB(B0, 1, 0); PG8_SCHED; PG8_LDA(At, 1, 0); PG8_STAGE(PG8_SA(0, 1), a2 + hstep, voffA);
            PG8_WAIT_L(8); PG8_BAR; PG8_WAIT_L(0); PG8_MMA(0, 0, At, B0); PG8_BAR; PG8_SCHED;
            PG8_LDB(B1, 1, 1); PG8_STAGE(PG8_SB(1, 0), b3, voffB);
            PG8_BAR; PG8_WAIT_L(0); PG8_MMA(0, 1, At, B1); PG8_BAR;
            PG8_LDA(At, 1, 1); PG8_STAGE(PG8_SA(1, 0), a3, voffA);
            PG8_BAR; PG8_WAIT_L(0); PG8_MMA(1, 0, At, B0); PG8_BAR; PG8_SCHED;
            PG8_STAGE(PG8_SB(1, 1), b3 + hstep, voffB);
            PG8_WAIT_V(6); PG8_BAR; PG8_MMA(1, 1, At, B1); PG8_BAR;
            }
        }
        if constexpr (ALIGN_EPI) { if (wr == 0) PG8_BAR; }
        if constexpr (!Epi::AFTER_DRAIN) { E(acc, cur, wr, wc, fr, fq); S.done(cur); }
        if (!has_next) break;
#pragma unroll
        for (int a = 0; a < 2; ++a)
#pragma unroll
            for (int b = 0; b < 2; ++b)
#pragma unroll
                for (int m = 0; m < 4; ++m)
#pragma unroll
                    for (int n = 0; n < 2; ++n) acc[a][b][m][n] = (f32x4){0.f, 0.f, 0.f, 0.f};
        cur = nxt; cA = nA; cB = nB; ++ui;
        if constexpr (ALIGN_EPI) { if (wr == 1) PG8_BAR; }
    }
    PG8_WAIT_V(0);
    if constexpr (!ALIGN_EPI) { if (wr == 0) PG8_BAR; }
    PG8_BAR;
    if constexpr (Epi::AFTER_DRAIN) { E.fused(acc, cur, wr, wc, fr, fq, lds, wid, lane); S.done(cur); }
#undef PG8_SA
#undef PG8_SB
#undef PG8_STAGE
#undef PG8_LDA
#undef PG8_LDB
#undef PG8_MMA
#undef PG8_WAIT_V
#undef PG8_WAIT_L
#undef PG8_BAR
#undef PG8_SCHED
}
}

typedef unsigned short bf16_t;
typedef short bf16x8 __attribute__((ext_vector_type(8)));
typedef short s16x4 __attribute__((ext_vector_type(4)));
typedef float f32x4 __attribute__((ext_vector_type(4)));
typedef float f32x16 __attribute__((ext_vector_type(16)));
typedef unsigned u32x4 __attribute__((ext_vector_type(4)));
typedef unsigned u32x2 __attribute__((ext_vector_type(2)));
#define DI __device__ __forceinline__
#define LAUNDER(x) asm volatile("" : "+v"(x))

constexpr int T_ = 32768, DM = 1024, FF = 2816, SEQ = 16384, NLAYER = 2;
constexpr int INC = 3336, INP = 3584, PLD = 3344;
constexpr int C_AQ = 0, C_AK = 256, C_AV = 512, C_BQ = 768, C_BK = 1024, C_BV = 1280, C_BO = 1536, C_CQ = 1792, C_CK = 2048, C_CV = 2304, C_DQ = 2560, C_DK = 2816, C_DV = 3072, C_GI = 3328, C_GF = 3332;
constexpr float LOG2E = 1.4426950408889634f, EPS_ = 1e-6f;
#ifndef D_EARLY
#define D_EARLY 1
#endif

constexpr size_t SZ_WGU = (size_t)2 * FF * DM * 2, SZ_WD = (size_t)DM * FF * 2, SZ_WIN = (size_t)INP * DM * 2, SZ_WOUT = (size_t)DM * DM * 2;
constexpr size_t LW_WGU1 = 0, LW_WD1 = LW_WGU1 + SZ_WGU, LW_WIN = LW_WD1 + SZ_WD, LW_WOUT = LW_WIN + SZ_WIN, LW_WGU2 = LW_WOUT + SZ_WOUT, LW_WD2 = LW_WGU2 + SZ_WGU, LW_SIZE = LW_WD2 + SZ_WD;
constexpr size_t WS_CTL = 0, WS_W = 8192, WS_XN = WS_W + NLAYER * LW_SIZE, WS_HP = WS_XN + (size_t)T_ * DM * 2, WS_BQ = WS_HP + (size_t)T_ * PLD * 2,
                 WS_BK = WS_BQ + (size_t)T_ * 256 * 2, WS_BKT = WS_BK + (size_t)T_ * 256 * 2, WS_VT = WS_BKT + (size_t)T_ * 256 * 2, WS_DC = WS_VT + (size_t)4 * T_ * 256 * 2,
                 WS_SC = WS_DC + (size_t)8 * 256 * 4160 * 4, WS_SS = WS_SC + 3 * 8 * 256 * 4, WS_END = WS_SS + (size_t)7 * T_ * 4;
static_assert(WS_XN % 256 == 0 && WS_HP % 256 == 0 && WS_BQ % 256 == 0 && WS_DC % 256 == 0 && (size_t)T_ * FF * 2 <= (size_t)T_ * PLD * 2, "ws map");
constexpr int LDS_BYTES = pg8::STAGE_BYTES + 1024;

DI unsigned pk2(float a, float b) { return pg8::cvt_pk_bf16(a, b); }
DI float bf2f(bf16_t h) { return __uint_as_float((unsigned)h << 16); }
DI float bflo(unsigned w) { return __uint_as_float(w << 16); }
DI float bfhi(unsigned w) { return __uint_as_float(w & 0xffff0000u); }
DI float ex2(float x) { return __builtin_amdgcn_exp2f(x); }
DI float lg2(float x) { return __builtin_amdgcn_logf(x); }
DI float rcpf_(float x) { return __builtin_amdgcn_rcpf(x); }
DI int crow(int r, int hi) { return (r & 3) + 8 * (r >> 2) + 4 * hi; }
#define MFMA32(a, b, c) __builtin_amdgcn_mfma_f32_32x32x16_bf16((a), (b), (c), 0, 0, 0)
DI f32x16 splat16(float v) { f32x16 r;
#pragma unroll
  for (int i = 0; i < 16; ++i) r[i] = v; return r; }
DI bf16x8 pack8(const f32x16& s, int kk) {
  u32x4 p; p.x = pk2(s[8 * kk], s[8 * kk + 1]); p.y = pk2(s[8 * kk + 2], s[8 * kk + 3]); p.z = pk2(s[8 * kk + 4], s[8 * kk + 5]); p.w = pk2(s[8 * kk + 6], s[8 * kk + 7]);
  return __builtin_bit_cast(bf16x8, p); }
DI bf16x8 cat4(s16x4 lo, s16x4 hi) { return __builtin_shufflevector(lo, hi, 0, 1, 2, 3, 4, 5, 6, 7); }

struct Args { const float* in[23]; float* out; unsigned char* ws; };

struct TDesc { const float* W0; const float* W1; const float* gk; bf16_t* WT; int kind, K, N, kt, nt; };
DI TDesc tt_decode(const Args& a, int it) {
  constexpr int I_GU = 16 * 88, I_D = 44 * 16, I_IN = 16 * 56, I_OUT = 16 * 16, I_L = 2 * I_GU + 2 * I_D + I_IN + I_OUT;
  const int l = it / I_L; int r = it % I_L; unsigned char* wl = a.ws + WS_W + (size_t)l * LW_SIZE; TDesc d;
  if (r < I_GU) { d.W0 = a.in[2] + (size_t)l * DM * FF; d.W1 = a.in[3] + (size_t)l * DM * FF; d.gk = a.in[1] + l * DM; d.WT = (bf16_t*)(wl + LW_WGU1); d.kind = 0; d.K = DM; d.N = FF; d.kt = r / 88; d.nt = r % 88; return d; } r -= I_GU;
  if (r < I_D) { d.W0 = a.in[4] + (size_t)l * FF * DM; d.W1 = nullptr; d.gk = nullptr; d.WT = (bf16_t*)(wl + LW_WD1); d.kind = 1; d.K = FF; d.N = DM; d.kt = r / 16; d.nt = r % 16; return d; } r -= I_D;
  if (r < I_IN) { d.W0 = a.in[6] + (size_t)l * DM * INC; d.W1 = nullptr; d.gk = a.in[5] + l * DM; d.WT = (bf16_t*)(wl + LW_WIN); d.kind = 2; d.K = DM; d.N = INC; d.kt = r / 56; d.nt = r % 56; return d; } r -= I_IN;
  if (r < I_OUT) { d.W0 = a.in[18] + (size_t)l * DM * DM; d.W1 = nullptr; d.gk = nullptr; d.WT = (bf16_t*)(wl + LW_WOUT); d.kind = 1; d.K = DM; d.N = DM; d.kt = r / 16; d.nt = r % 16; return d; } r -= I_OUT;
  if (r < I_GU) { d.W0 = a.in[20] + (size_t)l * DM * FF; d.W1 = a.in[21] + (size_t)l * DM * FF; d.gk = a.in[19] + l * DM; d.WT = (bf16_t*)(wl + LW_WGU2); d.kind = 0; d.K = DM; d.N = FF; d.kt = r / 88; d.nt = r % 88; return d; } r -= I_GU;
  d.W0 = a.in[22] + (size_t)l * FF * DM; d.W1 = nullptr; d.gk = nullptr; d.WT = (bf16_t*)(wl + LW_WD2); d.kind = 1; d.K = FF; d.N = DM; d.kt = r / 16; d.nt = r % 16; return d;
}
DI void tt_load(const TDesc& d, f32x4 (&v)[2], int tid) {
  const int n4 = tid & 15, np = d.nt * 64 + 4 * n4, k0 = d.kt * 64; const float* src = d.W0; int col;
  if (d.kind == 0) { const int pn = np >> 8, r = np & 255; src = (r < 128) ? d.W0 : d.W1; col = 128 * pn + (r & 127); }
  else if (d.kind == 1) col = np;
  else col = (np < 1792) ? np : (np < 3328) ? np + 8 : (np < 3336) ? 1792 + (np - 3328) : -1;
#pragma unroll
  for (int p = 0; p < 2; ++p) { const int kk = (tid >> 4) + 32 * p;
    v[p] = (col >= 0) ? *(const f32x4*)(src + (size_t)(k0 + kk) * d.N + col) * (d.gk ? d.gk[k0 + kk] : 1.f) : (f32x4){0.f, 0.f, 0.f, 0.f}; }
}
DI void prologue_weights(const Args& a, unsigned char* lds, int tid) {
  LAUNDER(tid);
  constexpr int NI = 6, NITEMS = NLAYER * (2 * 16 * 88 + 2 * 44 * 16 + 16 * 56 + 16 * 16);
  for (int it0 = blockIdx.x; it0 < NITEMS; it0 += NI * gridDim.x) {
    f32x4 v[NI][2]; TDesc d[NI];
#pragma unroll
    for (int q = 0; q < NI; ++q) { const int it = it0 + q * gridDim.x; if (it < NITEMS) { d[q] = tt_decode(a, it); tt_load(d[q], v[q], tid); } }
#pragma unroll
    for (int q = 0; q < NI; ++q) { float* scr = (float*)lds + q * (64 * 65);
#pragma unroll
      for (int p = 0; p < 2; ++p) { float* w = scr + ((tid >> 4) + 32 * p) * 65 + 4 * (tid & 15); w[0] = v[q][p].x; w[1] = v[q][p].y; w[2] = v[q][p].z; w[3] = v[q][p].w; } }
    __syncthreads();
#pragma unroll
    for (int q = 0; q < NI; ++q) { const int it = it0 + q * gridDim.x; if (it < NITEMS) {
      const int n = tid >> 3, kc = tid & 7; const float* sp = (const float*)lds + q * (64 * 65) + (8 * kc) * 65 + n;
      u32x4 o; o.x = pk2(sp[0], sp[65]); o.y = pk2(sp[2 * 65], sp[3 * 65]); o.z = pk2(sp[4 * 65], sp[5 * 65]); o.w = pk2(sp[6 * 65], sp[7 * 65]);
      *(u32x4*)(d[q].WT + (size_t)(d[q].nt * 64 + n) * d[q].K + d[q].kt * 64 + 8 * kc) = o; } }
    __syncthreads();
  }
}

DI float wave_sum(float v) {
#pragma unroll
  for (int o = 1; o < 64; o <<= 1) v += __shfl_xor(v, o);
  return v; }
DI float wave_max(float v) {
#pragma unroll
  for (int o = 1; o < 64; o <<= 1) v = fmaxf(v, __shfl_xor(v, o));
  return v; }
DI void cast_phase(const float* x, bf16_t* xb, float* ss, int tid) {
  LAUNDER(tid);
  const int lane = tid & 63, gw = blockIdx.x * 8 + (tid >> 6), ngw = gridDim.x * 8;
  for (int i = blockIdx.x * 512 + tid; i < 6 * T_; i += gridDim.x * 512) ss[T_ + i] = 0.f;
  for (int m0 = gw; m0 < T_; m0 += 2 * ngw) {
    f32x4 v[2][4];
#pragma unroll
    for (int r = 0; r < 2; ++r) { const int m = m0 + r * ngw; if (m < T_) { const f32x4* xr = (const f32x4*)(x + (size_t)m * DM) + lane;
#pragma unroll
      for (int j = 0; j < 4; ++j) v[r][j] = xr[64 * j]; } }
#pragma unroll
    for (int r = 0; r < 2; ++r) { const int m = m0 + r * ngw; if (m < T_) { float q = 0.f;
#pragma unroll
      for (int j = 0; j < 4; ++j) q += (v[r][j].x * v[r][j].x + v[r][j].y * v[r][j].y) + (v[r][j].z * v[r][j].z + v[r][j].w * v[r][j].w);
      q = wave_sum(q); if (lane == 0) ss[m] = q;
      u32x2* o = (u32x2*)(xb + (size_t)m * DM) + lane;
#pragma unroll
      for (int j = 0; j < 4; ++j) { u32x2 w; w.x = pk2(v[r][j].x, v[r][j].y); w.y = pk2(v[r][j].z, v[r][j].w); o[64 * j] = w; } } }
  }
}

struct PrepParams { const float *aqg, *akg, *cqg, *ckg, *convw, *convb; };
DI void prep_phase(bf16_t* P, bf16_t* BQ, bf16_t* BK, bf16_t* BKt, bf16_t* Vt, const PrepParams& pp, unsigned char* lds, int tid) {
  LAUNDER(tid);
  float* gt = (float*)lds;
  if (tid < 64) { gt[tid] = pp.aqg[tid]; gt[64 + tid] = pp.akg[tid]; gt[128 + tid] = pp.cqg[tid & 31]; gt[192 + tid] = pp.ckg[tid & 31]; gt[256 + tid] = 1.f; }
  __syncthreads();
  for (int tile = blockIdx.x; tile < T_ / 64; tile += gridDim.x) {
    const int tok0 = tile * 64, b = tok0 / SEQ, s0 = tok0 % SEQ;
    for (int id0 = tid; id0 < 64 * 160; id0 += 10 * 512) {
      u32x4 w4[10]; bf16_t* p4[10];
#pragma unroll
      for (int u = 0; u < 10; ++u) { const int id = id0 + 512 * u, tk = id / 160, ci = id % 160, seg = ci >> 5, within = (ci & 31) * 8;
        const int colb = (seg == 0) ? C_AQ : (seg == 1) ? C_AK : (seg == 2) ? C_CQ : (seg == 3) ? C_CK : C_DQ;
        p4[u] = P + (size_t)(tok0 + tk) * PLD + colb + within; w4[u] = *(const u32x4*)p4[u]; }
#pragma unroll
      for (int u = 0; u < 10; ++u) { const int id = id0 + 512 * u, ci = id % 160, seg = ci >> 5, within = (ci & 31) * 8;
        const u32x4 w = w4[u]; float v[8];
        v[0] = bflo(w.x); v[1] = bfhi(w.x); v[2] = bflo(w.y); v[3] = bfhi(w.y); v[4] = bflo(w.z); v[5] = bfhi(w.z); v[6] = bflo(w.w); v[7] = bfhi(w.w);
        float ss = 0.f;
#pragma unroll
        for (int j = 0; j < 8; ++j) ss += v[j] * v[j];
        ss += __shfl_xor(ss, 1); ss += __shfl_xor(ss, 2);
        const float ss32 = ss; ss += __shfl_xor(ss, 4);
        float sc;
        if (seg < 2) { sc = rsqrtf(ss * (1.f / 64.f) + EPS_) * (seg == 0 ? 0.125f * LOG2E : 1.f); }
        else if (seg < 4) { sc = rsqrtf(ss32 * (1.f / 32.f) + EPS_) * (seg == 2 ? 0.17677669529663687f * LOG2E : 1.f); }
        else { sc = 0.125f * LOG2E; }
        const float* gp = gt + seg * 64 + (within & 63);
        const f32x4 ga = *(const f32x4*)gp, gb = *(const f32x4*)(gp + 4);
        u32x4 o; o.x = pk2(v[0] * sc * ga.x, v[1] * sc * ga.y); o.y = pk2(v[2] * sc * ga.z, v[3] * sc * ga.w); o.z = pk2(v[4] * sc * gb.x, v[5] * sc * gb.y); o.w = pk2(v[6] * sc * gb.z, v[7] * sc * gb.w);
        *(u32x4*)p4[u] = o; }
    }
    bf16_t* Lin = (bf16_t*)(lds + 2048); bf16_t* Lout = Lin + 67 * 264;
    u32x4 r[5];
#define PREP_LOAD_GROUP(G) do { const int col0_ = ((G) == 0) ? C_AV : ((G) == 1) ? C_BV : ((G) == 2) ? C_CV : ((G) == 3) ? C_DV : ((G) == 4) ? C_BQ : C_BK; \
      _Pragma("unroll") for (int u = 0; u < 5; ++u) { const int idx = tid + 512 * u, row = idx >> 5, pc = idx & 31, srow = s0 - 3 + row; \
        r[u] = (u32x4){0u, 0u, 0u, 0u}; \
        if (idx < 67 * 32 && srow >= 0) r[u] = *(const u32x4*)(P + (size_t)(b * SEQ + srow) * PLD + col0_ + 8 * pc); } } while (0)
    PREP_LOAD_GROUP(0);
#pragma unroll
    for (int g = 0; g < 6; ++g) {
      __syncthreads();
#pragma unroll
      for (int u = 0; u < 5; ++u) { const int idx = tid + 512 * u, row = idx >> 5, pc = idx & 31; if (idx < 67 * 32) *(u32x4*)(Lin + row * 264 + 8 * pc) = r[u]; }
      __syncthreads();
      if (g + 1 < 6) PREP_LOAD_GROUP(g + 1);
      const int c = tid & 255, th = tid >> 8; const bf16_t* colp = Lin + (32 * th) * 264 + c;
      if (g < 4) {
        unsigned w[16];
#pragma unroll
        for (int q = 0; q < 16; ++q) { const int p = 2 * q, i = (p & ~12) | ((p & 4) << 1) | ((p & 8) >> 1);
          w[q] = (unsigned)colp[(3 + i) * 264] | ((unsigned)colp[(3 + i + 1) * 264] << 16); }
        bf16_t* vd = Vt + (size_t)g * T_ * 256 + (((size_t)(b * 4 + (c >> 6)) * 256 + (s0 >> 6)) * 64 + (c & 63)) * 64 + 32 * th;
#pragma unroll
        for (int q4 = 0; q4 < 4; ++q4) { u32x4 o; o.x = w[4 * q4]; o.y = w[4 * q4 + 1]; o.z = w[4 * q4 + 2]; o.w = w[4 * q4 + 3]; *(u32x4*)(vd + 8 * q4) = o; }
      } else {
        const int cq = (g - 4) * 256 + c;
        const float w0 = pp.convw[cq], w1 = pp.convw[512 + cq], w2 = pp.convw[1024 + cq], w3 = pp.convw[1536 + cq], bb = pp.convb[cq], sc = (g == 4) ? 1.f : 0.125f;
        float x[35];
#pragma unroll
        for (int i = 0; i < 35; ++i) x[i] = bf2f(colp[i * 264]);
        unsigned short yb[32];
#pragma unroll
        for (int i = 0; i < 32; ++i) { const float y = bb + x[i] * w0 + x[i + 1] * w1 + x[i + 2] * w2 + x[i + 3] * w3; yb[i] = (unsigned short)(pk2(pg8::silu_f(y) * sc, 0.f) & 0xffffu); Lout[(32 * th + i) * 264 + c] = yb[i]; }
        if (g == 5) {
          bf16_t* kd = BKt + (((size_t)(b * 4 + (c >> 6)) * 256 + (s0 >> 6)) * 64 + (c & 63)) * 64 + 32 * th;
#pragma unroll
          for (int q4 = 0; q4 < 4; ++q4) { unsigned w[4];
#pragma unroll
            for (int q = 0; q < 4; ++q) { const int p = 2 * (4 * q4 + q), i = (p & ~12) | ((p & 4) << 1) | ((p & 8) >> 1); w[q] = (unsigned)yb[i] | ((unsigned)yb[i + 1] << 16); }
            u32x4 o; o.x = w[0]; o.y = w[1]; o.z = w[2]; o.w = w[3]; *(u32x4*)(kd + 8 * q4) = o; }
        }
        __syncthreads();
        bf16_t* dst = (g == 4) ? BQ : BK;
#pragma unroll
        for (int u = 0; u < 4; ++u) { const int idx = tid + 512 * u, row = idx >> 5, pc = idx & 31; *(u32x4*)(dst + (size_t)(tok0 + row) * 256 + 8 * pc) = *(const u32x4*)(Lout + row * 264 + 8 * pc); }
      }
    }
    __syncthreads();
  }
}

#undef PREP_LOAD_GROUP
DI float wave_scan_add(float v, int lane) {
#pragma unroll
  for (int o = 1; o < 64; o <<= 1) { const float t = __shfl_up(v, o); if (lane >= o) v += t; }
  return v; }
DI float wave_scan_max(float v, int lane) {
#pragma unroll
  for (int o = 1; o < 64; o <<= 1) { const float t = __shfl_up(v, o); if (lane >= o) v = fmaxf(v, t); }
  return v; }
DI float fexp(float x) { return ex2(x * LOG2E); }
DI float log_sigmoid_f(float x) { return fminf(x, 0.f) - lg2(1.0f + fexp(-fabsf(x))) * 0.6931471805599453f; }
DI void lds_wave_sync() { asm volatile("s_waitcnt lgkmcnt(0)" ::: "memory"); __builtin_amdgcn_wave_barrier(); }

DI void b1_phase(const bf16_t* P, const bf16_t* BKt, const bf16_t* VtB, float* DC, float* SC, const float* gate_bias, unsigned char* lds, int tid) {
  LAUNDER(tid);
  const int lane = tid & 63, wave = tid >> 6, r32 = lane & 31, hi = lane >> 5;
  float* wsc = (float*)(lds + wave * 1024);
  for (int item = blockIdx.x * 8 + wave; item < 2048; item += gridDim.x * 8) {
    const int bh = item >> 8, c = item & 255, b = bh >> 2, h = bh & 3, s0 = c * 64; const size_t tok0 = (size_t)b * SEQ + s0;
    const float gf = bf2f(P[(tok0 + lane) * PLD + C_GF + h]) + gate_bias[4 + h], gi = bf2f(P[(tok0 + lane) * PLD + C_GI + h]) + gate_bias[h];
    const float lf = log_sigmoid_f(gf), bcum = wave_scan_add(lf, lane), btot = __shfl(bcum, 63);
    const float g = btot - bcum + gi, mloc = wave_max(g), w = fexp(g - mloc);
    wsc[lane] = w; lds_wave_sync();
    f32x16 acc[2][2];
#pragma unroll
    for (int i = 0; i < 2; ++i)
#pragma unroll
      for (int j = 0; j < 2; ++j) acc[i][j] = splat16(0.f);
    float dn[2] = {0.f, 0.f};
#pragma unroll
    for (int ks = 0; ks < 4; ++ks) {
      const f32x4 wa = *(const f32x4*)(wsc + 16 * ks + 4 * hi), wb = *(const f32x4*)(wsc + 16 * ks + 8 + 4 * hi);
      bf16x8 vf[2], kf[2];
#pragma unroll
      for (int eb = 0; eb < 2; ++eb) {
        vf[eb] = *(const bf16x8*)(VtB + (((size_t)bh * 256 + c) * 64 + 32 * eb + r32) * 64 + 16 * ks + 8 * hi);
        const u32x4 kw = *(const u32x4*)(BKt + (((size_t)bh * 256 + c) * 64 + 32 * eb + r32) * 64 + 16 * ks + 8 * hi);
        const float k0 = bflo(kw.x) * wa.x, k1 = bfhi(kw.x) * wa.y, k2 = bflo(kw.y) * wa.z, k3 = bfhi(kw.y) * wa.w, k4 = bflo(kw.z) * wb.x, k5 = bfhi(kw.z) * wb.y, k6 = bflo(kw.w) * wb.z, k7 = bfhi(kw.w) * wb.w;
        dn[eb] += ((k0 + k1) + (k2 + k3)) + ((k4 + k5) + (k6 + k7));
        u32x4 o; o.x = pk2(k0, k1); o.y = pk2(k2, k3); o.z = pk2(k4, k5); o.w = pk2(k6, k7); kf[eb] = __builtin_bit_cast(bf16x8, o);
      }
#pragma unroll
      for (int eb = 0; eb < 2; ++eb)
#pragma unroll
        for (int db = 0; db < 2; ++db) acc[eb][db] = MFMA32(vf[eb], kf[db], acc[eb][db]);
    }
    float* dc = DC + ((size_t)bh * 256 + c) * 4160;
#pragma unroll
    for (int eb = 0; eb < 2; ++eb)
#pragma unroll
      for (int db = 0; db < 2; ++db)
#pragma unroll
        for (int i = 0; i < 16; ++i) dc[(32 * eb + crow(i, hi)) * 64 + 32 * db + r32] = acc[eb][db][i];
#pragma unroll
    for (int db = 0; db < 2; ++db) { const float t = dn[db] + __shfl_xor(dn[db], 32); if (hi == 0) dc[4096 + 32 * db + r32] = t; }
    if (lane == 0) { SC[bh * 256 + c] = btot; SC[2048 + bh * 256 + c] = mloc; }
    lds_wave_sync();
  }
}

DI void b2_item(float* DC, float* SC, int j, unsigned char* lds, int tid) {
  LAUNDER(tid);
  float* L = (float*)lds;
  const int ge = j * 512 + tid, bh0 = (j * 512) / 1040, bh1 = (j * 512 + 511) / 1040;
  { const int slot = tid >> 8, c = tid & 255, bh = slot ? bh1 : bh0;
    if (bh < 8) { L[slot * 1024 + c] = SC[bh * 256 + c]; L[slot * 1024 + 256 + c] = SC[2048 + bh * 256 + c]; } }
  __syncthreads();
  if ((tid & 63) == 0 && (tid >> 6) < 2) { const int slot = tid >> 6, bh = slot ? bh1 : bh0;
    if (bh < 8 && (slot == 0 || bh1 != bh0)) { float* q = L + slot * 1024; float m = 0.f; const bool wr = (j * 512 <= bh * 1040) && (bh * 1040 < j * 512 + 512);
      for (int c = 0; c < 256; ++c) { const float b = q[c], l = q[256 + c], mn = fmaxf(b + m, l); q[512 + c] = fexp(b + m - mn); q[768 + c] = fexp(l - mn); if (wr) SC[4096 + bh * 256 + c] = m; m = mn; } } }
  __syncthreads();
  if (ge < 8 * 1040) {
    const int bh = ge / 1040, el = (ge % 1040) * 4; const float* q = L + ((bh == bh0) ? 0 : 1024);
    float* p = DC + (size_t)bh * 256 * 4160 + el; float z0 = 0.f; LAUNDER(z0); f32x4 C = {z0, z0, z0, z0};
    for (int c0 = 0; c0 < 256; c0 += 8) {
      f32x4 d[8];
#pragma unroll
      for (int u = 0; u < 8; ++u) d[u] = *(const f32x4*)(p + (size_t)(c0 + u) * 4160);
#pragma unroll
      for (int u = 0; u < 8; ++u) { *(f32x4*)(p + (size_t)(c0 + u) * 4160) = C; C = C * q[512 + c0 + u] + d[u] * q[768 + c0 + u]; }
    }
  }
}

DI void b3_phase(const bf16_t* P, const bf16_t* BQ, const bf16_t* BK, const bf16_t* VtB, const float* DC, const float* SC, const float* gate_bias, const float* onorm, bf16_t* Y, unsigned char* lds, int tid) {
  LAUNDER(tid);
  const int lane = tid & 63, wave = tid >> 6, r32 = lane & 31, hi = lane >> 5;
  float* R = (float*)(lds + wave * 2048); float* MU = R + 64; float* SI = R + 128; float* EM = R + 192; float* NV = R + 256;
  for (int item = blockIdx.x * 8 + wave; item < 2048; item += gridDim.x * 8) {
    const int bh = item >> 8, c = item & 255, b = bh >> 2, h = bh & 3, s0 = c * 64; const size_t tok0 = (size_t)b * SEQ + s0;
    const float* dc = DC + ((size_t)bh * 256 + c) * 4160;
    {
      const float gf = bf2f(P[(tok0 + lane) * PLD + C_GF + h]) + gate_bias[4 + h], gi = bf2f(P[(tok0 + lane) * PLD + C_GI + h]) + gate_bias[h];
      const float lf = log_sigmoid_f(gf), bcum = wave_scan_add(lf, lane), r = gi - bcum, pmax = wave_scan_max(r, lane);
      const float m_in = SC[4096 + bh * 256 + c], mu = fmaxf(m_in, pmax);
      R[lane] = r; MU[lane] = mu; SI[lane] = fexp(m_in - mu); EM[lane] = fexp(-bcum - mu); NV[lane] = dc[4096 + lane];
    }
    lds_wave_sync();
#pragma unroll
    for (int tq = 0; tq < 2; ++tq) {
      const int t = 32 * tq + r32; const float mu_t = MU[t], si_t = SI[t], em_t = EM[t];
      bf16x8 qf[4]; float qn = 0.f;
#pragma unroll
      for (int ks = 0; ks < 4; ++ks) {
        const u32x4 qw = *(const u32x4*)(BQ + (tok0 + t) * 256 + h * 64 + 16 * ks + 8 * hi); qf[ks] = __builtin_bit_cast(bf16x8, qw);
        const f32x4 na = *(const f32x4*)(NV + 16 * ks + 8 * hi), nb = *(const f32x4*)(NV + 16 * ks + 8 * hi + 4);
        qn += bflo(qw.x) * na.x + bfhi(qw.x) * na.y + bflo(qw.y) * na.z + bfhi(qw.y) * na.w + bflo(qw.z) * nb.x + bfhi(qw.z) * nb.y + bflo(qw.w) * nb.z + bfhi(qw.w) * nb.w;
      }
      qn += __shfl_xor(qn, 32);
      f32x16 G[2], num[2];
#pragma unroll
      for (int eb = 0; eb < 2; ++eb) { G[eb] = splat16(0.f); num[eb] = splat16(0.f);
#pragma unroll
        for (int ks = 0; ks < 4; ++ks) { const float* cp = dc + (32 * eb + r32) * 64 + 16 * ks + 8 * hi; const f32x4 ca = *(const f32x4*)cp, cb = *(const f32x4*)(cp + 4);
          u32x4 o; o.x = pk2(ca.x, ca.y); o.y = pk2(ca.z, ca.w); o.z = pk2(cb.x, cb.y); o.w = pk2(cb.z, cb.w);
          G[eb] = MFMA32(__builtin_bit_cast(bf16x8, o), qf[ks], G[eb]); }
        asm volatile("" ::: "memory"); }
      float dsum = 0.f;
#pragma unroll
      for (int tk = 0; tk < 2; ++tk) {
        if (tk <= tq) {
          f32x16 S = splat16(0.f);
#pragma unroll
          for (int ks = 0; ks < 4; ++ks) { const bf16x8 kf = *(const bf16x8*)(BK + (tok0 + 32 * tk + r32) * 256 + h * 64 + 16 * ks + 8 * hi); S = MFMA32(kf, qf[ks], S); }
          asm volatile("" ::: "memory");
#pragma unroll
          for (int g4 = 0; g4 < 4; ++g4) { const f32x4 rv = *(const f32x4*)(R + 32 * tk + 8 * g4 + 4 * hi);
#pragma unroll
            for (int j = 0; j < 4; ++j) { const int s = 32 * tk + 8 * g4 + 4 * hi + j; const float w = (s <= t) ? fexp(rv[j] - mu_t) : 0.f; const float val = S[4 * g4 + j] * w; dsum += val; S[4 * g4 + j] = val; } }
#pragma unroll
          for (int kk = 0; kk < 2; ++kk) { const bf16x8 pf = pack8(S, kk);
#pragma unroll
            for (int eb = 0; eb < 2; ++eb) { const bf16_t* vp = VtB + (((size_t)bh * 256 + c) * 64 + 32 * eb + r32) * 64 + 32 * tk + 16 * kk + 8 * hi;
              const bf16x8 vf = *(const bf16x8*)vp; num[eb] = MFMA32(vf, pf, num[eb]); } }
          asm volatile("" ::: "memory");
        }
      }
      dsum += __shfl_xor(dsum, 32);
      const float den = si_t * qn + dsum, inv = 1.0f / fmaxf(fabsf(den), em_t);
      float ss = 0.f;
#pragma unroll
      for (int eb = 0; eb < 2; ++eb)
#pragma unroll
        for (int i = 0; i < 16; ++i) { const float hv = (num[eb][i] + si_t * G[eb][i]) * inv; num[eb][i] = hv; ss += hv * hv; }
      ss += __shfl_xor(ss, 32);
      const float rstd = rsqrtf(ss * (1.f / 64.f) + EPS_);
      const bf16_t* bo = P + (tok0 + t) * PLD + C_BO + h * 64; bf16_t* yo = Y + (tok0 + t) * DM + 256 + h * 64;
#pragma unroll
      for (int eb = 0; eb < 2; ++eb)
#pragma unroll
        for (int g4 = 0; g4 < 4; ++g4) { const int e = 32 * eb + 8 * g4 + 4 * hi; const u32x2 bw = *(const u32x2*)(bo + e); const f32x4 gn = *(const f32x4*)(onorm + h * 64 + e);
          const float o0 = num[eb][4 * g4] * rstd * gn.x * rcpf_(1.f + fexp(-bflo(bw.x))), o1 = num[eb][4 * g4 + 1] * rstd * gn.y * rcpf_(1.f + fexp(-bfhi(bw.x)));
          const float o2 = num[eb][4 * g4 + 2] * rstd * gn.z * rcpf_(1.f + fexp(-bflo(bw.y))), o3 = num[eb][4 * g4 + 3] * rstd * gn.w * rcpf_(1.f + fexp(-bfhi(bw.y)));
          u32x2 ow; ow.x = pk2(o0, o1); ow.y = pk2(o2, o3); *(u32x2*)(yo + e) = ow; }
    }
    lds_wave_sync();
  }
}

struct AttnParams { const bf16_t* P; const bf16_t* Vt; bf16_t* Y; const float* biasL; float negM; float lam; float oscale; const float* cgain; };
constexpr int NCH = 1;
template <int MODE>
DI void attn_unit(unsigned char* lds, const AttnParams& ap, int b, int h, int qb, int tid) {
  LAUNDER(tid);
  const int wave = tid >> 6, lane = tid & 63, r32 = lane & 31, hi = lane >> 5, bh = b * 4 + h;
  constexpr int qcol0 = (MODE == 0) ? C_AQ : (MODE == 1) ? C_CQ : C_DQ, kcol0 = (MODE == 0) ? C_AK : (MODE == 1) ? C_CK : C_DK, ycol0 = (MODE == 0) ? 0 : (MODE == 1) ? 512 : 768;
  const bf16_t* Vt = ap.Vt + (size_t)((MODE == 0) ? 0 : (MODE == 1) ? 2 : 3) * T_ * 256;
  const size_t tokb = (size_t)b * SEQ;
  const int qpos = qb * 256 + wave * 32 + r32, cw = qb * 4 + (wave >> 1);
  bf16x8 qf[4];
  { const bf16_t* qp = ap.P + (tokb + qpos) * PLD + qcol0 + h * 64 + 8 * hi;
#pragma unroll
    for (int ks = 0; ks < 4; ++ks) qf[ks] = *(const bf16x8*)(qp + 16 * ks); }
  bf16_t* Ks0 = (bf16_t*)lds; bf16_t* Vs0 = Ks0 + NCH * 64 * 72; volatile int* flags = (volatile int*)(lds + 2 * NCH * 64 * 72 * 2);
  const int jhi = 4 * qb + 3, jlo = (MODE == 0) ? ((4 * qb - 8 > 0) ? 4 * qb - 8 : 0) : 0, ntiles = jhi - jlo + 1;
  const int lrow = tid >> 3, lch = tid & 7;
  const bf16_t* kg = ap.P + (tokb + lrow) * PLD + kcol0 + h * 64 + 8 * lch;
  const bf16_t* vg = Vt + (size_t)bh * 256 * 4096 + lrow * 64 + 8 * lch;
  const int j0 = (MODE == 2) ? jhi : jlo;
  u32x4 kreg[NCH], vreg[NCH];
#pragma unroll
  for (int c = 0; c < NCH; ++c) { const int jc = (MODE == 2) ? j0 - c : j0 + c; kreg[c] = *(const u32x4*)(kg + (size_t)jc * 64 * PLD); vreg[c] = *(const u32x4*)(vg + (size_t)jc * 4096); }
  f32x16 O0[2], O1[2]; float l0 = 0.f, l1 = 0.f, cum = 0.f;
#pragma unroll
  for (int eb = 0; eb < 2; ++eb) { O0[eb] = splat16(0.f); O1[eb] = splat16(0.f); }
  bool wdone = false;
  if (MODE == 2 && D_EARLY) { if (tid < 8) flags[tid] = 0; }
  for (int n = 0; n < ntiles; n += NCH) {
    const int jb = (MODE == 2) ? jhi - n : jlo + n;
    __syncthreads();
    if (MODE == 2 && D_EARLY) { int alld = 1;
#pragma unroll
      for (int w = 0; w < 8; ++w) alld &= flags[w];
      if (alld) break; }
#pragma unroll
    for (int c = 0; c < NCH; ++c) { *(u32x4*)(Ks0 + (c * 64 + lrow) * 72 + 8 * lch) = kreg[c]; *(u32x4*)(Vs0 + (c * 64 + lrow) * 72 + 8 * lch) = vreg[c]; }
    __syncthreads();
    if (n + NCH < ntiles) {
#pragma unroll
      for (int c = 0; c < NCH; ++c) { const int jn = (MODE == 2) ? jb - NCH - c : jb + NCH + c; kreg[c] = *(const u32x4*)(kg + (size_t)jn * 64 * PLD); vreg[c] = *(const u32x4*)(vg + (size_t)jn * 4096); } }
#pragma unroll
    for (int c = 0; c < NCH; ++c) {
    const int j = (MODE == 2) ? jb - c : jb + c;
    const bf16_t* Ks = Ks0 + c * 64 * 72; const bf16_t* Vs = Vs0 + c * 64 * 72;
    const bool active = (j <= cw) && (MODE != 0 || j >= cw - 8);
    if (!active) continue;
    if (MODE == 2 && D_EARLY && wdone) continue;
    if (MODE == 1) {
#pragma unroll
      for (int kh = 0; kh < 2; ++kh) {
        const bf16_t* kb = Ks + (32 * kh + r32) * 72 + 8 * hi;
        bf16x8 p0[2], p1[2];
        { f32x16 s0 = splat16(ap.negM);
          s0 = MFMA32(*(const bf16x8*)(kb), qf[0], s0); s0 = MFMA32(*(const bf16x8*)(kb + 16), qf[1], s0);
#pragma unroll
          for (int i = 0; i < 16; ++i) { s0[i] = ex2(s0[i]); l0 += s0[i]; }
          p0[0] = pack8(s0, 0); p0[1] = pack8(s0, 1); }
        { f32x16 s1 = splat16(ap.negM);
          s1 = MFMA32(*(const bf16x8*)(kb + 32), qf[2], s1); s1 = MFMA32(*(const bf16x8*)(kb + 48), qf[3], s1);
#pragma unroll
          for (int i = 0; i < 16; ++i) { s1[i] = ex2(s1[i]); l1 += s1[i]; }
          p1[0] = pack8(s1, 0); p1[1] = pack8(s1, 1); }
#pragma unroll
        for (int kk = 0; kk < 2; ++kk) {
#pragma unroll
          for (int eb = 0; eb < 2; ++eb) { const bf16_t* vb = Vs + (32 * eb + r32) * 72 + 32 * kh + 16 * kk + 8 * hi; const bf16x8 vf = *(const bf16x8*)vb;
            O0[eb] = MFMA32(vf, p0[kk], O0[eb]); O1[eb] = MFMA32(vf, p1[kk], O1[eb]); } }
      }
    } else if (MODE == 0) {
      const int dch = cw - j; const float binit = ap.negM + ((dch >= 3) ? ap.biasL[256] : 0.f);
#pragma unroll
      for (int kh = 0; kh < 2; ++kh) {
        const bf16_t* kb = Ks + (32 * kh + r32) * 72 + 8 * hi;
        f32x16 s0 = splat16(binit);
#pragma unroll
        for (int ks = 0; ks < 4; ++ks) s0 = MFMA32(*(const bf16x8*)(kb + 16 * ks), qf[ks], s0);
        if (dch < 3) {
#pragma unroll
          for (int i = 0; i < 16; ++i) { int rel = qpos - (64 * j + 32 * kh + crow(i, hi)); rel = rel > 128 ? 128 : (rel < -128 ? -128 : rel); s0[i] += ap.biasL[rel + 128]; } }
#pragma unroll
        for (int i = 0; i < 16; ++i) { s0[i] = ex2(s0[i]); l0 += s0[i]; }
#pragma unroll
        for (int kk = 0; kk < 2; ++kk) { const bf16x8 p0 = pack8(s0, kk);
#pragma unroll
          for (int eb = 0; eb < 2; ++eb) { const bf16_t* vb = Vs + (32 * eb + r32) * 72 + 32 * kh + 16 * kk + 8 * hi; const bf16x8 vf = *(const bf16x8*)vb;
            O0[eb] = MFMA32(vf, p0, O0[eb]); } }
      }
    } else {
      f32x16 z[2];
#pragma unroll
      for (int kh = 0; kh < 2; ++kh) { const bf16_t* kb = Ks + (32 * kh + r32) * 72 + 8 * hi; z[kh] = splat16(0.f);
#pragma unroll
        for (int ks = 0; ks < 4; ++ks) z[kh] = MFMA32(*(const bf16x8*)(kb + 16 * ks), qf[ks], z[kh]); }
      const bool diag = (j == cw); f32x16 sp[2]; float bs[8], ob[8];
#pragma unroll
      for (int kh = 0; kh < 2; ++kh)
#pragma unroll
        for (int g4 = 0; g4 < 4; ++g4) { float t = 0.f;
#pragma unroll
          for (int jj = 0; jj < 4; ++jj) { const int i = 4 * g4 + jj; const bool before = !diag || (64 * j + 32 * kh + crow(i, hi) < qpos);
            const float v = before ? lg2(1.0f + ex2(z[kh][i])) : 0.f; sp[kh][i] = v; t += v; }
          bs[4 * kh + g4] = t; }
#pragma unroll
      for (int p = 0; p < 8; ++p) ob[p] = __shfl_xor(bs[p], 32);
      float Rr = 0.f, saf[8];
#pragma unroll
      for (int p = 7; p >= 0; --p) { const float ev = hi ? ob[p] : bs[p], od = hi ? bs[p] : ob[p]; saf[p] = Rr + (hi ? 0.f : od); Rr += ev + od; }
#pragma unroll
      for (int kh = 0; kh < 2; ++kh)
#pragma unroll
        for (int g4 = 0; g4 < 4; ++g4) { float e = saf[4 * kh + g4];
#pragma unroll
          for (int jj = 3; jj >= 0; --jj) { const int i = 4 * g4 + jj; const bool before = !diag || (64 * j + 32 * kh + crow(i, hi) < qpos);
            const float a = before ? ex2(z[kh][i] - sp[kh][i] - e + cum) : 0.f; e += sp[kh][i]; z[kh][i] = a; } }
      cum -= Rr;
#pragma unroll
      for (int kh = 0; kh < 2; ++kh)
#pragma unroll
        for (int kk = 0; kk < 2; ++kk) { const bf16x8 p0 = pack8(z[kh], kk);
#pragma unroll
          for (int eb = 0; eb < 2; ++eb) { const bf16_t* vb = Vs + (32 * eb + r32) * 72 + 32 * kh + 16 * kk + 8 * hi; const bf16x8 vf = *(const bf16x8*)vb;
            O0[eb] = MFMA32(vf, p0, O0[eb]); } }
      if (D_EARLY) { const int done = __all(cum <= -151.0f); if (lane == 0) flags[wave] = done; wdone = (done != 0); }
    }
    }
  }
  bf16_t* yo = ap.Y + (tokb + qpos) * DM + ycol0 + h * 64;
  if (MODE == 0) { l0 += __shfl_xor(l0, 32); const float inv = 1.0f / l0;
#pragma unroll
    for (int eb = 0; eb < 2; ++eb)
#pragma unroll
      for (int i = 0; i < 16; ++i) O0[eb][i] *= inv;
  } else if (MODE == 1) { l0 += __shfl_xor(l0, 32); l1 += __shfl_xor(l1, 32); const float i0 = 1.0f / l0, i1 = ap.lam / l1; float ss = 0.f;
#pragma unroll
    for (int eb = 0; eb < 2; ++eb)
#pragma unroll
      for (int i = 0; i < 16; ++i) { const float o = O0[eb][i] * i0 - O1[eb][i] * i1; O0[eb][i] = o; ss += o * o; }
    ss += __shfl_xor(ss, 32); const float rstd = rsqrtf(ss * (1.f / 64.f) + EPS_) * ap.oscale;
#pragma unroll
    for (int eb = 0; eb < 2; ++eb)
#pragma unroll
      for (int i = 0; i < 16; ++i) O0[eb][i] *= rstd * ap.cgain[32 * eb + crow(i, hi)];
  }
#pragma unroll
  for (int eb = 0; eb < 2; ++eb)
#pragma unroll
    for (int g4 = 0; g4 < 4; ++g4) { u32x2 ow; ow.x = pk2(O0[eb][4 * g4], O0[eb][4 * g4 + 1]); ow.y = pk2(O0[eb][4 * g4 + 2], O0[eb][4 * g4 + 3]); *(u32x2*)(yo + 32 * eb + 8 * g4 + 4 * hi) = ow; }
}

struct MixParams { AttnParams ap; float* DC; float* SC; const float* relb; const float *aqg, *akg, *cqg, *ckg, *clam, *cog; float lam_init; unsigned* ctr; };
DI void mix_phase(unsigned char* lds, const MixParams& mp, int tid) {
  LAUNDER(tid);
  volatile int* misc = (volatile int*)(lds + pg8::STAGE_BYTES);
  float* biasT = (float*)(lds + 81920);
  float* red = (float*)(lds + 81920 + 4 * 260 * 4);
  for (int i = tid; i < 4 * 257; i += 512) biasT[(i / 257) * 260 + (i % 257)] = mp.relb[i] * LOG2E;
  if (tid < 64) {
    const int lane = tid;
    const float aq = wave_max(fabsf(mp.aqg[lane])), ak = wave_max(fabsf(mp.akg[lane]));
    const float cq = wave_max(fabsf(mp.cqg[lane & 31])), ck = wave_max(fabsf(mp.ckg[lane & 31]));
    const float d1 = wave_sum(lane < 32 ? mp.clam[lane] * mp.clam[32 + lane] : 0.f), d2 = wave_sum(lane < 32 ? mp.clam[64 + lane] * mp.clam[96 + lane] : 0.f);
    if (lane == 0) { red[0] = 8.0f * aq * ak * LOG2E * 1.02f; red[1] = 5.656854249f * cq * ck * LOG2E * 1.02f; red[2] = fexp(d1) - fexp(d2) + mp.lam_init; }
  }
  __syncthreads();
  if (tid < 256) { const int hh = tid >> 6, ln = tid & 63; float m = -1e30f;
#pragma unroll
    for (int i = 0; i < 5; ++i) { const int e = ln + 64 * i; if (e < 257) m = fmaxf(m, biasT[hh * 260 + e]); }
    m = wave_max(m); if (ln == 0) red[4 + hh] = m; }
  __syncthreads();
  const float MA = red[0], MC = red[1], lam = red[2];
  AttnParams ap = mp.ap;
  for (;;) {
    __syncthreads();
    if (tid == 0) misc[0] = (int)atomicAdd(mp.ctr, 1u);
    __syncthreads();
    const int it = misc[0];
    constexpr int NB2 = 17;
    if (it >= NB2 + 3 * 512) break;
    if (it < NB2) { b2_item(mp.DC, mp.SC, it, lds, tid); continue; }
    const int r = (it - NB2) & 511, kind = (it - NB2) >> 9, qb = 63 - (r >> 3), bh = r & 7, b = bh >> 2, h = bh & 3;
    if (kind == 0) { ap.negM = -MC; ap.lam = lam; ap.oscale = 1.0f - mp.lam_init; ap.cgain = mp.cog; attn_unit<1>(lds, ap, b, h, qb, tid); }
    else if (kind == 1) { attn_unit<2>(lds, ap, b, h, qb, tid); }
    else { ap.negM = -(MA + red[4 + h]); ap.biasL = biasT + h * 260; attn_unit<0>(lds, ap, b, h, qb, tid); }
  }
}

DI const float* ldp(const unsigned char* lds, int i) {
  const volatile unsigned* t = (const volatile unsigned*)(lds + pg8::STAGE_BYTES + 64);
  const unsigned lo = __builtin_amdgcn_readfirstlane(t[2 * i]), hi = __builtin_amdgcn_readfirstlane(t[2 * i + 1]);
  return (const float*)(((unsigned long long)hi << 32) | lo); }
DI int fresh_tid(int wave_s) { int lane; asm volatile("v_mbcnt_lo_u32_b32 %0, -1, 0\n\tv_mbcnt_hi_u32_b32 %0, -1, %0" : "=v"(lane)); return wave_s * 64 + lane; }

DI void gbar(unsigned* bw, unsigned& k, int tid) {
  ++k;
  asm volatile("s_waitcnt vmcnt(0)" ::: "memory");
  __syncthreads();
  if (tid == 0) {
    __builtin_amdgcn_fence(__ATOMIC_RELEASE, "agent");
    const unsigned G = gridDim.x, x = blockIdx.x & 7u, nloc = (G - x + 7u) >> 3, ngrp = G < 8u ? G : 8u;
    unsigned* xcnt = bw + 64 * x; unsigned* xgen = bw + 64 * (8 + x); unsigned* top = bw + 64 * 16; unsigned* topgen = bw + 64 * 17;
    const unsigned old = __hip_atomic_fetch_add(xcnt, 1u, __ATOMIC_RELAXED, __HIP_MEMORY_SCOPE_AGENT);
    if (old + 1u == k * nloc) {
      const unsigned o2 = __hip_atomic_fetch_add(top, 1u, __ATOMIC_RELAXED, __HIP_MEMORY_SCOPE_AGENT);
      if (o2 + 1u == k * ngrp) __hip_atomic_store(topgen, k, __ATOMIC_RELAXED, __HIP_MEMORY_SCOPE_AGENT);
      else while (__hip_atomic_load(topgen, __ATOMIC_RELAXED, __HIP_MEMORY_SCOPE_AGENT) < k) __builtin_amdgcn_s_sleep(1);
      __hip_atomic_store(xgen, k, __ATOMIC_RELAXED, __HIP_MEMORY_SCOPE_AGENT);
    } else {
      while (__hip_atomic_load(xgen, __ATOMIC_RELAXED, __HIP_MEMORY_SCOPE_AGENT) < k) __builtin_amdgcn_s_sleep(1);
    }
    __builtin_amdgcn_fence(__ATOMIC_ACQUIRE, "agent");
  }
  __syncthreads();
}
#define WSP(off) ((unsigned char*)ldp(lds, 24) + (off))
__global__ void __launch_bounds__(512) fwd_kernel(Args a) {
  extern __shared__ __attribute__((aligned(16))) unsigned char lds[];
  cg::grid_group grid = cg::this_grid();
  const int wave_s = __builtin_amdgcn_readfirstlane(threadIdx.x >> 6);
  if (threadIdx.x == 0) {
    const float** t = (const float**)(lds + pg8::STAGE_BYTES + 64);
#pragma unroll
    for (int i = 0; i < 23; ++i) t[i] = a.in[i];
    t[23] = a.out; t[24] = (const float*)a.ws;
  }
  if (blockIdx.x == 0) { unsigned* ctl = (unsigned*)(a.ws + WS_CTL); for (int i = threadIdx.x; i < 2048; i += 512) ctl[i] = 0u; }
  __syncthreads();
  unsigned bk = 0u;
  PG8_LAS unsigned char* ldsL = (PG8_LAS unsigned char*)lds;
  typedef pg8::StaticOrder SO;

  { Args a2;
#pragma unroll
    for (int i = 0; i < 23; ++i) a2.in[i] = ldp(lds, i);
    a2.out = nullptr; a2.ws = WSP(0);
    prologue_weights(a2, lds, fresh_tid(wave_s)); }
  cast_phase(ldp(lds, 0), (bf16_t*)WSP(WS_XN), (float*)WSP(WS_SS), fresh_tid(wave_s));
  grid.sync();
  for (int l = 0; l < NLAYER; ++l) {
    const size_t wlo = WS_W + (size_t)l * LW_SIZE;
    { const float* xin = (l == 0) ? ldp(lds, 0) : ldp(lds, 23); (void)xin;
      pg8::Gemm g{(bf16_t*)WSP(WS_XN), (const bf16_t*)WSP(wlo + LW_WGU1), T_, 2 * FF, DM}; SO S; S.init(T_, 2 * FF, gridDim.x, blockIdx.x); pg8::EpiSwiGLU E{(bf16_t*)WSP(WS_HP), FF, (const float*)WSP(WS_SS) + (size_t)(3 * l) * T_};
      pg8::gemm_phase<pg8::EpiSwiGLU, SO, true, true>(ldsL, g, S, E, fresh_tid(wave_s)); }
    gbar((unsigned*)WSP(WS_CTL) + 64, bk, fresh_tid(wave_s));
    { const float* xin = (l == 0) ? ldp(lds, 0) : ldp(lds, 23);
      pg8::Gemm g{(bf16_t*)WSP(WS_HP), (const bf16_t*)WSP(wlo + LW_WD1), T_, DM, FF}; SO S; S.init(T_, DM, gridDim.x, blockIdx.x); pg8::EpiResid E{xin, (float*)ldp(lds, 23), DM, 0.5f, (bf16_t*)WSP(WS_XN), (float*)WSP(WS_SS) + (size_t)(3 * l + 1) * T_};
      pg8::gemm_phase<pg8::EpiResid, SO, true, true>(ldsL, g, S, E, fresh_tid(wave_s)); }
    gbar((unsigned*)WSP(WS_CTL) + 64, bk, fresh_tid(wave_s));
    { pg8::Gemm g{(bf16_t*)WSP(WS_XN), (const bf16_t*)WSP(wlo + LW_WIN), T_, INP, DM}; SO S; S.init(T_, INP, gridDim.x, blockIdx.x); pg8::EpiBf16Lim E{(bf16_t*)WSP(WS_HP), PLD, PLD, (const float*)WSP(WS_SS) + (size_t)(3 * l + 1) * T_};
      pg8::gemm_phase<pg8::EpiBf16Lim, SO, true, true>(ldsL, g, S, E, fresh_tid(wave_s)); }
    gbar((unsigned*)WSP(WS_CTL) + 64, bk, fresh_tid(wave_s));
    { PrepParams pp{ldp(lds, 7) + l * 64, ldp(lds, 8) + l * 64, ldp(lds, 14) + l * 32, ldp(lds, 15) + l * 32, ldp(lds, 10) + l * 2048, ldp(lds, 11) + l * 512};
      prep_phase((bf16_t*)WSP(WS_HP), (bf16_t*)WSP(WS_BQ), (bf16_t*)WSP(WS_BK), (bf16_t*)WSP(WS_BKT), (bf16_t*)WSP(WS_VT), pp, lds, fresh_tid(wave_s)); }
    gbar((unsigned*)WSP(WS_CTL) + 64, bk, fresh_tid(wave_s));
    b1_phase((bf16_t*)WSP(WS_HP), (bf16_t*)WSP(WS_BKT), (bf16_t*)WSP(WS_VT) + (size_t)T_ * 256, (float*)WSP(WS_DC), (float*)WSP(WS_SC), ldp(lds, 12) + l * 8, lds, fresh_tid(wave_s));
    gbar((unsigned*)WSP(WS_CTL) + 64, bk, fresh_tid(wave_s));
    { const float lam_init = (l == 0) ? 0.2f : (0.8f - 0.6f * 0.7408182206817179f);
      MixParams mp; mp.ap.P = (bf16_t*)WSP(WS_HP); mp.ap.Vt = (bf16_t*)WSP(WS_VT); mp.ap.Y = (bf16_t*)WSP(WS_XN); mp.ap.biasL = nullptr; mp.ap.negM = 0.f; mp.ap.lam = 0.f; mp.ap.oscale = 1.f; mp.ap.cgain = nullptr;
      mp.DC = (float*)WSP(WS_DC); mp.SC = (float*)WSP(WS_SC); mp.relb = ldp(lds, 9) + l * 4 * 257; mp.aqg = ldp(lds, 7) + l * 64; mp.akg = ldp(lds, 8) + l * 64; mp.cqg = ldp(lds, 14) + l * 32; mp.ckg = ldp(lds, 15) + l * 32;
      mp.clam = ldp(lds, 16) + l * 128; mp.cog = ldp(lds, 17) + l * 64; mp.lam_init = lam_init; mp.ctr = (unsigned*)WSP(WS_CTL) + l;
      mix_phase(lds, mp, fresh_tid(wave_s)); }
    gbar((unsigned*)WSP(WS_CTL) + 64, bk, fresh_tid(wave_s));
    b3_phase((bf16_t*)WSP(WS_HP), (bf16_t*)WSP(WS_BQ), (bf16_t*)WSP(WS_BK), (bf16_t*)WSP(WS_VT) + (size_t)T_ * 256, (float*)WSP(WS_DC), (float*)WSP(WS_SC), ldp(lds, 12) + l * 8, ldp(lds, 13) + l * 256, (bf16_t*)WSP(WS_XN), lds, fresh_tid(wave_s));
    gbar((unsigned*)WSP(WS_CTL) + 64, bk, fresh_tid(wave_s));
    { float* xo = (float*)ldp(lds, 23);
      pg8::Gemm g{(bf16_t*)WSP(WS_XN), (const bf16_t*)WSP(wlo + LW_WOUT), T_, DM, DM}; SO S; S.init(T_, DM, gridDim.x, blockIdx.x); pg8::EpiResid E{xo, xo, DM, 1.0f, (bf16_t*)WSP(WS_BQ), (float*)WSP(WS_SS) + (size_t)(3 * l + 2) * T_};
      pg8::gemm_phase<pg8::EpiResid, SO, true, true>(ldsL, g, S, E, fresh_tid(wave_s)); }
    gbar((unsigned*)WSP(WS_CTL) + 64, bk, fresh_tid(wave_s));
    { pg8::Gemm g{(bf16_t*)WSP(WS_BQ), (const bf16_t*)WSP(wlo + LW_WGU2), T_, 2 * FF, DM}; SO S; S.init(T_, 2 * FF, gridDim.x, blockIdx.x); pg8::EpiSwiGLU E{(bf16_t*)WSP(WS_HP), FF, (const float*)WSP(WS_SS) + (size_t)(3 * l + 2) * T_};
      pg8::gemm_phase<pg8::EpiSwiGLU, SO, true, true>(ldsL, g, S, E, fresh_tid(wave_s)); }
    gbar((unsigned*)WSP(WS_CTL) + 64, bk, fresh_tid(wave_s));
    { float* xo = (float*)ldp(lds, 23);
      pg8::Gemm g{(bf16_t*)WSP(WS_HP), (const bf16_t*)WSP(wlo + LW_WD2), T_, DM, FF}; SO S; S.init(T_, DM, gridDim.x, blockIdx.x); pg8::EpiResid E{xo, xo, DM, 0.5f, (l + 1 < NLAYER) ? (bf16_t*)WSP(WS_XN) : nullptr, (float*)WSP(WS_SS) + (size_t)(3 * l + 3) * T_};
      pg8::gemm_phase<pg8::EpiResid, SO, true, true>(ldsL, g, S, E, fresh_tid(wave_s)); }
    if (l + 1 < NLAYER) gbar((unsigned*)WSP(WS_CTL) + 64, bk, fresh_tid(wave_s));
  }
}

extern "C" void kernel_launch(void* const* d_in, const int* in_sizes, int n_in, void* d_out, int out_size, void* d_ws, size_t ws_size, hipStream_t stream) {
  static int grid = 0;
  if (grid == 0) {
    if (n_in != 23 || out_size != T_ * DM || ws_size < WS_END) { fprintf(stderr, "kernel_launch: unexpected problem (n_in %d out %d ws %zu need %zu)\n", n_in, out_size, ws_size, (size_t)WS_END); grid = -1; return; }
    int dev = 0, cus = 0, per_cu = 0;
    hipGetDevice(&dev); hipDeviceGetAttribute(&cus, hipDeviceAttributeMultiprocessorCount, dev);
    if (hipFuncSetAttribute((const void*)fwd_kernel, hipFuncAttributeMaxDynamicSharedMemorySize, LDS_BYTES) != hipSuccess) fprintf(stderr, "kernel_launch: hipFuncSetAttribute failed\n");
    if (hipOccupancyMaxActiveBlocksPerMultiprocessor(&per_cu, (const void*)fwd_kernel, 512, LDS_BYTES) != hipSuccess || per_cu < 1) { fprintf(stderr, "kernel_launch: occupancy query gave %d\n", per_cu); per_cu = 1; }
    (void)hipGetLastError();
    grid = cus * per_cu;
  }
  if (grid < 0) return;
  Args a{};
  for (int i = 0; i < 23; ++i) a.in[i] = (const float*)d_in[i];
  a.out = (float*)d_out; a.ws = (unsigned char*)d_ws;
  void* args[] = {&a};
  hipError_t e = hipLaunchCooperativeKernel((const void*)fwd_kernel, dim3(grid), dim3(512), args, LDS_BYTES, stream);
  if (e != hipSuccess) fprintf(stderr, "cooperative launch failed: %s (grid %d)\n", hipGetErrorString(e), grid);
}
```

```cpp
#include <hip/hip_runtime.h>
#include <hip/hip_cooperative_groups.h>
#include <cstdio>
#include <cstdint>
namespace cg = cooperative_groups;

namespace pg8 {
#define PG8_LAS __attribute__((address_space(3)))
typedef unsigned short bf16_t;
typedef short bf16x8 __attribute__((ext_vector_type(8)));
typedef float f32x4 __attribute__((ext_vector_type(4)));
typedef unsigned u32x4 __attribute__((ext_vector_type(4)));
constexpr int BM = 256, BK = 64, HALF = 128, HTB = HALF * BK * 2  , STAGE_BYTES = 8 * HTB, NXCD = 8, WGM = 4;

__host__ __device__ __forceinline__ int lds_byte(int r, int c) { const int st = (r >> 4) * 2 + (c >> 5), rr = r & 15, cc = c & 31, ob = rr * 64 + cc * 2; return st * 1024 + (ob ^ (((ob >> 9) & 1) << 5)); }
__host__ __device__ __forceinline__ void stage_rc(int b, int& R, int& C) { const int st = b / 1024, sb = b % 1024, swz = sb ^ (((sb >> 9) & 1) << 5); R = (st >> 1) * 16 + swz / 64; C = (st & 1) * 32 + (swz % 64) / 2; }
__host__ __device__ __forceinline__ int perm32(int rho) { const int n = rho >> 4, i = rho & 15; return 8 * (i >> 2) + 4 * n + (i & 3); }

struct Unit { int pm, pn; };
struct Gemm { const bf16_t* A; const bf16_t* Bt; int M, N, K; };

struct StaticOrder {
    int nM, nN, nwg, G, c;
    __host__ __device__ void init(int M, int N, int G_, int c_) { nM = M / BM; nN = N / BM; nwg = nM * nN; G = G_; c = c_; }
    __host__ __device__ bool next(int i, Unit& u) const {
        const long L = (long)i * G + c; if (L >= nwg) return false;
        int wgid = (int)L; { const int q = nwg / NXCD, r = nwg % NXCD, xcd = wgid % NXCD, off = wgid / NXCD; wgid = (xcd < r ? xcd * (q + 1) : r * (q + 1) + (xcd - r) * q) + off; }
        const int nig = WGM * nN, gid = wgid / nig, fm = gid * WGM, gsz = (nM - fm) < WGM ? (nM - fm) : WGM;
        u.pm = fm + ((wgid % nig) % gsz); u.pn = (wgid % nig) / gsz; return true;
    }
    __device__ __forceinline__ void a_ready(const Unit&) const {}
    __device__ __forceinline__ void done(const Unit&) const {}
};


typedef float f32x2_t __attribute__((ext_vector_type(2))); typedef __bf16 bf16x2_t __attribute__((ext_vector_type(2)));
__device__ __forceinline__ unsigned cvt_pk_bf16(float lo, float hi) { f32x2_t v = {lo, hi}; bf16x2_t b = __builtin_convertvector(v, bf16x2_t); return __builtin_bit_cast(unsigned, b); }
__device__ __forceinline__ float silu_f(float x) { return x * __builtin_amdgcn_rcpf(1.0f + __builtin_amdgcn_exp2f(-1.4426950408889634f * x)); }

struct EpiBf16Lim {
    static constexpr bool PERM = true, AFTER_DRAIN = false;
    bf16_t* O; int ldc; int ncols; const float* ss;
    __device__ __forceinline__ void operator()(const f32x4 (&acc)[2][2][4][2], const Unit& u, int wr, int wc, int fr, int fq) const {
        const int row0 = u.pm * BM + wr * 64 + fr; const int col0 = u.pn * BM + wc * 32 + 8 * fq;
        float rsv[2][4];
#pragma unroll
        for (int ai = 0; ai < 2; ++ai)
#pragma unroll
            for (int m = 0; m < 4; ++m) rsv[ai][m] = ss[row0 + ai * HALF + m * 16];
#pragma unroll
        for (int ai = 0; ai < 2; ++ai)
#pragma unroll
            for (int m = 0; m < 4; ++m) { bf16_t* rowp = O + (size_t)(row0 + ai * HALF + m * 16) * ldc + col0;
                const float rs = __builtin_amdgcn_rsqf(rsv[ai][m] * (1.0f / 1024.0f) + 1e-6f);
#pragma unroll
                for (int bj = 0; bj < 2; ++bj) { const f32x4 v0 = acc[ai][bj][m][0] * rs, v1 = acc[ai][bj][m][1] * rs;
                    u32x4 w; w.x = cvt_pk_bf16(v0[0], v0[1]); w.y = cvt_pk_bf16(v0[2], v0[3]); w.z = cvt_pk_bf16(v1[0], v1[1]); w.w = cvt_pk_bf16(v1[2], v1[3]);
                    if (col0 + bj * HALF < ncols) *(u32x4*)(rowp + bj * HALF) = w; } }
    }
};
struct EpiSwiGLU {
    static constexpr bool PERM = true, AFTER_DRAIN = false;
    bf16_t* O; int ldc; const float* ss;
    __device__ __forceinline__ void operator()(const f32x4 (&acc)[2][2][4][2], const Unit& u, int wr, int wc, int fr, int fq) const {
        const int row0 = u.pm * BM + wr * 64 + fr; const int col0 = u.pn * HALF + wc * 32 + 8 * fq;
        float rsv[2][4];
#pragma unroll
        for (int ai = 0; ai < 2; ++ai)
#pragma unroll
            for (int m = 0; m < 4; ++m) rsv[ai][m] = ss[row0 + ai * HALF + m * 16];
#pragma unroll
        for (int ai = 0; ai < 2; ++ai)
#pragma unroll
            for (int m = 0; m < 4; ++m) { bf16_t* rowp = O + (size_t)(row0 + ai * HALF + m * 16) * ldc + col0;
                const float rs = __builtin_amdgcn_rsqf(rsv[ai][m] * (1.0f / 1024.0f) + 1e-6f);
                const f32x4 g0 = acc[ai][0][m][0] * rs, g1 = acc[ai][0][m][1] * rs, u0 = acc[ai][1][m][0] * rs, u1 = acc[ai][1][m][1] * rs;
                u32x4 w;
                w.x = cvt_pk_bf16(silu_f(g0[0]) * u0[0], silu_f(g0[1]) * u0[1]); w.y = cvt_pk_bf16(silu_f(g0[2]) * u0[2], silu_f(g0[3]) * u0[3]);
                w.z = cvt_pk_bf16(silu_f(g1[0]) * u1[0], silu_f(g1[1]) * u1[1]); w.w = cvt_pk_bf16(silu_f(g1[2]) * u1[2], silu_f(g1[3]) * u1[3]);
                *(u32x4*)rowp = w; }
    }
};
typedef unsigned u32x2v __attribute__((ext_vector_type(2)));
struct EpiResid {
    static constexpr bool PERM = true, AFTER_DRAIN = false;
    const float* base; float* out; int ldc; float alpha; bf16_t* xb; float* ss;
    __device__ __forceinline__ void operator()(const f32x4 (&acc)[2][2][4][2], const Unit& u, int wr, int wc, int fr, int fq) const {
        const int row0 = u.pm * BM + wr * 64 + fr; const int col0 = u.pn * BM + wc * 32 + 8 * fq;
#pragma unroll
        for (int ai = 0; ai < 2; ++ai) {
            f32x4 pre[4][2][2];
#pragma unroll
            for (int m = 0; m < 4; ++m) { const size_t off = (size_t)(row0 + ai * HALF + m * 16) * ldc + col0;
#pragma unroll
                for (int bj = 0; bj < 2; ++bj)
#pragma unroll
                    for (int n = 0; n < 2; ++n) pre[m][bj][n] = *(const f32x4*)(base + off + bj * HALF + n * 4); }
#pragma unroll
            for (int m = 0; m < 4; ++m) { const size_t off = (size_t)(row0 + ai * HALF + m * 16) * ldc + col0; float q = 0.f;
#pragma unroll
                for (int bj = 0; bj < 2; ++bj) { const f32x4 o0 = pre[m][bj][0] + acc[ai][bj][m][0] * alpha, o1 = pre[m][bj][1] + acc[ai][bj][m][1] * alpha;
                    *(f32x4*)(out + off + bj * HALF) = o0; *(f32x4*)(out + off + bj * HALF + 4) = o1;
                    if (xb) { q += ((o0[0] * o0[0] + o0[1] * o0[1]) + (o0[2] * o0[2] + o0[3] * o0[3])) + ((o1[0] * o1[0] + o1[1] * o1[1]) + (o1[2] * o1[2] + o1[3] * o1[3]));
                        u32x4 w; w.x = cvt_pk_bf16(o0[0], o0[1]); w.y = cvt_pk_bf16(o0[2], o0[3]); w.z = cvt_pk_bf16(o1[0], o1[1]); w.w = cvt_pk_bf16(o1[2], o1[3]); *(u32x4*)(xb + off + bj * HALF) = w; } }
                if (xb) { q += __shfl_xor(q, 16); q += __shfl_xor(q, 32); if (fq == 0) atomicAdd(ss + row0 + ai * HALF + m * 16, q); } }
        }
    }
};

template <class Epi, class Sched, bool ALIGN_EPI = false, bool SP2 = false>
__device__ __forceinline__ void gemm_phase(PG8_LAS unsigned char* lds, const Gemm g, const Sched& S, const Epi& E, int tid_in) {
    int tid_l = tid_in; asm volatile("" : "+v"(tid_l)); const int tid = tid_l, wid = __builtin_amdgcn_readfirstlane(tid >> 6), lane = tid & 63, wr = wid >> 2, wc = wid & 3, fr = lane & 15, fq = lane >> 4;
    const int K = g.K, nt = K / BK;
    unsigned voffA[2], voffB[2];
#pragma unroll
    for (int i = 0; i < 2; ++i) { int R, C; stage_rc(tid * 16 + i * 8192, R, C); const int Rb = Epi::PERM ? ((R & ~31) + perm32(R & 31)) : R;
        voffA[i] = (unsigned)(R * K + C) * 2u; voffB[i] = (unsigned)(Rb * K + C) * 2u; }
    const size_t kstep = (size_t)(BK * 2);
    const size_t hstep = (size_t)HALF * K * 2;
    const size_t tstep = 2 * hstep;
    const unsigned ldsw = (unsigned)wid * 1024u;
    const int aoff = lds_byte(wr * 64 + fr, fq * 8), boff = lds_byte(wc * 32 + fr, fq * 8);
#define PG8_SA(b, h) (((b) * 2 + (h)) * HTB)
#define PG8_SB(b, h) ((4 + (b) * 2 + (h)) * HTB)
#define PG8_STAGE(bufoff, gbase, voff) do { _Pragma("unroll") for (int _i = 0; _i < 2; ++_i) \
        __builtin_amdgcn_global_load_lds((const unsigned*)((const char*)(gbase) + (voff)[_i]), (PG8_LAS unsigned*)(lds + (bufoff) + ldsw + _i * 8192), 16, 0, 0); } while (0)
#define PG8_LDA(dst, b, h) do { _Pragma("unroll") for (int m = 0; m < 4; ++m) _Pragma("unroll") for (int k = 0; k < 2; ++k) dst[m][k] = *(const PG8_LAS bf16x8*)(lds + PG8_SA(b, h) + aoff + m * 2048 + k * 1024); } while (0)
#define PG8_LDB(dst, b, h) do { _Pragma("unroll") for (int n = 0; n < 2; ++n) _Pragma("unroll") for (int k = 0; k < 2; ++k) dst[n][k] = *(const PG8_LAS bf16x8*)(lds + PG8_SB(b, h) + boff + n * 2048 + k * 1024); } while (0)
#define PG8_MMA(ai, bj, At, Bt) do { __builtin_amdgcn_s_setprio(1); _Pragma("unroll") for (int m = 0; m < 4; ++m) _Pragma("unroll") for (int n = 0; n < 2; ++n) _Pragma("unroll") for (int k = 0; k < 2; ++k) \
        acc[ai][bj][m][n] = __builtin_amdgcn_mfma_f32_16x16x32_bf16(Bt[n][k], At[m][k], acc[ai][bj][m][n], 0, 0, 0); __builtin_amdgcn_s_setprio(0); } while (0)
#define PG8_WAIT_V(n) asm volatile("s_waitcnt vmcnt(" #n ")" ::: "memory")
#define PG8_WAIT_L(n) asm volatile("s_waitcnt lgkmcnt(" #n ")" ::: "memory")
#define PG8_BAR __builtin_amdgcn_s_barrier()
#define PG8_SCHED __builtin_amdgcn_sched_barrier(0)
    Unit cur, nxt; int ui = 0;
    if (!S.next(0, cur)) return;
    f32x4 acc[2][2][4][2];
#pragma unroll
    for (int a = 0; a < 2; ++a)
#pragma unroll
        for (int b = 0; b < 2; ++b)
#pragma unroll
            for (int m = 0; m < 4; ++m)
#pragma unroll
                for (int n = 0; n < 2; ++n) acc[a][b][m][n] = (f32x4){0.f, 0.f, 0.f, 0.f};
    bf16x8 At[4][2], B0[2][2], B1[2][2];
    const char* cA = (const char*)g.A + (size_t)cur.pm * tstep; const char* cB = (const char*)g.Bt + (size_t)cur.pn * tstep;
    S.a_ready(cur);
    if constexpr (SP2) {
        PG8_STAGE(PG8_SB(0, 0), cB, voffB); PG8_STAGE(PG8_SB(0, 1), cB + hstep, voffB); PG8_STAGE(PG8_SA(0, 0), cA, voffA); PG8_STAGE(PG8_SA(0, 1), cA + hstep, voffA);
        if (wr == 1) PG8_BAR;
        PG8_WAIT_V(2); PG8_BAR;
        PG8_STAGE(PG8_SB(1, 0), cB + kstep, voffB); PG8_STAGE(PG8_SA(1, 0), cA + kstep, voffA); PG8_STAGE(PG8_SB(1, 1), cB + hstep + kstep, voffB);
        PG8_WAIT_V(6); PG8_BAR;
    } else {
        PG8_STAGE(PG8_SB(0, 0), cB, voffB); PG8_STAGE(PG8_SA(0, 0), cA, voffA); PG8_STAGE(PG8_SB(0, 1), cB + hstep, voffB); PG8_STAGE(PG8_SA(0, 1), cA + hstep, voffA);
        if (wr == 1) PG8_BAR;
        PG8_WAIT_V(4); PG8_BAR;
        PG8_STAGE(PG8_SB(1, 0), cB + kstep, voffB); PG8_STAGE(PG8_SA(1, 0), cA + kstep, voffA); PG8_STAGE(PG8_SB(1, 1), cB + hstep + kstep, voffB);
        PG8_WAIT_V(6); PG8_BAR;
    }
    for (;;) {
        const bool has_next = S.next(ui + 1, nxt);
        const char* nA = has_next ? (const char*)g.A + (size_t)nxt.pm * tstep : cA; const char* nB = has_next ? (const char*)g.Bt + (size_t)nxt.pn * tstep : cB;
        for (int t = 0; t < nt; t += 2) {
            const bool last = (t == nt - 2);
            const char* a1 = cA + (size_t)(t + 1) * kstep;
            const char* a2 = last ? nA : cA + (size_t)(t + 2) * kstep; const char* b2 = last ? nB : cB + (size_t)(t + 2) * kstep;
            const char* a3 = a2 + kstep; const char* b3 = b2 + kstep;
            if (last && has_next) S.a_ready(nxt);
            if constexpr (SP2) {
            PG8_LDB(B0, 0, 0); PG8_LDB(B1, 0, 1); PG8_SCHED; PG8_LDA(At, 0, 0); PG8_STAGE(PG8_SA(1, 1), a1 + hstep, voffA);
            PG8_WAIT_V(8); PG8_WAIT_L(0); PG8_BAR; PG8_MMA(0, 0, At, B0); PG8_MMA(0, 1, At, B1); PG8_BAR; PG8_SCHED;
            PG8_LDA(At, 0, 1); PG8_STAGE(PG8_SB(0, 0), b2, voffB); PG8_STAGE(PG8_SB(0, 1), b2 + hstep, voffB); PG8_STAGE(PG8_SA(0, 0), a2, voffA);
            PG8_WAIT_V(8); PG8_WAIT_L(0); PG8_BAR; PG8_MMA(1, 0, At, B0); PG8_MMA(1, 1, At, B1); PG8_BAR; PG8_SCHED;
            PG8_LDB(B0, 1, 0); PG8_LDB(B1, 1, 1); PG8_SCHED; PG8_LDA(At, 1, 0); PG8_STAGE(PG8_SA(0, 1), a2 + hstep, voffA);
            PG8_WAIT_V(8); PG8_WAIT_L(0); PG8_BAR; PG8_MMA(0, 0, At, B0); PG8_MMA(0, 1, At, B1); PG8_BAR; PG8_SCHED;
            PG8_LDA(At, 1, 1); PG8_STAGE(PG8_SB(1, 0), b3, voffB); PG8_STAGE(PG8_SB(1, 1), b3 + hstep, voffB); PG8_STAGE(PG8_SA(1, 0), a3, voffA);
            PG8_WAIT_V(8); PG8_WAIT_L(0); PG8_BAR; PG8_MMA(1, 0, At, B0); PG8_MMA(1, 1, At, B1); PG8_BAR; PG8_SCHED;
            } else {
            PG8_LDB(B0, 0, 0); PG8_SCHED; PG8_LDA(At, 0, 0); PG8_STAGE(PG8_SA(1, 1), a1 + hstep, voffA);
            PG8_WAIT_L(8); PG8_BAR; PG8_WAIT_L(0); PG8_MMA(0, 0, At, B0); PG8_BAR; PG8_SCHED;
            PG8_LDB(B1, 0, 1); PG8_STAGE(PG8_SB(0, 0), b2, voffB);
            PG8_BAR; PG8_WAIT_L(0); PG8_MMA(0, 1, At, B1); PG8_BAR;
            PG8_LDA(At, 0, 1); PG8_STAGE(PG8_SA(0, 0), a2, voffA);
            PG8_BAR; PG8_WAIT_L(0); PG8_MMA(1, 0, At, B0); PG8_BAR; PG8_SCHED;
            PG8_STAGE(PG8_SB(0, 1), b2 + hstep, voffB);
            PG8_WAIT_V(6); PG8_BAR; PG8_MMA(1, 1, At, B1); PG8_BAR;
            PG8_LDB(B0, 1, 0); PG8_SCHED; PG8_LDA(At, 1, 0); PG8_STAGE(PG8_SA(0, 1), a2 + hstep, voffA);
            PG8_WAIT_L(8); PG8_BAR; PG8_WAIT_L(0); PG8_MMA(0, 0, At, B0); PG8_BAR; PG8_SCHED;
            PG8_LDB(B1, 1, 1); PG8_STAGE(PG8_SB(1, 0), b3, voffB);
            PG8_BAR; PG8_WAIT_L(0); PG8_MMA(0, 1, At, B1); PG8_BAR;
            PG8_LDA(At, 1, 1); PG8_STAGE(PG8_SA(1, 0), a3, voffA);
            PG8_BAR; PG8_WAIT_L(0); PG8_MMA(1, 0, At, B0); PG8_BAR; PG8_SCHED;
            PG8_STAGE(PG8_SB(1, 1), b3 + hstep, voffB);
            PG8_WAIT_V(6); PG8_BAR; PG8_MMA(1, 1, At, B1); PG8_BAR;
            }
        }
        if constexpr (ALIGN_EPI) { if (wr == 0) PG8_BAR; }
        if constexpr (!Epi::AFTER_DRAIN) { E(acc, cur, wr, wc, fr, fq); S.done(cur); }
        if (!has_next) break;
#pragma unroll
        for (int a = 0; a < 2; ++a)
#pragma unroll
            for (int b = 0; b < 2; ++b)
#pragma unroll
                for (int m = 0; m < 4; ++m)
#pragma unroll
                    for (int n = 0; n < 2; ++n) acc[a][b][m][n] = (f32x4){0.f, 0.f, 0.f, 0.f};
        cur = nxt; cA = nA; cB = nB; ++ui;
        if constexpr (ALIGN_EPI) { if (wr == 1) PG8_BAR; }
    }
    PG8_WAIT_V(0);
    if constexpr (!ALIGN_EPI) { if (wr == 0) PG8_BAR; }
    PG8_BAR;
    if constexpr (Epi::AFTER_DRAIN) { E.fused(acc, cur, wr, wc, fr, fq, lds, wid, lane); S.done(cur); }
#undef PG8_SA
#undef PG8_SB
#undef PG8_STAGE
#undef PG8_LDA
#undef PG8_LDB
#undef PG8_MMA
#undef PG8_WAIT_V
#undef PG8_WAIT_L
#undef PG8_BAR
#undef PG8_SCHED
}
}

typedef unsigned short bf16_t;
typedef short bf16x8 __attribute__((ext_vector_type(8)));
typedef short s16x4 __attribute__((ext_vector_type(4)));
typedef float f32x4 __attribute__((ext_vector_type(4)));
typedef float f32x16 __attribute__((ext_vector_type(16)));
typedef unsigned u32x4 __attribute__((ext_vector_type(4)));
typedef unsigned u32x2 __attribute__((ext_vector_type(2)));
#define DI __device__ __forceinline__
#define LAUNDER(x) asm volatile("" : "+v"(x))

constexpr int T_ = 32768, DM = 1024, FF = 2816, SEQ = 16384, NLAYER = 2;
constexpr int INC = 3336, INP = 3584, PLD = 3344;
constexpr int C_AQ = 0, C_AK = 256, C_AV = 512, C_BQ = 768, C_BK = 1024, C_BV = 1280, C_BO = 1536, C_CQ = 1792, C_CK = 2048, C_CV = 2304, C_DQ = 2560, C_DK = 2816, C_DV = 3072, C_GI = 3328, C_GF = 3332;
constexpr float LOG2E = 1.4426950408889634f, EPS_ = 1e-6f;
#ifndef D_EARLY
#define D_EARLY 1
#endif

constexpr size_t SZ_WGU = (size_t)2 * FF * DM * 2, SZ_WD = (size_t)DM * FF * 2, SZ_WIN = (size_t)INP * DM * 2, SZ_WOUT = (size_t)DM * DM * 2;
constexpr size_t LW_WGU1 = 0, LW_WD1 = LW_WGU1 + SZ_WGU, LW_WIN = LW_WD1 + SZ_WD, LW_WOUT = LW_WIN + SZ_WIN, LW_WGU2 = LW_WOUT + SZ_WOUT, LW_WD2 = LW_WGU2 + SZ_WGU, LW_SIZE = LW_WD2 + SZ_WD;
constexpr size_t WS_CTL = 0, WS_W = 8192, WS_XN = WS_W + NLAYER * LW_SIZE, WS_HP = WS_XN + (size_t)T_ * DM * 2, WS_BQ = WS_HP + (size_t)T_ * PLD * 2,
                 WS_BK = WS_BQ + (size_t)T_ * 256 * 2, WS_BKT = WS_BK + (size_t)T_ * 256 * 2, WS_VT = WS_BKT + (size_t)T_ * 256 * 2, WS_DC = WS_VT + (size_t)4 * T_ * 256 * 2,
                 WS_SC = WS_DC + (size_t)8 * 256 * 4160 * 4, WS_SS = WS_SC + 3 * 8 * 256 * 4, WS_END = WS_SS + (size_t)7 * T_ * 4;
static_assert(WS_XN % 256 == 0 && WS_HP % 256 == 0 && WS_BQ % 256 == 0 && WS_DC % 256 == 0 && (size_t)T_ * FF * 2 <= (size_t)T_ * PLD * 2, "ws map");
constexpr int LDS_BYTES = pg8::STAGE_BYTES + 1024;

DI unsigned pk2(float a, float b) { return pg8::cvt_pk_bf16(a, b); }
DI float bf2f(bf16_t h) { return __uint_as_float((unsigned)h << 16); }
DI float bflo(unsigned w) { return __uint_as_float(w << 16); }
DI float bfhi(unsigned w) { return __uint_as_float(w & 0xffff0000u); }
DI float ex2(float x) { return __builtin_amdgcn_exp2f(x); }
DI float lg2(float x) { return __builtin_amdgcn_logf(x); }
DI float rcpf_(float x) { return __builtin_amdgcn_rcpf(x); }
DI int crow(int r, int hi) { return (r & 3) + 8 * (r >> 2) + 4 * hi; }
#define MFMA32(a, b, c) __builtin_amdgcn_mfma_f32_32x32x16_bf16((a), (b), (c), 0, 0, 0)
DI f32x16 splat16(float v) { f32x16 r;
#pragma unroll
  for (int i = 0; i < 16; ++i) r[i] = v; return r; }
DI bf16x8 pack8(const f32x16& s, int kk) {
  u32x4 p; p.x = pk2(s[8 * kk], s[8 * kk + 1]); p.y = pk2(s[8 * kk + 2], s[8 * kk + 3]); p.z = pk2(s[8 * kk + 4], s[8 * kk + 5]); p.w = pk2(s[8 * kk + 6], s[8 * kk + 7]);
  return __builtin_bit_cast(bf16x8, p); }
DI bf16x8 cat4(s16x4 lo, s16x4 hi) { return __builtin_shufflevector(lo, hi, 0, 1, 2, 3, 4, 5, 6, 7); }

struct Args { const float* in[23]; float* out; unsigned char* ws; };

struct TDesc { const float* W0; const float* W1; const float* gk; bf16_t* WT; int kind, K, N, kt, nt; };
DI TDesc tt_decode(const Args& a, int it) {
  constexpr int I_GU = 16 * 88, I_D = 44 * 16, I_IN = 16 * 56, I_OUT = 16 * 16, I_L = 2 * I_GU + 2 * I_D + I_IN + I_OUT;
  const int l = it / I_L; int r = it % I_L; unsigned char* wl = a.ws + WS_W + (size_t)l * LW_SIZE; TDesc d;
  if (r < I_GU) { d.W0 = a.in[2] + (size_t)l * DM * FF; d.W1 = a.in[3] + (size_t)l * DM * FF; d.gk = a.in[1] + l * DM; d.WT = (bf16_t*)(wl + LW_WGU1); d.kind = 0; d.K = DM; d.N = FF; d.kt = r / 88; d.nt = r % 88; return d; } r -= I_GU;
  if (r < I_D) { d.W0 = a.in[4] + (size_t)l * FF * DM; d.W1 = nullptr; d.gk = nullptr; d.WT = (bf16_t*)(wl + LW_WD1); d.kind = 1; d.K = FF; d.N = DM; d.kt = r / 16; d.nt = r % 16; return d; } r -= I_D;
  if (r < I_IN) { d.W0 = a.in[6] + (size_t)l * DM * INC; d.W1 = nullptr; d.gk = a.in[5] + l * DM; d.WT = (bf16_t*)(wl + LW_WIN); d.kind = 2; d.K = DM; d.N = INC; d.kt = r / 56; d.nt = r % 56; return d; } r -= I_IN;
  if (r < I_OUT) { d.W0 = a.in[18] + (size_t)l * DM * DM; d.W1 = nullptr; d.gk = nullptr; d.WT = (bf16_t*)(wl + LW_WOUT); d.kind = 1; d.K = DM; d.N = DM; d.kt = r / 16; d.nt = r % 16; return d; } r -= I_OUT;
  if (r < I_GU) { d.W0 = a.in[20] + (size_t)l * DM * FF; d.W1 = a.in[21] + (size_t)l * DM * FF; d.gk = a.in[19] + l * DM; d.WT = (bf16_t*)(wl + LW_WGU2); d.kind = 0; d.K = DM; d.N = FF; d.kt = r / 88; d.nt = r % 88; return d; } r -= I_GU;
  d.W0 = a.in[22] + (size_t)l * FF * DM; d.W1 = nullptr; d.gk = nullptr; d.WT = (bf16_t*)(wl + LW_WD2); d.kind = 1; d.K = FF; d.N = DM; d.kt = r / 16; d.nt = r % 16; return d;
}
DI void tt_load(const TDesc& d, f32x4 (&v)[2], int tid) {
  const int n4 = tid & 15, np = d.nt * 64 + 4 * n4, k0 = d.kt * 64; const float* src = d.W0; int col;
  if (d.kind == 0) { const int pn = np >> 8, r = np & 255; src = (r < 128) ? d.W0 : d.W1; col = 128 * pn + (r & 127); }
  else if (d.kind == 1) col = np;
  else col = (np < 1792) ? np : (np < 3328) ? np + 8 : (np < 3336) ? 1792 + (np - 3328) : -1;
#pragma unroll
  for (int p = 0; p < 2; ++p) { const int kk = (tid >> 4) + 32 * p;
    v[p] = (col >= 0) ? *(const f32x4*)(src + (size_t)(k0 + kk) * d.N + col) * (d.gk ? d.gk[k0 + kk] : 1.f) : (f32x4){0.f, 0.f, 0.f, 0.f}; }
}
DI void prologue_weights(const Args& a, unsigned char* lds, int tid) {
  LAUNDER(tid);
  constexpr int NI = 6, NITEMS = NLAYER * (2 * 16 * 88 + 2 * 44 * 16 + 16 * 56 + 16 * 16);
  for (int it0 = blockIdx.x; it0 < NITEMS; it0 += NI * gridDim.x) {
    f32x4 v[NI][2]; TDesc d[NI];
#pragma unroll
    for (int q = 0; q < NI; ++q) { const int it = it0 + q * gridDim.x; if (it < NITEMS) { d[q] = tt_decode(a, it); tt_load(d[q], v[q], tid); } }
#pragma unroll
    for (int q = 0; q < NI; ++q) { float* scr = (float*)lds + q * (64 * 65);
#pragma unroll
      for (int p = 0; p < 2; ++p) { float* w = scr + ((tid >> 4) + 32 * p) * 65 + 4 * (tid & 15); w[0] = v[q][p].x; w[1] = v[q][p].y; w[2] = v[q][p].z; w[3] = v[q][p].w; } }
    __syncthreads();
#pragma unroll
    for (int q = 0; q < NI; ++q) { const int it = it0 + q * gridDim.x; if (it < NITEMS) {
      const int n = tid >> 3, kc = tid & 7; const float* sp = (const float*)lds + q * (64 * 65) + (8 * kc) * 65 + n;
      u32x4 o; o.x = pk2(sp[0], sp[65]); o.y = pk2(sp[2 * 65], sp[3 * 65]); o.z = pk2(sp[4 * 65], sp[5 * 65]); o.w = pk2(sp[6 * 65], sp[7 * 65]);
      *(u32x4*)(d[q].WT + (size_t)(d[q].nt * 64 + n) * d[q].K + d[q].kt * 64 + 8 * kc) = o; } }
    __syncthreads();
  }
}

DI float wave_sum(float v) {
#pragma unroll
  for (int o = 1; o < 64; o <<= 1) v += __shfl_xor(v, o);
  return v; }
DI float wave_max(float v) {
#pragma unroll
  for (int o = 1; o < 64; o <<= 1) v = fmaxf(v, __shfl_xor(v, o));
  return v; }
DI void cast_phase(const float* x, bf16_t* xb, float* ss, int tid) {
  LAUNDER(tid);
  const int lane = tid & 63, gw = blockIdx.x * 8 + (tid >> 6), ngw = gridDim.x * 8;
  for (int i = blockIdx.x * 512 + tid; i < 6 * T_; i += gridDim.x * 512) ss[T_ + i] = 0.f;
  for (int m0 = gw; m0 < T_; m0 += 2 * ngw) {
    f32x4 v[2][4];
#pragma unroll
    for (int r = 0; r < 2; ++r) { const int m = m0 + r * ngw; if (m < T_) { const f32x4* xr = (const f32x4*)(x + (size_t)m * DM) + lane;
#pragma unroll
      for (int j = 0; j < 4; ++j) v[r][j] = xr[64 * j]; } }
#pragma unroll
    for (int r = 0; r < 2; ++r) { const int m = m0 + r * ngw; if (m < T_) { float q = 0.f;
#pragma unroll
      for (int j = 0; j < 4; ++j) q += (v[r][j].x * v[r][j].x + v[r][j].y * v[r][j].y) + (v[r][j].z * v[r][j].z + v[r][j].w * v[r][j].w);
      q = wave_sum(q); if (lane == 0) ss[m] = q;
      u32x2* o = (u32x2*)(xb + (size_t)m * DM) + lane;
#pragma unroll
      for (int j = 0; j < 4; ++j) { u32x2 w; w.x = pk2(v[r][j].x, v[r][j].y); w.y = pk2(v[r][j].z, v[r][j].w); o[64 * j] = w; } } }
  }
}

struct PrepParams { const float *aqg, *akg, *cqg, *ckg, *convw, *convb; };
DI void prep_phase(bf16_t* P, bf16_t* BQ, bf16_t* BK, bf16_t* BKt, bf16_t* Vt, const PrepParams& pp, unsigned char* lds, int tid) {
  LAUNDER(tid);
  float* gt = (float*)lds;
  if (tid < 64) { gt[tid] = pp.aqg[tid]; gt[64 + tid] = pp.akg[tid]; gt[128 + tid] = pp.cqg[tid & 31]; gt[192 + tid] = pp.ckg[tid & 31]; gt[256 + tid] = 1.f; }
  __syncthreads();
  for (int tile = blockIdx.x; tile < T_ / 64; tile += gridDim.x) {
    const int tok0 = tile * 64, b = tok0 / SEQ, s0 = tok0 % SEQ;
    for (int id0 = tid; id0 < 64 * 160; id0 += 10 * 512) {
      u32x4 w4[10]; bf16_t* p4[10];
#pragma unroll
      for (int u = 0; u < 10; ++u) { const int id = id0 + 512 * u, tk = id / 160, ci = id % 160, seg = ci >> 5, within = (ci & 31) * 8;
        const int colb = (seg == 0) ? C_AQ : (seg == 1) ? C_AK : (seg == 2) ? C_CQ : (seg == 3) ? C_CK : C_DQ;
        p4[u] = P + (size_t)(tok0 + tk) * PLD + colb + within; w4[u] = *(const u32x4*)p4[u]; }
#pragma unroll
      for (int u = 0; u < 10; ++u) { const int id = id0 + 512 * u, ci = id % 160, seg = ci >> 5, within = (ci & 31) * 8;
        const u32x4 w = w4[u]; float v[8];
        v[0] = bflo(w.x); v[1] = bfhi(w.x); v[2] = bflo(w.y); v[3] = bfhi(w.y); v[4] = bflo(w.z); v[5] = bfhi(w.z); v[6] = bflo(w.w); v[7] = bfhi(w.w);
        float ss = 0.f;
#pragma unroll
        for (int j = 0; j < 8; ++j) ss += v[j] * v[j];
        ss += __shfl_xor(ss, 1); ss += __shfl_xor(ss, 2);
        const float ss32 = ss; ss += __shfl_xor(ss, 4);
        float sc;
        if (seg < 2) { sc = rsqrtf(ss * (1.f / 64.f) + EPS_) * (seg == 0 ? 0.125f * LOG2E : 1.f); }
        else if (seg < 4) { sc = rsqrtf(ss32 * (1.f / 32.f) + EPS_) * (seg == 2 ? 0.17677669529663687f * LOG2E : 1.f); }
        else { sc = 0.125f * LOG2E; }
        const float* gp = gt + seg * 64 + (within & 63);
        const f32x4 ga = *(const f32x4*)gp, gb = *(const f32x4*)(gp + 4);
        u32x4 o; o.x = pk2(v[0] * sc * ga.x, v[1] * sc * ga.y); o.y = pk2(v[2] * sc * ga.z, v[3] * sc * ga.w); o.z = pk2(v[4] * sc * gb.x, v[5] * sc * gb.y); o.w = pk2(v[6] * sc * gb.z, v[7] * sc * gb.w);
        *(u32x4*)p4[u] = o; }
    }
    bf16_t* Lin = (bf16_t*)(lds + 2048); bf16_t* Lout = Lin + 67 * 264;
    u32x4 r[5];
#define PREP_LOAD_GROUP(G) do { const int col0_ = ((G) == 0) ? C_AV : ((G) == 1) ? C_BV : ((G) == 2) ? C_CV : ((G) == 3) ? C_DV : ((G) == 4) ? C_BQ : C_BK; \
      _Pragma("unroll") for (int u = 0; u < 5; ++u) { const int idx = tid + 512 * u, row = idx >> 5, pc = idx & 31, srow = s0 - 3 + row; \
        r[u] = (u32x4){0u, 0u, 0u, 0u}; \
        if (idx < 67 * 32 && srow >= 0) r[u] = *(const u32x4*)(P + (size_t)(b * SEQ + srow) * PLD + col0_ + 8 * pc); } } while (0)
    PREP_LOAD_GROUP(0);
#pragma unroll
    for (int g = 0; g < 6; ++g) {
      __syncthreads();
#pragma unroll
      for (int u = 0; u < 5; ++u) { const int idx = tid + 512 * u, row = idx >> 5, pc = idx & 31; if (idx < 67 * 32) *(u32x4*)(Lin + row * 264 + 8 * pc) = r[u]; }
      __syncthreads();
      if (g + 1 < 6) PREP_LOAD_GROUP(g + 1);
      const int c = tid & 255, th = tid >> 8; const bf16_t* colp = Lin + (32 * th) * 264 + c;
      if (g < 4) {
        unsigned w[16];
#pragma unroll
        for (int q = 0; q < 16; ++q) { const int p = 2 * q, i = (p & ~12) | ((p & 4) << 1) | ((p & 8) >> 1);
          w[q] = (unsigned)colp[(3 + i) * 264] | ((unsigned)colp[(3 + i + 1) * 264] << 16); }
        bf16_t* vd = Vt + (size_t)g * T_ * 256 + (((size_t)(b * 4 + (c >> 6)) * 256 + (s0 >> 6)) * 64 + (c & 63)) * 64 + 32 * th;
#pragma unroll
        for (int q4 = 0; q4 < 4; ++q4) { u32x4 o; o.x = w[4 * q4]; o.y = w[4 * q4 + 1]; o.z = w[4 * q4 + 2]; o.w = w[4 * q4 + 3]; *(u32x4*)(vd + 8 * q4) = o; }
      } else {
        const int cq = (g - 4) * 256 + c;
        const float w0 = pp.convw[cq], w1 = pp.convw[512 + cq], w2 = pp.convw[1024 + cq], w3 = pp.convw[1536 + cq], bb = pp.convb[cq], sc = (g == 4) ? 1.f : 0.125f;
        float x[35];
#pragma unroll
        for (int i = 0; i < 35; ++i) x[i] = bf2f(colp[i * 264]);
        unsigned short yb[32];
#pragma unroll
        for (int i = 0; i < 32; ++i) { const float y = bb + x[i] * w0 + x[i + 1] * w1 + x[i + 2] * w2 + x[i + 3] * w3; yb[i] = (unsigned short)(pk2(pg8::silu_f(y) * sc, 0.f) & 0xffffu); Lout[(32 * th + i) * 264 + c] = yb[i]; }
        if (g == 5) {
          bf16_t* kd = BKt + (((size_t)(b * 4 + (c >> 6)) * 256 + (s0 >> 6)) * 64 + (c & 63)) * 64 + 32 * th;
#pragma unroll
          for (int q4 = 0; q4 < 4; ++q4) { unsigned w[4];
#pragma unroll
            for (int q = 0; q < 4; ++q) { const int p = 2 * (4 * q4 + q), i = (p & ~12) | ((p & 4) << 1) | ((p & 8) >> 1); w[q] = (unsigned)yb[i] | ((unsigned)yb[i + 1] << 16); }
            u32x4 o; o.x = w[0]; o.y = w[1]; o.z = w[2]; o.w = w[3]; *(u32x4*)(kd + 8 * q4) = o; }
        }
        __syncthreads();
        bf16_t* dst = (g == 4) ? BQ : BK;
#pragma unroll
        for (int u = 0; u < 4; ++u) { const int idx = tid + 512 * u, row = idx >> 5, pc = idx & 31; *(u32x4*)(dst + (size_t)(tok0 + row) * 256 + 8 * pc) = *(const u32x4*)(Lout + row * 264 + 8 * pc); }
      }
    }
    __syncthreads();
  }
}

#undef PREP_LOAD_GROUP
DI float wave_scan_add(float v, int lane) {
#pragma unroll
  for (int o = 1; o < 64; o <<= 1) { const float t = __shfl_up(v, o); if (lane >= o) v += t; }
  return v; }
DI float wave_scan_max(float v, int lane) {
#pragma unroll
  for (int o = 1; o < 64; o <<= 1) { const float t = __shfl_up(v, o); if (lane >= o) v = fmaxf(v, t); }
  return v; }
DI float fexp(float x) { return ex2(x * LOG2E); }
DI float log_sigmoid_f(float x) { return fminf(x, 0.f) - lg2(1.0f + fexp(-fabsf(x))) * 0.6931471805599453f; }
DI void lds_wave_sync() { asm volatile("s_waitcnt lgkmcnt(0)" ::: "memory"); __builtin_amdgcn_wave_barrier(); }

DI void b1_phase(const bf16_t* P, const bf16_t* BKt, const bf16_t* VtB, float* DC, float* SC, const float* gate_bias, unsigned char* lds, int tid) {
  LAUNDER(tid);
  const int lane = tid & 63, wave = tid >> 6, r32 = lane & 31, hi = lane >> 5;
  float* wsc = (float*)(lds + wave * 1024);
  for (int item = blockIdx.x * 8 + wave; item < 2048; item += gridDim.x * 8) {
    const int bh = item >> 8, c = item & 255, b = bh >> 2, h = bh & 3, s0 = c * 64; const size_t tok0 = (size_t)b * SEQ + s0;
    const float gf = bf2f(P[(tok0 + lane) * PLD + C_GF + h]) + gate_bias[4 + h], gi = bf2f(P[(tok0 + lane) * PLD + C_GI + h]) + gate_bias[h];
    const float lf = log_sigmoid_f(gf), bcum = wave_scan_add(lf, lane), btot = __shfl(bcum, 63);
    const float g = btot - bcum + gi, mloc = wave_max(g), w = fexp(g - mloc);
    wsc[lane] = w; lds_wave_sync();
    f32x16 acc[2][2];
#pragma unroll
    for (int i = 0; i < 2; ++i)
#pragma unroll
      for (int j = 0; j < 2; ++j) acc[i][j] = splat16(0.f);
    float dn[2] = {0.f, 0.f};
#pragma unroll
    for (int ks = 0; ks < 4; ++ks) {
      const f32x4 wa = *(const f32x4*)(wsc + 16 * ks + 4 * hi), wb = *(const f32x4*)(wsc + 16 * ks + 8 + 4 * hi);
      bf16x8 vf[2], kf[2];
#pragma unroll
      for (int eb = 0; eb < 2; ++eb) {
        vf[eb] = *(const bf16x8*)(VtB + (((size_t)bh * 256 + c) * 64 + 32 * eb + r32) * 64 + 16 * ks + 8 * hi);
        const u32x4 kw = *(const u32x4*)(BKt + (((size_t)bh * 256 + c) * 64 + 32 * eb + r32) * 64 + 16 * ks + 8 * hi);
        const float k0 = bflo(kw.x) * wa.x, k1 = bfhi(kw.x) * wa.y, k2 = bflo(kw.y) * wa.z, k3 = bfhi(kw.y) * wa.w, k4 = bflo(kw.z) * wb.x, k5 = bfhi(kw.z) * wb.y, k6 = bflo(kw.w) * wb.z, k7 = bfhi(kw.w) * wb.w;
        dn[eb] += ((k0 + k1) + (k2 + k3)) + ((k4 + k5) + (k6 + k7));
        u32x4 o; o.x = pk2(k0, k1); o.y = pk2(k2, k3); o.z = pk2(k4, k5); o.w = pk2(k6, k7); kf[eb] = __builtin_bit_cast(bf16x8, o);
      }
#pragma unroll
      for (int eb = 0; eb < 2; ++eb)
#pragma unroll
        for (int db = 0; db < 2; ++db) acc[eb][db] = MFMA32(vf[eb], kf[db], acc[eb][db]);
    }
    float* dc = DC + ((size_t)bh * 256 + c) * 4160;
#pragma unroll
    for (int eb = 0; eb < 2; ++eb)
#pragma unroll
      for (int db = 0; db < 2; ++db)
#pragma unroll
        for (int i = 0; i < 16; ++i) dc[(32 * eb + crow(i, hi)) * 64 + 32 * db + r32] = acc[eb][db][i];
#pragma unroll
    for (int db = 0; db < 2; ++db) { const float t = dn[db] + __shfl_xor(dn[db], 32); if (hi == 0) dc[4096 + 32 * db + r32] = t; }
    if (lane == 0) { SC[bh * 256 + c] = btot; SC[2048 + bh * 256 + c] = mloc; }
    lds_wave_sync();
  }
}

DI void b2_item(float* DC, float* SC, int j, unsigned char* lds, int tid) {
  LAUNDER(tid);
  float* L = (float*)lds;
  const int ge = j * 512 + tid, bh0 = (j * 512) / 1040, bh1 = (j * 512 + 511) / 1040;
  { const int slot = tid >> 8, c = tid & 255, bh = slot ? bh1 : bh0;
    if (bh < 8) { L[slot * 1024 + c] = SC[bh * 256 + c]; L[slot * 1024 + 256 + c] = SC[2048 + bh * 256 + c]; } }
  __syncthreads();
  if ((tid & 63) == 0 && (tid >> 6) < 2) { const int slot = tid >> 6, bh = slot ? bh1 : bh0;
    if (bh < 8 && (slot == 0 || bh1 != bh0)) { float* q = L + slot * 1024; float m = 0.f; const bool wr = (j * 512 <= bh * 1040) && (bh * 1040 < j * 512 + 512);
      for (int c = 0; c < 256; ++c) { const float b = q[c], l = q[256 + c], mn = fmaxf(b + m, l); q[512 + c] = fexp(b + m - mn); q[768 + c] = fexp(l - mn); if (wr) SC[4096 + bh * 256 + c] = m; m = mn; } } }
  __syncthreads();
  if (ge < 8 * 1040) {
    const int bh = ge / 1040, el = (ge % 1040) * 4; const float* q = L + ((bh == bh0) ? 0 : 1024);
    float* p = DC + (size_t)bh * 256 * 4160 + el; float z0 = 0.f; LAUNDER(z0); f32x4 C = {z0, z0, z0, z0};
    for (int c0 = 0; c0 < 256; c0 += 8) {
      f32x4 d[8];
#pragma unroll
      for (int u = 0; u < 8; ++u) d[u] = *(const f32x4*)(p + (size_t)(c0 + u) * 4160);
#pragma unroll
      for (int u = 0; u < 8; ++u) { *(f32x4*)(p + (size_t)(c0 + u) * 4160) = C; C = C * q[512 + c0 + u] + d[u] * q[768 + c0 + u]; }
    }
  }
}

DI void b3_phase(const bf16_t* P, const bf16_t* BQ, const bf16_t* BK, const bf16_t* VtB, const float* DC, const float* SC, const float* gate_bias, const float* onorm, bf16_t* Y, unsigned char* lds, int tid) {
  LAUNDER(tid);
  const int lane = tid & 63, wave = tid >> 6, r32 = lane & 31, hi = lane >> 5;
  float* R = (float*)(lds + wave * 2048); float* MU = R + 64; float* SI = R + 128; float* EM = R + 192; float* NV = R + 256;
  for (int item = blockIdx.x * 8 + wave; item < 2048; item += gridDim.x * 8) {
    const int bh = item >> 8, c = item & 255, b = bh >> 2, h = bh & 3, s0 = c * 64; const size_t tok0 = (size_t)b * SEQ + s0;
    const float* dc = DC + ((size_t)bh * 256 + c) * 4160;
    {
      const float gf = bf2f(P[(tok0 + lane) * PLD + C_GF + h]) + gate_bias[4 + h], gi = bf2f(P[(tok0 + lane) * PLD + C_GI + h]) + gate_bias[h];
      const float lf = log_sigmoid_f(gf), bcum = wave_scan_add(lf, lane), r = gi - bcum, pmax = wave_scan_max(r, lane);
      const float m_in = SC[4096 + bh * 256 + c], mu = fmaxf(m_in, pmax);
      R[lane] = r; MU[lane] = mu; SI[lane] = fexp(m_in - mu); EM[lane] = fexp(-bcum - mu); NV[lane] = dc[4096 + lane];
    }
    lds_wave_sync();
#pragma unroll
    for (int tq = 0; tq < 2; ++tq) {
      const int t = 32 * tq + r32; const float mu_t = MU[t], si_t = SI[t], em_t = EM[t];
      bf16x8 qf[4]; float qn = 0.f;
#pragma unroll
      for (int ks = 0; ks < 4; ++ks) {
        const u32x4 qw = *(const u32x4*)(BQ + (tok0 + t) * 256 + h * 64 + 16 * ks + 8 * hi); qf[ks] = __builtin_bit_cast(bf16x8, qw);
        const f32x4 na = *(const f32x4*)(NV + 16 * ks + 8 * hi), nb = *(const f32x4*)(NV + 16 * ks + 8 * hi + 4);
        qn += bflo(qw.x) * na.x + bfhi(qw.x) * na.y + bflo(qw.y) * na.z + bfhi(qw.y) * na.w + bflo(qw.z) * nb.x + bfhi(qw.z) * nb.y + bflo(qw.w) * nb.z + bfhi(qw.w) * nb.w;
      }
      qn += __shfl_xor(qn, 32);
      f32x16 G[2], num[2];
#pragma unroll
      for (int eb = 0; eb < 2; ++eb) { G[eb] = splat16(0.f); num[eb] = splat16(0.f);
#pragma unroll
        for (int ks = 0; ks < 4; ++ks) { const float* cp = dc + (32 * eb + r32) * 64 + 16 * ks + 8 * hi; const f32x4 ca = *(const f32x4*)cp, cb = *(const f32x4*)(cp + 4);
          u32x4 o; o.x = pk2(ca.x, ca.y); o.y = pk2(ca.z, ca.w); o.z = pk2(cb.x, cb.y); o.w = pk2(cb.z, cb.w);
          G[eb] = MFMA32(__builtin_bit_cast(bf16x8, o), qf[ks], G[eb]); }
        asm volatile("" ::: "memory"); }
      float dsum = 0.f;
#pragma unroll
      for (int tk = 0; tk < 2; ++tk) {
        if (tk <= tq) {
          f32x16 S = splat16(0.f);
#pragma unroll
          for (int ks = 0; ks < 4; ++ks) { const bf16x8 kf = *(const bf16x8*)(BK + (tok0 + 32 * tk + r32) * 256 + h * 64 + 16 * ks + 8 * hi); S = MFMA32(kf, qf[ks], S); }
          asm volatile("" ::: "memory");
#pragma unroll
          for (int g4 = 0; g4 < 4; ++g4) { const f32x4 rv = *(const f32x4*)(R + 32 * tk + 8 * g4 + 4 * hi);
#pragma unroll
            for (int j = 0; j < 4; ++j) { const int s = 32 * tk + 8 * g4 + 4 * hi + j; const float w = (s <= t) ? fexp(rv[j] - mu_t) : 0.f; const float val = S[4 * g4 + j] * w; dsum += val; S[4 * g4 + j] = val; } }
#pragma unroll
          for (int kk = 0; kk < 2; ++kk) { const bf16x8 pf = pack8(S, kk);
#pragma unroll
            for (int eb = 0; eb < 2; ++eb) { const bf16_t* vp = VtB + (((size_t)bh * 256 + c) * 64 + 32 * eb + r32) * 64 + 32 * tk + 16 * kk + 8 * hi;
              const bf16x8 vf = *(const bf16x8*)vp; num[eb] = MFMA32(vf, pf, num[eb]); } }
          asm volatile("" ::: "memory");
        }
      }
      dsum += __shfl_xor(dsum, 32);
      const float den = si_t * qn + dsum, inv = 1.0f / fmaxf(fabsf(den), em_t);
      float ss = 0.f;
#pragma unroll
      for (int eb = 0; eb < 2; ++eb)
#pragma unroll
        for (int i = 0; i < 16; ++i) { const float hv = (num[eb][i] + si_t * G[eb][i]) * inv; num[eb][i] = hv; ss += hv * hv; }
      ss += __shfl_xor(ss, 32);
      const float rstd = rsqrtf(ss * (1.f / 64.f) + EPS_);
      const bf16_t* bo = P + (tok0 + t) * PLD + C_BO + h * 64; bf16_t* yo = Y + (tok0 + t) * DM + 256 + h * 64;
#pragma unroll
      for (int eb = 0; eb < 2; ++eb)
#pragma unroll
        for (int g4 = 0; g4 < 4; ++g4) { const int e = 32 * eb + 8 * g4 + 4 * hi; const u32x2 bw = *(const u32x2*)(bo + e); const f32x4 gn = *(const f32x4*)(onorm + h * 64 + e);
          const float o0 = num[eb][4 * g4] * rstd * gn.x * rcpf_(1.f + fexp(-bflo(bw.x))), o1 = num[eb][4 * g4 + 1] * rstd * gn.y * rcpf_(1.f + fexp(-bfhi(bw.x)));
          const float o2 = num[eb][4 * g4 + 2] * rstd * gn.z * rcpf_(1.f + fexp(-bflo(bw.y))), o3 = num[eb][4 * g4 + 3] * rstd * gn.w * rcpf_(1.f + fexp(-bfhi(bw.y)));
          u32x2 ow; ow.x = pk2(o0, o1); ow.y = pk2(o2, o3); *(u32x2*)(yo + e) = ow; }
    }
    lds_wave_sync();
  }
}

struct AttnParams { const bf16_t* P; const bf16_t* Vt; bf16_t* Y; const float* biasL; float negM; float lam; float oscale; const float* cgain; };
constexpr int NCH = 1;
template <int MODE>
DI void attn_unit(unsigned char* lds, const AttnParams& ap, int b, int h, int qb, int tid) {
  LAUNDER(tid);
  const int wave = tid >> 6, lane = tid & 63, r32 = lane & 31, hi = lane >> 5, bh = b * 4 + h;
  constexpr int qcol0 = (MODE == 0) ? C_AQ : (MODE == 1) ? C_CQ : C_DQ, kcol0 = (MODE == 0) ? C_AK : (MODE == 1) ? C_CK : C_DK, ycol0 = (MODE == 0) ? 0 : (MODE == 1) ? 512 : 768;
  const bf16_t* Vt = ap.Vt + (size_t)((MODE == 0) ? 0 : (MODE == 1) ? 2 : 3) * T_ * 256;
  const size_t tokb = (size_t)b * SEQ;
  const int qpos = qb * 256 + wave * 32 + r32, cw = qb * 4 + (wave >> 1);
  bf16x8 qf[4];
  { const bf16_t* qp = ap.P + (tokb + qpos) * PLD + qcol0 + h * 64 + 8 * hi;
#pragma unroll
    for (int ks = 0; ks < 4; ++ks) qf[ks] = *(const bf16x8*)(qp + 16 * ks); }
  bf16_t* Ks0 = (bf16_t*)lds; bf16_t* Vs0 = Ks0 + NCH * 64 * 72; volatile int* flags = (volatile int*)(lds + 2 * NCH * 64 * 72 * 2);
  const int jhi = 4 * qb + 3, jlo = (MODE == 0) ? ((4 * qb - 8 > 0) ? 4 * qb - 8 : 0) : 0, ntiles = jhi - jlo + 1;
  const int lrow = tid >> 3, lch = tid & 7;
  const bf16_t* kg = ap.P + (tokb + lrow) * PLD + kcol0 + h * 64 + 8 * lch;
  const bf16_t* vg = Vt + (size_t)bh * 256 * 4096 + lrow * 64 + 8 * lch;
  const int j0 = (MODE == 2) ? jhi : jlo;
  u32x4 kreg[NCH], vreg[NCH];
#pragma unroll
  for (int c = 0; c < NCH; ++c) { const int jc = (MODE == 2) ? j0 - c : j0 + c; kreg[c] = *(const u32x4*)(kg + (size_t)jc * 64 * PLD); vreg[c] = *(const u32x4*)(vg + (size_t)jc * 4096); }
  f32x16 O0[2], O1[2]; float l0 = 0.f, l1 = 0.f, cum = 0.f;
#pragma unroll
  for (int eb = 0; eb < 2; ++eb) { O0[eb] = splat16(0.f); O1[eb] = splat16(0.f); }
  bool wdone = false;
  if (MODE == 2 && D_EARLY) { if (tid < 8) flags[tid] = 0; }
  for (int n = 0; n < ntiles; n += NCH) {
    const int jb = (MODE == 2) ? jhi - n : jlo + n;
    __syncthreads();
    if (MODE == 2 && D_EARLY) { int alld = 1;
#pragma unroll
      for (int w = 0; w < 8; ++w) alld &= flags[w];
      if (alld) break; }
#pragma unroll
    for (int c = 0; c < NCH; ++c) { *(u32x4*)(Ks0 + (c * 64 + lrow) * 72 + 8 * lch) = kreg[c]; *(u32x4*)(Vs0 + (c * 64 + lrow) * 72 + 8 * lch) = vreg[c]; }
    __syncthreads();
    if (n + NCH < ntiles) {
#pragma unroll
      for (int c = 0; c < NCH; ++c) { const int jn = (MODE == 2) ? jb - NCH - c : jb + NCH + c; kreg[c] = *(const u32x4*)(kg + (size_t)jn * 64 * PLD); vreg[c] = *(const u32x4*)(vg + (size_t)jn * 4096); } }
#pragma unroll
    for (int c = 0; c < NCH; ++c) {
    const int j = (MODE == 2) ? jb - c : jb + c;
    const bf16_t* Ks = Ks0 + c * 64 * 72; const bf16_t* Vs = Vs0 + c * 64 * 72;
    const bool active = (j <= cw) && (MODE != 0 || j >= cw - 8);
    if (!active) continue;
    if (MODE == 2 && D_EARLY && wdone) continue;
    if (MODE == 1) {
#pragma unroll
      for (int kh = 0; kh < 2; ++kh) {
        const bf16_t* kb = Ks + (32 * kh + r32) * 72 + 8 * hi;
        bf16x8 p0[2], p1[2];
        { f32x16 s0 = splat16(ap.negM);
          s0 = MFMA32(*(const bf16x8*)(kb), qf[0], s0); s0 = MFMA32(*(const bf16x8*)(kb + 16), qf[1], s0);
#pragma unroll
          for (int i = 0; i < 16; ++i) { s0[i] = ex2(s0[i]); l0 += s0[i]; }
          p0[0] = pack8(s0, 0); p0[1] = pack8(s0, 1); }
        { f32x16 s1 = splat16(ap.negM);
          s1 = MFMA32(*(const bf16x8*)(kb + 32), qf[2], s1); s1 = MFMA32(*(const bf16x8*)(kb + 48), qf[3], s1);
#pragma unroll
          for (int i = 0; i < 16; ++i) { s1[i] = ex2(s1[i]); l1 += s1[i]; }
          p1[0] = pack8(s1, 0); p1[1] = pack8(s1, 1); }
#pragma unroll
        for (int kk = 0; kk < 2; ++kk) {
#pragma unroll
          for (int eb = 0; eb < 2; ++eb) { const bf16_t* vb = Vs + (32 * eb + r32) * 72 + 32 * kh + 16 * kk + 8 * hi; const bf16x8 vf = *(const bf16x8*)vb;
            O0[eb] = MFMA32(vf, p0[kk], O0[eb]); O1[eb] = MFMA32(vf, p1[kk], O1[eb]); } }
      }
    } else if (MODE == 0) {
      const int dch = cw - j; const float binit = ap.negM + ((dch >= 3) ? ap.biasL[256] : 0.f);
#pragma unroll
      for (int kh = 0; kh < 2; ++kh) {
        const bf16_t* kb = Ks + (32 * kh + r32) * 72 + 8 * hi;
        f32x16 s0 = splat16(binit);
#pragma unroll
        for (int ks = 0; ks < 4; ++ks) s0 = MFMA32(*(const bf16x8*)(kb + 16 * ks), qf[ks], s0);
        if (dch < 3) {
#pragma unroll
          for (int i = 0; i < 16; ++i) { int rel = qpos - (64 * j + 32 * kh + crow(i, hi)); rel = rel > 128 ? 128 : (rel < -128 ? -128 : rel); s0[i] += ap.biasL[rel + 128]; } }
#pragma unroll
        for (int i = 0; i < 16; ++i) { s0[i] = ex2(s0[i]); l0 += s0[i]; }
#pragma unroll
        for (int kk = 0; kk < 2; ++kk) { const bf16x8 p0 = pack8(s0, kk);
#pragma unroll
          for (int eb = 0; eb < 2; ++eb) { const bf16_t* vb = Vs + (32 * eb + r32) * 72 + 32 * kh + 16 * kk + 8 * hi; const bf16x8 vf = *(const bf16x8*)vb;
            O0[eb] = MFMA32(vf, p0, O0[eb]); } }
      }
    } else {
      f32x16 z[2];
#pragma unroll
      for (int kh = 0; kh < 2; ++kh) { const bf16_t* kb = Ks + (32 * kh + r32) * 72 + 8 * hi; z[kh] = splat16(0.f);
#pragma unroll
        for (int ks = 0; ks < 4; ++ks) z[kh] = MFMA32(*(const bf16x8*)(kb + 16 * ks), qf[ks], z[kh]); }
      const bool diag = (j == cw); f32x16 sp[2]; float bs[8], ob[8];
#pragma unroll
      for (int kh = 0; kh < 2; ++kh)
#pragma unroll
        for (int g4 = 0; g4 < 4; ++g4) { float t = 0.f;
#pragma unroll
          for (int jj = 0; jj < 4; ++jj) { const int i = 4 * g4 + jj; const bool before = !diag || (64 * j + 32 * kh + crow(i, hi) < qpos);
            const float v = before ? lg2(1.0f + ex2(z[kh][i])) : 0.f; sp[kh][i] = v; t += v; }
          bs[4 * kh + g4] = t; }
#pragma unroll
      for (int p = 0; p < 8; ++p) ob[p] = __shfl_xor(bs[p], 32);
      float Rr = 0.f, saf[8];
#pragma unroll
      for (int p = 7; p >= 0; --p) { const float ev = hi ? ob[p] : bs[p], od = hi ? bs[p] : ob[p]; saf[p] = Rr + (hi ? 0.f : od); Rr += ev + od; }
#pragma unroll
      for (int kh = 0; kh < 2; ++kh)
#pragma unroll
        for (int g4 = 0; g4 < 4; ++g4) { float e = saf[4 * kh + g4];
#pragma unroll
          for (int jj = 3; jj >= 0; --jj) { const int i = 4 * g4 + jj; const bool before = !diag || (64 * j + 32 * kh + crow(i, hi) < qpos);
            const float a = before ? ex2(z[kh][i] - sp[kh][i] - e + cum) : 0.f; e += sp[kh][i]; z[kh][i] = a; } }
      cum -= Rr;
#pragma unroll
      for (int kh = 0; kh < 2; ++kh)
#pragma unroll
        for (int kk = 0; kk < 2; ++kk) { const bf16x8 p0 = pack8(z[kh], kk);
#pragma unroll
          for (int eb = 0; eb < 2; ++eb) { const bf16_t* vb = Vs + (32 * eb + r32) * 72 + 32 * kh + 16 * kk + 8 * hi; const bf16x8 vf = *(const bf16x8*)vb;
            O0[eb] = MFMA32(vf, p0, O0[eb]); } }
      if (D_EARLY) { const int done = __all(cum <= -151.0f); if (lane == 0) flags[wave] = done; wdone = (done != 0); }
    }
    }
  }
  bf16_t* yo = ap.Y + (tokb + qpos) * DM + ycol0 + h * 64;
  if (MODE == 0) { l0 += __shfl_xor(l0, 32); const float inv = 1.0f / l0;
#pragma unroll
    for (int eb = 0; eb < 2; ++eb)
#pragma unroll
      for (int i = 0; i < 16; ++i) O0[eb][i] *= inv;
  } else if (MODE == 1) { l0 += __shfl_xor(l0, 32); l1 += __shfl_xor(l1, 32); const float i0 = 1.0f / l0, i1 = ap.lam / l1; float ss = 0.f;
#pragma unroll
    for (int eb = 0; eb < 2; ++eb)
#pragma unroll
      for (int i = 0; i < 16; ++i) { const float o = O0[eb][i] * i0 - O1[eb][i] * i1; O0[eb][i] = o; ss += o * o; }
    ss += __shfl_xor(ss, 32); const float rstd = rsqrtf(ss * (1.f / 64.f) + EPS_) * ap.oscale;
#pragma unroll
    for (int eb = 0; eb < 2; ++eb)
#pragma unroll
      for (int i = 0; i < 16; ++i) O0[eb][i] *= rstd * ap.cgain[32 * eb + crow(i, hi)];
  }
#pragma unroll
  for (int eb = 0; eb < 2; ++eb)
#pragma unroll
    for (int g4 = 0; g4 < 4; ++g4) { u32x2 ow; ow.x = pk2(O0[eb][4 * g4], O0[eb][4 * g4 + 1]); ow.y = pk2(O0[eb][4 * g4 + 2], O0[eb][4 * g4 + 3]); *(u32x2*)(yo + 32 * eb + 8 * g4 + 4 * hi) = ow; }
}

struct MixParams { AttnParams ap; float* DC; float* SC; const float* relb; const float *aqg, *akg, *cqg, *ckg, *clam, *cog; float lam_init; unsigned* ctr; };
DI void mix_phase(unsigned char* lds, const MixParams& mp, int tid) {
  LAUNDER(tid);
  volatile int* misc = (volatile int*)(lds + pg8::STAGE_BYTES);
  float* biasT = (float*)(lds + 81920);
  float* red = (float*)(lds + 81920 + 4 * 260 * 4);
  for (int i = tid; i < 4 * 257; i += 512) biasT[(i / 257) * 260 + (i % 257)] = mp.relb[i] * LOG2E;
  if (tid < 64) {
    const int lane = tid;
    const float aq = wave_max(fabsf(mp.aqg[lane])), ak = wave_max(fabsf(mp.akg[lane]));
    const float cq = wave_max(fabsf(mp.cqg[lane & 31])), ck = wave_max(fabsf(mp.ckg[lane & 31]));
    const float d1 = wave_sum(lane < 32 ? mp.clam[lane] * mp.clam[32 + lane] : 0.f), d2 = wave_sum(lane < 32 ? mp.clam[64 + lane] * mp.clam[96 + lane] : 0.f);
    if (lane == 0) { red[0] = 8.0f * aq * ak * LOG2E * 1.02f; red[1] = 5.656854249f * cq * ck * LOG2E * 1.02f; red[2] = fexp(d1) - fexp(d2) + mp.lam_init; }
  }
  __syncthreads();
  if (tid < 256) { const int hh = tid >> 6, ln = tid & 63; float m = -1e30f;
#pragma unroll
    for (int i = 0; i < 5; ++i) { const int e = ln + 64 * i; if (e < 257) m = fmaxf(m, biasT[hh * 260 + e]); }
    m = wave_max(m); if (ln == 0) red[4 + hh] = m; }
  __syncthreads();
  const float MA = red[0], MC = red[1], lam = red[2];
  AttnParams ap = mp.ap;
  for (;;) {
    __syncthreads();
    if (tid == 0) misc[0] = (int)atomicAdd(mp.ctr, 1u);
    __syncthreads();
    const int it = misc[0];
    constexpr int NB2 = 17;
    if (it >= NB2 + 3 * 512) break;
    if (it < NB2) { b2_item(mp.DC, mp.SC, it, lds, tid); continue; }
    const int r = (it - NB2) & 511, kind = (it - NB2) >> 9, qb = 63 - (r >> 3), bh = r & 7, b = bh >> 2, h = bh & 3;
    if (kind == 0) { ap.negM = -MC; ap.lam = lam; ap.oscale = 1.0f - mp.lam_init; ap.cgain = mp.cog; attn_unit<1>(lds, ap, b, h, qb, tid); }
    else if (kind == 1) { attn_unit<2>(lds, ap, b, h, qb, tid); }
    else { ap.negM = -(MA + red[4 + h]); ap.biasL = biasT + h * 260; attn_unit<0>(lds, ap, b, h, qb, tid); }
  }
}

DI const float* ldp(const unsigned char* lds, int i) {
  const volatile __attribute__((address_space(3))) unsigned* t = (const volatile __attribute__((address_space(3))) unsigned*)(lds + pg8::STAGE_BYTES + 64);
  const unsigned lo = __builtin_amdgcn_readfirstlane(t[2 * i]), hi = __builtin_amdgcn_readfirstlane(t[2 * i + 1]);
  return (const float*)(const __attribute__((address_space(1))) float*)(((unsigned long long)hi << 32) | lo); }
DI int fresh_tid(int wave_s) { int lane; asm volatile("v_mbcnt_lo_u32_b32 %0, -1, 0\n\tv_mbcnt_hi_u32_b32 %0, -1, %0" : "=v"(lane)); return wave_s * 64 + lane; }

DI void gbar(unsigned* bw, unsigned& k, int tid) {
  ++k;
  asm volatile("s_waitcnt vmcnt(0)" ::: "memory");
  __syncthreads();
  if (tid == 0) {
    __builtin_amdgcn_fence(__ATOMIC_RELEASE, "agent");
    const unsigned G = gridDim.x, x = blockIdx.x & 7u, nloc = (G - x + 7u) >> 3, ngrp = G < 8u ? G : 8u;
    unsigned* xcnt = bw + 64 * x; unsigned* xgen = bw + 64 * (8 + x); unsigned* top = bw + 64 * 16; unsigned* topgen = bw + 64 * 17;
    const unsigned old = __hip_atomic_fetch_add(xcnt, 1u, __ATOMIC_RELAXED, __HIP_MEMORY_SCOPE_AGENT);
    if (old + 1u == k * nloc) {
      const unsigned o2 = __hip_atomic_fetch_add(top, 1u, __ATOMIC_RELAXED, __HIP_MEMORY_SCOPE_AGENT);
      if (o2 + 1u == k * ngrp) __hip_atomic_store(topgen, k, __ATOMIC_RELAXED, __HIP_MEMORY_SCOPE_AGENT);
      else while (__hip_atomic_load(topgen, __ATOMIC_RELAXED, __HIP_MEMORY_SCOPE_AGENT) < k) __builtin_amdgcn_s_sleep(1);
      __hip_atomic_store(xgen, k, __ATOMIC_RELAXED, __HIP_MEMORY_SCOPE_AGENT);
    } else {
      while (__hip_atomic_load(xgen, __ATOMIC_RELAXED, __HIP_MEMORY_SCOPE_AGENT) < k) __builtin_amdgcn_s_sleep(1);
    }
    __builtin_amdgcn_fence(__ATOMIC_ACQUIRE, "agent");
  }
  __syncthreads();
}
#define WSP(off) ((unsigned char*)ldp(lds, 24) + (off))
__global__ void __launch_bounds__(512) fwd_kernel(Args a) {
  extern __shared__ __attribute__((aligned(16))) unsigned char lds[];
  cg::grid_group grid = cg::this_grid();
  const int wave_s = __builtin_amdgcn_readfirstlane(threadIdx.x >> 6);
  if (threadIdx.x == 0) {
    const float** t = (const float**)(lds + pg8::STAGE_BYTES + 64);
#pragma unroll
    for (int i = 0; i < 23; ++i) t[i] = a.in[i];
    t[23] = a.out; t[24] = (const float*)a.ws;
  }
  if (blockIdx.x == 0) { unsigned* ctl = (unsigned*)(a.ws + WS_CTL); for (int i = threadIdx.x; i < 2048; i += 512) ctl[i] = 0u; }
  __syncthreads();
  unsigned bk = 0u;
  PG8_LAS unsigned char* ldsL = (PG8_LAS unsigned char*)lds;
  typedef pg8::StaticOrder SO;

  { Args a2;
#pragma unroll
    for (int i = 0; i < 23; ++i) a2.in[i] = ldp(lds, i);
    a2.out = nullptr; a2.ws = WSP(0);
    prologue_weights(a2, lds, fresh_tid(wave_s)); }
  cast_phase(ldp(lds, 0), (bf16_t*)WSP(WS_XN), (float*)WSP(WS_SS), fresh_tid(wave_s));
  grid.sync();
  for (int l = 0; l < NLAYER; ++l) {
    const size_t wlo = WS_W + (size_t)l * LW_SIZE;
    { const float* xin = (l == 0) ? ldp(lds, 0) : ldp(lds, 23); (void)xin;
      pg8::Gemm g{(bf16_t*)WSP(WS_XN), (const bf16_t*)WSP(wlo + LW_WGU1), T_, 2 * FF, DM}; SO S; S.init(T_, 2 * FF, gridDim.x, blockIdx.x); pg8::EpiSwiGLU E{(bf16_t*)WSP(WS_HP), FF, (const float*)WSP(WS_SS) + (size_t)(3 * l) * T_};
      pg8::gemm_phase<pg8::EpiSwiGLU, SO, true, true>(ldsL, g, S, E, fresh_tid(wave_s)); }
    gbar((unsigned*)WSP(WS_CTL) + 64, bk, fresh_tid(wave_s));
    { const float* xin = (l == 0) ? ldp(lds, 0) : ldp(lds, 23);
      pg8::Gemm g{(bf16_t*)WSP(WS_HP), (const bf16_t*)WSP(wlo + LW_WD1), T_, DM, FF}; SO S; S.init(T_, DM, gridDim.x, blockIdx.x); pg8::EpiResid E{xin, (float*)ldp(lds, 23), DM, 0.5f, (bf16_t*)WSP(WS_XN), (float*)WSP(WS_SS) + (size_t)(3 * l + 1) * T_};
      pg8::gemm_phase<pg8::EpiResid, SO, true, true>(ldsL, g, S, E, fresh_tid(wave_s)); }
    gbar((unsigned*)WSP(WS_CTL) + 64, bk, fresh_tid(wave_s));
    { pg8::Gemm g{(bf16_t*)WSP(WS_XN), (const bf16_t*)WSP(wlo + LW_WIN), T_, INP, DM}; SO S; S.init(T_, INP, gridDim.x, blockIdx.x); pg8::EpiBf16Lim E{(bf16_t*)WSP(WS_HP), PLD, PLD, (const float*)WSP(WS_SS) + (size_t)(3 * l + 1) * T_};
      pg8::gemm_phase<pg8::EpiBf16Lim, SO, true, true>(ldsL, g, S, E, fresh_tid(wave_s)); }
    gbar((unsigned*)WSP(WS_CTL) + 64, bk, fresh_tid(wave_s));
    { PrepParams pp{ldp(lds, 7) + l * 64, ldp(lds, 8) + l * 64, ldp(lds, 14) + l * 32, ldp(lds, 15) + l * 32, ldp(lds, 10) + l * 2048, ldp(lds, 11) + l * 512};
      prep_phase((bf16_t*)WSP(WS_HP), (bf16_t*)WSP(WS_BQ), (bf16_t*)WSP(WS_BK), (bf16_t*)WSP(WS_BKT), (bf16_t*)WSP(WS_VT), pp, lds, fresh_tid(wave_s)); }
    gbar((unsigned*)WSP(WS_CTL) + 64, bk, fresh_tid(wave_s));
    b1_phase((bf16_t*)WSP(WS_HP), (bf16_t*)WSP(WS_BKT), (bf16_t*)WSP(WS_VT) + (size_t)T_ * 256, (float*)WSP(WS_DC), (float*)WSP(WS_SC), ldp(lds, 12) + l * 8, lds, fresh_tid(wave_s));
    gbar((unsigned*)WSP(WS_CTL) + 64, bk, fresh_tid(wave_s));
    { const float lam_init = (l == 0) ? 0.2f : (0.8f - 0.6f * 0.7408182206817179f);
      MixParams mp; mp.ap.P = (bf16_t*)WSP(WS_HP); mp.ap.Vt = (bf16_t*)WSP(WS_VT); mp.ap.Y = (bf16_t*)WSP(WS_XN); mp.ap.biasL = nullptr; mp.ap.negM = 0.f; mp.ap.lam = 0.f; mp.ap.oscale = 1.f; mp.ap.cgain = nullptr;
      mp.DC = (float*)WSP(WS_DC); mp.SC = (float*)WSP(WS_SC); mp.relb = ldp(lds, 9) + l * 4 * 257; mp.aqg = ldp(lds, 7) + l * 64; mp.akg = ldp(lds, 8) + l * 64; mp.cqg = ldp(lds, 14) + l * 32; mp.ckg = ldp(lds, 15) + l * 32;
      mp.clam = ldp(lds, 16) + l * 128; mp.cog = ldp(lds, 17) + l * 64; mp.lam_init = lam_init; mp.ctr = (unsigned*)WSP(WS_CTL) + l;
      mix_phase(lds, mp, fresh_tid(wave_s)); }
    gbar((unsigned*)WSP(WS_CTL) + 64, bk, fresh_tid(wave_s));
    b3_phase((bf16_t*)WSP(WS_HP), (bf16_t*)WSP(WS_BQ), (bf16_t*)WSP(WS_BK), (bf16_t*)WSP(WS_VT) + (size_t)T_ * 256, (float*)WSP(WS_DC), (float*)WSP(WS_SC), ldp(lds, 12) + l * 8, ldp(lds, 13) + l * 256, (bf16_t*)WSP(WS_XN), lds, fresh_tid(wave_s));
    gbar((unsigned*)WSP(WS_CTL) + 64, bk, fresh_tid(wave_s));
    { float* xo = (float*)ldp(lds, 23);
      pg8::Gemm g{(bf16_t*)WSP(WS_XN), (const bf16_t*)WSP(wlo + LW_WOUT), T_, DM, DM}; SO S; S.init(T_, DM, gridDim.x, blockIdx.x); pg8::EpiResid E{xo, xo, DM, 1.0f, (bf16_t*)WSP(WS_BQ), (float*)WSP(WS_SS) + (size_t)(3 * l + 2) * T_};
      pg8::gemm_phase<pg8::EpiResid, SO, true, true>(ldsL, g, S, E, fresh_tid(wave_s)); }
    gbar((unsigned*)WSP(WS_CTL) + 64, bk, fresh_tid(wave_s));
    { pg8::Gemm g{(bf16_t*)WSP(WS_BQ), (const bf16_t*)WSP(wlo + LW_WGU2), T_, 2 * FF, DM}; SO S; S.init(T_, 2 * FF, gridDim.x, blockIdx.x); pg8::EpiSwiGLU E{(bf16_t*)WSP(WS_HP), FF, (const float*)WSP(WS_SS) + (size_t)(3 * l + 2) * T_};
      pg8::gemm_phase<pg8::EpiSwiGLU, SO, true, true>(ldsL, g, S, E, fresh_tid(wave_s)); }
    gbar((unsigned*)WSP(WS_CTL) + 64, bk, fresh_tid(wave_s));
    { float* xo = (float*)ldp(lds, 23);
      pg8::Gemm g{(bf16_t*)WSP(WS_HP), (const bf16_t*)WSP(wlo + LW_WD2), T_, DM, FF}; SO S; S.init(T_, DM, gridDim.x, blockIdx.x); pg8::EpiResid E{xo, xo, DM, 0.5f, (l + 1 < NLAYER) ? (bf16_t*)WSP(WS_XN) : nullptr, (float*)WSP(WS_SS) + (size_t)(3 * l + 3) * T_};
      pg8::gemm_phase<pg8::EpiResid, SO, true, true>(ldsL, g, S, E, fresh_tid(wave_s)); }
    if (l + 1 < NLAYER) gbar((unsigned*)WSP(WS_CTL) + 64, bk, fresh_tid(wave_s));
  }
}

extern "C" void kernel_launch(void* const* d_in, const int* in_sizes, int n_in, void* d_out, int out_size, void* d_ws, size_t ws_size, hipStream_t stream) {
  static int grid = 0;
  if (grid == 0) {
    if (n_in != 23 || out_size != T_ * DM || ws_size < WS_END) { fprintf(stderr, "kernel_launch: unexpected problem (n_in %d out %d ws %zu need %zu)\n", n_in, out_size, ws_size, (size_t)WS_END); grid = -1; return; }
    int dev = 0, cus = 0, per_cu = 0;
    hipGetDevice(&dev); hipDeviceGetAttribute(&cus, hipDeviceAttributeMultiprocessorCount, dev);
    if (hipFuncSetAttribute((const void*)fwd_kernel, hipFuncAttributeMaxDynamicSharedMemorySize, LDS_BYTES) != hipSuccess) fprintf(stderr, "kernel_launch: hipFuncSetAttribute failed\n");
    if (hipOccupancyMaxActiveBlocksPerMultiprocessor(&per_cu, (const void*)fwd_kernel, 512, LDS_BYTES) != hipSuccess || per_cu < 1) { fprintf(stderr, "kernel_launch: occupancy query gave %d\n", per_cu); per_cu = 1; }
    (void)hipGetLastError();
    grid = cus * per_cu;
  }
  if (grid < 0) return;
  Args a{};
  for (int i = 0; i < 23; ++i) a.in[i] = (const float*)d_in[i];
  a.out = (float*)d_out; a.ws = (unsigned char*)d_ws;
  void* args[] = {&a};
  hipError_t e = hipLaunchCooperativeKernel((const void*)fwd_kernel, dim3(grid), dim3(512), args, LDS_BYTES, stream);
  if (e != hipSuccess) fprintf(stderr, "cooperative launch failed: %s (grid %d)\n", hipGetErrorString(e), grid);
}
```

```cpp
#include <hip/hip_runtime.h>
#include <hip/hip_cooperative_groups.h>
#include <cstdio>
#include <cstdint>
namespace cg = cooperative_groups;

namespace pg8 {
#define PG8_LAS __attribute__((address_space(3)))
typedef unsigned short bf16_t;
typedef short bf16x8 __attribute__((ext_vector_type(8)));
typedef float f32x4 __attribute__((ext_vector_type(4)));
typedef unsigned u32x4 __attribute__((ext_vector_type(4)));
constexpr int BM = 256, BK = 64, HALF = 128, HTB = HALF * BK * 2  , STAGE_BYTES = 8 * HTB, NXCD = 8, WGM = 4;

__host__ __device__ __forceinline__ int lds_byte(int r, int c) { const int st = (r >> 4) * 2 + (c >> 5), rr = r & 15, cc = c & 31, ob = rr * 64 + cc * 2; return st * 1024 + (ob ^ (((ob >> 9) & 1) << 5)); }
__host__ __device__ __forceinline__ void stage_rc(int b, int& R, int& C) { const int st = b / 1024, sb = b % 1024, swz = sb ^ (((sb >> 9) & 1) << 5); R = (st >> 1) * 16 + swz / 64; C = (st & 1) * 32 + (swz % 64) / 2; }
__host__ __device__ __forceinline__ int perm32(int rho) { const int n = rho >> 4, i = rho & 15; return 8 * (i >> 2) + 4 * n + (i & 3); }

struct Unit { int pm, pn; };
struct Gemm { const bf16_t* A; const bf16_t* Bt; int M, N, K; };

struct StaticOrder {
    int nM, nN, nwg, G, c;
    __host__ __device__ void init(int M, int N, int G_, int c_) { nM = M / BM; nN = N / BM; nwg = nM * nN; G = G_; c = c_; }
    __host__ __device__ bool next(int i, Unit& u) const {
        const long L = (long)i * G + c; if (L >= nwg) return false;
        int wgid = (int)L; { const int q = nwg / NXCD, r = nwg % NXCD, xcd = wgid % NXCD, off = wgid / NXCD; wgid = (xcd < r ? xcd * (q + 1) : r * (q + 1) + (xcd - r) * q) + off; }
        const int nig = WGM * nN, gid = wgid / nig, fm = gid * WGM, gsz = (nM - fm) < WGM ? (nM - fm) : WGM;
        u.pm = fm + ((wgid % nig) % gsz); u.pn = (wgid % nig) / gsz; return true;
    }
    __device__ __forceinline__ void a_ready(const Unit&) const {}
    __device__ __forceinline__ void done(const Unit&) const {}
};


typedef float f32x2_t __attribute__((ext_vector_type(2))); typedef __bf16 bf16x2_t __attribute__((ext_vector_type(2)));
__device__ __forceinline__ unsigned cvt_pk_bf16(float lo, float hi) { f32x2_t v = {lo, hi}; bf16x2_t b = __builtin_convertvector(v, bf16x2_t); return __builtin_bit_cast(unsigned, b); }
__device__ __forceinline__ float silu_f(float x) { return x * __builtin_amdgcn_rcpf(1.0f + __builtin_amdgcn_exp2f(-1.4426950408889634f * x)); }

struct EpiBf16Lim {
    static constexpr bool PERM = true, AFTER_DRAIN = false;
    bf16_t* O; int ldc; int ncols; const float* ss;
    __device__ __forceinline__ void operator()(const f32x4 (&acc)[2][2][4][2], const Unit& u, int wr, int wc, int fr, int fq) const {
        const int row0 = u.pm * BM + wr * 64 + fr; const int col0 = u.pn * BM + wc * 32 + 8 * fq;
        float rsv[2][4];
#pragma unroll
        for (int ai = 0; ai < 2; ++ai)
#pragma unroll
            for (int m = 0; m < 4; ++m) rsv[ai][m] = ss[row0 + ai * HALF + m * 16];
#pragma unroll
        for (int ai = 0; ai < 2; ++ai)
#pragma unroll
            for (int m = 0; m < 4; ++m) { bf16_t* rowp = O + (size_t)(row0 + ai * HALF + m * 16) * ldc + col0;
                const float rs = __builtin_amdgcn_rsqf(rsv[ai][m] * (1.0f / 1024.0f) + 1e-6f);
#pragma unroll
                for (int bj = 0; bj < 2; ++bj) { const f32x4 v0 = acc[ai][bj][m][0] * rs, v1 = acc[ai][bj][m][1] * rs;
                    u32x4 w; w.x = cvt_pk_bf16(v0[0], v0[1]); w.y = cvt_pk_bf16(v0[2], v0[3]); w.z = cvt_pk_bf16(v1[0], v1[1]); w.w = cvt_pk_bf16(v1[2], v1[3]);
                    if (col0 + bj * HALF < ncols) *(u32x4*)(rowp + bj * HALF) = w; } }
    }
};
struct EpiSwiGLU {
    static constexpr bool PERM = true, AFTER_DRAIN = false;
    bf16_t* O; int ldc; const float* ss;
    __device__ __forceinline__ void operator()(const f32x4 (&acc)[2][2][4][2], const Unit& u, int wr, int wc, int fr, int fq) const {
        const int row0 = u.pm * BM + wr * 64 + fr; const int col0 = u.pn * HALF + wc * 32 + 8 * fq;
        float rsv[2][4];
#pragma unroll
        for (int ai = 0; ai < 2; ++ai)
#pragma unroll
            for (int m = 0; m < 4; ++m) rsv[ai][m] = ss[row0 + ai * HALF + m * 16];
#pragma unroll
        for (int ai = 0; ai < 2; ++ai)
#pragma unroll
            for (int m = 0; m < 4; ++m) { bf16_t* rowp = O + (size_t)(row0 + ai * HALF + m * 16) * ldc + col0;
                const float rs = __builtin_amdgcn_rsqf(rsv[ai][m] * (1.0f / 1024.0f) + 1e-6f);
                const f32x4 g0 = acc[ai][0][m][0] * rs, g1 = acc[ai][0][m][1] * rs, u0 = acc[ai][1][m][0] * rs, u1 = acc[ai][1][m][1] * rs;
                u32x4 w;
                w.x = cvt_pk_bf16(silu_f(g0[0]) * u0[0], silu_f(g0[1]) * u0[1]); w.y = cvt_pk_bf16(silu_f(g0[2]) * u0[2], silu_f(g0[3]) * u0[3]);
                w.z = cvt_pk_bf16(silu_f(g1[0]) * u1[0], silu_f(g1[1]) * u1[1]); w.w = cvt_pk_bf16(silu_f(g1[2]) * u1[2], silu_f(g1[3]) * u1[3]);
                *(u32x4*)rowp = w; }
    }
};
typedef unsigned u32x2v __attribute__((ext_vector_type(2)));
struct EpiResid {
    static constexpr bool PERM = true, AFTER_DRAIN = false;
    const float* base; float* out; int ldc; float alpha; bf16_t* xb; float* ss;
    __device__ __forceinline__ void operator()(const f32x4 (&acc)[2][2][4][2], const Unit& u, int wr, int wc, int fr, int fq) const {
        const int row0 = u.pm * BM + wr * 64 + fr; const int col0 = u.pn * BM + wc * 32 + 8 * fq;
#pragma unroll
        for (int ai = 0; ai < 2; ++ai) {
            f32x4 pre[4][2][2];
#pragma unroll
            for (int m = 0; m < 4; ++m) { const size_t off = (size_t)(row0 + ai * HALF + m * 16) * ldc + col0;
#pragma unroll
                for (int bj = 0; bj < 2; ++bj)
#pragma unroll
                    for (int n = 0; n < 2; ++n) pre[m][bj][n] = *(const f32x4*)(base + off + bj * HALF + n * 4); }
#pragma unroll
            for (int m = 0; m < 4; ++m) { const size_t off = (size_t)(row0 + ai * HALF + m * 16) * ldc + col0; float q = 0.f;
#pragma unroll
                for (int bj = 0; bj < 2; ++bj) { const f32x4 o0 = pre[m][bj][0] + acc[ai][bj][m][0] * alpha, o1 = pre[m][bj][1] + acc[ai][bj][m][1] * alpha;
                    *(f32x4*)(out + off + bj * HALF) = o0; *(f32x4*)(out + off + bj * HALF + 4) = o1;
                    if (xb) { q += ((o0[0] * o0[0] + o0[1] * o0[1]) + (o0[2] * o0[2] + o0[3] * o0[3])) + ((o1[0] * o1[0] + o1[1] * o1[1]) + (o1[2] * o1[2] + o1[3] * o1[3]));
                        u32x4 w; w.x = cvt_pk_bf16(o0[0], o0[1]); w.y = cvt_pk_bf16(o0[2], o0[3]); w.z = cvt_pk_bf16(o1[0], o1[1]); w.w = cvt_pk_bf16(o1[2], o1[3]); *(u32x4*)(xb + off + bj * HALF) = w; } }
                if (xb) { q += __shfl_xor(q, 16); q += __shfl_xor(q, 32); if (fq == 0) atomicAdd(ss + row0 + ai * HALF + m * 16, q); } }
        }
    }
};

template <class Epi, class Sched, bool ALIGN_EPI = false, bool SP2 = false>
__device__ __forceinline__ void gemm_phase(PG8_LAS unsigned char* lds, const Gemm g, const Sched& S, const Epi& E, int tid_in) {
    int tid_l = tid_in; asm volatile("" : "+v"(tid_l)); const int tid = tid_l, wid = __builtin_amdgcn_readfirstlane(tid >> 6), lane = tid & 63, wr = wid >> 2, wc = wid & 3, fr = lane & 15, fq = lane >> 4;
    const int K = g.K, nt = K / BK;
    unsigned voffA[2], voffB[2];
#pragma unroll
    for (int i = 0; i < 2; ++i) { int R, C; stage_rc(tid * 16 + i * 8192, R, C); const int Rb = Epi::PERM ? ((R & ~31) + perm32(R & 31)) : R;
        voffA[i] = (unsigned)(R * K + C) * 2u; voffB[i] = (unsigned)(Rb * K + C) * 2u; }
    const size_t kstep = (size_t)(BK * 2);
    const size_t hstep = (size_t)HALF * K * 2;
    const size_t tstep = 2 * hstep;
    const unsigned ldsw = (unsigned)wid * 1024u;
    const int aoff = lds_byte(wr * 64 + fr, fq * 8), boff = lds_byte(wc * 32 + fr, fq * 8);
#define PG8_SA(b, h) (((b) * 2 + (h)) * HTB)
#define PG8_SB(b, h) ((4 + (b) * 2 + (h)) * HTB)
#define PG8_STAGE(bufoff, gbase, voff) do { _Pragma("unroll") for (int _i = 0; _i < 2; ++_i) \
        __builtin_amdgcn_global_load_lds((const unsigned*)((const char*)(gbase) + (voff)[_i]), (PG8_LAS unsigned*)(lds + (bufoff) + ldsw + _i * 8192), 16, 0, 0); } while (0)
#define PG8_LDA(dst, b, h) do { _Pragma("unroll") for (int m = 0; m < 4; ++m) _Pragma("unroll") for (int k = 0; k < 2; ++k) dst[m][k] = *(const PG8_LAS bf16x8*)(lds + PG8_SA(b, h) + aoff + m * 2048 + k * 1024); } while (0)
#define PG8_LDB(dst, b, h) do { _Pragma("unroll") for (int n = 0; n < 2; ++n) _Pragma("unroll") for (int k = 0; k < 2; ++k) dst[n][k] = *(const PG8_LAS bf16x8*)(lds + PG8_SB(b, h) + boff + n * 2048 + k * 1024); } while (0)
#define PG8_MMA(ai, bj, At, Bt) do { __builtin_amdgcn_s_setprio(1); _Pragma("unroll") for (int m = 0; m < 4; ++m) _Pragma("unroll") for (int n = 0; n < 2; ++n) _Pragma("unroll") for (int k = 0; k < 2; ++k) \
        acc[ai][bj][m][n] = __builtin_amdgcn_mfma_f32_16x16x32_bf16(Bt[n][k], At[m][k], acc[ai][bj][m][n], 0, 0, 0); __builtin_amdgcn_s_setprio(0); } while (0)
#define PG8_WAIT_V(n) asm volatile("s_waitcnt vmcnt(" #n ")" ::: "memory")
#define PG8_WAIT_L(n) asm volatile("s_waitcnt lgkmcnt(" #n ")" ::: "memory")
#define PG8_BAR __builtin_amdgcn_s_barrier()
#define PG8_SCHED __builtin_amdgcn_sched_barrier(0)
    Unit cur, nxt; int ui = 0;
    if (!S.next(0, cur)) return;
    f32x4 acc[2][2][4][2];
#pragma unroll
    for (int a = 0; a < 2; ++a)
#pragma unroll
        for (int b = 0; b < 2; ++b)
#pragma unroll
            for (int m = 0; m < 4; ++m)
#pragma unroll
                for (int n = 0; n < 2; ++n) acc[a][b][m][n] = (f32x4){0.f, 0.f, 0.f, 0.f};
    bf16x8 At[4][2], B0[2][2], B1[2][2];
    const char* cA = (const char*)g.A + (size_t)cur.pm * tstep; const char* cB = (const char*)g.Bt + (size_t)cur.pn * tstep;
    S.a_ready(cur);
    if constexpr (SP2) {
        PG8_STAGE(PG8_SB(0, 0), cB, voffB); PG8_STAGE(PG8_SB(0, 1), cB + hstep, voffB); PG8_STAGE(PG8_SA(0, 0), cA, voffA); PG8_STAGE(PG8_SA(0, 1), cA + hstep, voffA);
        if (wr == 1) PG8_BAR;
        PG8_WAIT_V(2); PG8_BAR;
        PG8_STAGE(PG8_SB(1, 0), cB + kstep, voffB); PG8_STAGE(PG8_SA(1, 0), cA + kstep, voffA); PG8_STAGE(PG8_SB(1, 1), cB + hstep + kstep, voffB);
        PG8_WAIT_V(6); PG8_BAR;
    } else {
        PG8_STAGE(PG8_SB(0, 0), cB, voffB); PG8_STAGE(PG8_SA(0, 0), cA, voffA); PG8_STAGE(PG8_SB(0, 1), cB + hstep, voffB); PG8_STAGE(PG8_SA(0, 1), cA + hstep, voffA);
        if (wr == 1) PG8_BAR;
        PG8_WAIT_V(4); PG8_BAR;
        PG8_STAGE(PG8_SB(1, 0), cB + kstep, voffB); PG8_STAGE(PG8_SA(1, 0), cA + kstep, voffA); PG8_STAGE(PG8_SB(1, 1), cB + hstep + kstep, voffB);
        PG8_WAIT_V(6); PG8_BAR;
    }
    for (;;) {
        const bool has_next = S.next(ui + 1, nxt);
        const char* nA = has_next ? (const char*)g.A + (size_t)nxt.pm * tstep : cA; const char* nB = has_next ? (const char*)g.Bt + (size_t)nxt.pn * tstep : cB;
        for (int t = 0; t < nt; t += 2) {
            const bool last = (t == nt - 2);
            const char* a1 = cA + (size_t)(t + 1) * kstep;
            const char* a2 = last ? nA : cA + (size_t)(t + 2) * kstep; const char* b2 = last ? nB : cB + (size_t)(t + 2) * kstep;
            const char* a3 = a2 + kstep; const char* b3 = b2 + kstep;
            if (last && has_next) S.a_ready(nxt);
            if constexpr (SP2) {
            PG8_LDB(B0, 0, 0); PG8_LDB(B1, 0, 1); PG8_SCHED; PG8_LDA(At, 0, 0); PG8_STAGE(PG8_SA(1, 1), a1 + hstep, voffA);
            PG8_WAIT_V(8); PG8_WAIT_L(0); PG8_BAR; PG8_MMA(0, 0, At, B0); PG8_MMA(0, 1, At, B1); PG8_BAR; PG8_SCHED;
            PG8_LDA(At, 0, 1); PG8_STAGE(PG8_SB(0, 0), b2, voffB); PG8_STAGE(PG8_SB(0, 1), b2 + hstep, voffB); PG8_STAGE(PG8_SA(0, 0), a2, voffA);
            PG8_WAIT_V(8); PG8_WAIT_L(0); PG8_BAR; PG8_MMA(1, 0, At, B0); PG8_MMA(1, 1, At, B1); PG8_BAR; PG8_SCHED;
            PG8_LDB(B0, 1, 0); PG8_LDB(B1, 1, 1); PG8_SCHED; PG8_LDA(At, 1, 0); PG8_STAGE(PG8_SA(0, 1), a2 + hstep, voffA);
            PG8_WAIT_V(8); PG8_WAIT_L(0); PG8_BAR; PG8_MMA(0, 0, At, B0); PG8_MMA(0, 1, At, B1); PG8_BAR; PG8_SCHED;
            PG8_LDA(At, 1, 1); PG8_STAGE(PG8_SB(1, 0), b3, voffB); PG8_STAGE(PG8_SB(1, 1), b3 + hstep, voffB); PG8_STAGE(PG8_SA(1, 0), a3, voffA);
            PG8_WAIT_V(8); PG8_WAIT_L(0); PG8_BAR; PG8_MMA(1, 0, At, B0); PG8_MMA(1, 1, At, B1); PG8_BAR; PG8_SCHED;
            } else {
            PG8_LDB(B0, 0, 0); PG8_SCHED; PG8_LDA(At, 0, 0); PG8_STAGE(PG8_SA(1, 1), a1 + hstep, voffA);
            PG8_WAIT_L(8); PG8_BAR; PG8_WAIT_L(0); PG8_MMA(0, 0, At, B0); PG8_BAR; PG8_SCHED;
            PG8_LDB(B1, 0, 1); PG8_STAGE(PG8_SB(0, 0), b2, voffB);
            PG8_BAR; PG8_WAIT_L(0); PG8_MMA(0, 1, At, B1); PG8_BAR;
            PG8_LDA(At, 0, 1); PG8_STAGE(PG8_SA(0, 0), a2, voffA);
            PG8_BAR; PG8_WAIT_L(0); PG8_MMA(1, 0, At, B0); PG8_BAR; PG8_SCHED;
            PG8_STAGE(PG8_SB(0, 1), b2 + hstep, voffB);
            PG8_WAIT_V(6); PG8_BAR; PG8_MMA(1, 1, At, B1); PG8_BAR;
            PG8_LDB(B0, 1, 0); PG8_SCHED; PG8_LDA(At, 1, 0); PG8_STAGE(PG8_SA(0, 1), a2 + hstep, voffA);
            PG8_WAIT_L(8); PG8_BAR; PG8_WAIT_L(0); PG8_MMA(0, 0, At, B0); PG8_BAR; PG8_SCHED;
            PG8_LDB(B1, 1, 1); PG8_STAGE(PG8_SB(1, 0), b3, voffB);
            PG8_BAR; PG8_WAIT_L(0); PG8_MMA(0, 1, At, B1); PG8_BAR;
            PG8_LDA(At, 1, 1); PG8_STAGE(PG8_SA(1, 0), a3, voffA);
            PG8_BAR; PG8_WAIT_L(0); PG8_MMA(1, 0, At, B0); PG8_BAR; PG8_SCHED;
            PG8_STAGE(PG8_SB(1, 1), b3 + hstep, voffB);
            PG8_WAIT_V(6); PG8_BAR; PG8_MMA(1, 1, At, B1); PG8_BAR;
            }
        }
        if constexpr (ALIGN_EPI) { if (wr == 0) PG8_BAR; }
        if constexpr (!Epi::AFTER_DRAIN) { E(acc, cur, wr, wc, fr, fq); S.done(cur); }
        if (!has_next) break;
#pragma unroll
        for (int a = 0; a < 2; ++a)
#pragma unroll
            for (int b = 0; b < 2; ++b)
#pragma unroll
                for (int m = 0; m < 4; ++m)
#pragma unroll
                    for (int n = 0; n < 2; ++n) acc[a][b][m][n] = (f32x4){0.f, 0.f, 0.f, 0.f};
        cur = nxt; cA = nA; cB = nB; ++ui;
        if constexpr (ALIGN_EPI) { if (wr == 1) PG8_BAR; }
    }
    PG8_WAIT_V(0);
    if constexpr (!ALIGN_EPI) { if (wr == 0) PG8_BAR; }
    PG8_BAR;
    if constexpr (Epi::AFTER_DRAIN) { E.fused(acc, cur, wr, wc, fr, fq, lds, wid, lane); S.done(cur); }
#undef PG8_SA
#undef PG8_SB
#undef PG8_STAGE
#undef PG8_LDA
#undef PG8_LDB
#undef PG8_MMA
#undef PG8_WAIT_V
#undef PG8_WAIT_L
#undef PG8_BAR
#undef PG8_SCHED
}
}

typedef unsigned short bf16_t;
typedef short bf16x8 __attribute__((ext_vector_type(8)));
typedef short s16x4 __attribute__((ext_vector_type(4)));
typedef float f32x4 __attribute__((ext_vector_type(4)));
typedef float f32x16 __attribute__((ext_vector_type(16)));
typedef unsigned u32x4 __attribute__((ext_vector_type(4)));
typedef unsigned u32x2 __attribute__((ext_vector_type(2)));
#define DI __device__ __forceinline__
#define LAUNDER(x) asm volatile("" : "+v"(x))

constexpr int T_ = 32768, DM = 1024, FF = 2816, SEQ = 16384, NLAYER = 2;
constexpr int INC = 3336, INP = 3584, PLD = 3344;
constexpr int C_AQ = 0, C_AK = 256, C_AV = 512, C_BQ = 768, C_BK = 1024, C_BV = 1280, C_BO = 1536, C_CQ = 1792, C_CK = 2048, C_CV = 2304, C_DQ = 2560, C_DK = 2816, C_DV = 3072, C_GI = 3328, C_GF = 3332;
constexpr float LOG2E = 1.4426950408889634f, EPS_ = 1e-6f;
#ifndef D_EARLY
#define D_EARLY 1
#endif

constexpr size_t SZ_WGU = (size_t)2 * FF * DM * 2, SZ_WD = (size_t)DM * FF * 2, SZ_WIN = (size_t)INP * DM * 2, SZ_WOUT = (size_t)DM * DM * 2;
constexpr size_t LW_WGU1 = 0, LW_WD1 = LW_WGU1 + SZ_WGU, LW_WIN = LW_WD1 + SZ_WD, LW_WOUT = LW_WIN + SZ_WIN, LW_WGU2 = LW_WOUT + SZ_WOUT, LW_WD2 = LW_WGU2 + SZ_WGU, LW_SIZE = LW_WD2 + SZ_WD;
constexpr size_t WS_CTL = 0, WS_W = 8192, WS_XN = WS_W + NLAYER * LW_SIZE, WS_HP = WS_XN + (size_t)T_ * DM * 2, WS_BQ = WS_HP + (size_t)T_ * PLD * 2,
                 WS_BK = WS_BQ + (size_t)T_ * 256 * 2, WS_BKT = WS_BK + (size_t)T_ * 256 * 2, WS_VT = WS_BKT + (size_t)T_ * 256 * 2, WS_DC = WS_VT + (size_t)4 * T_ * 256 * 2,
                 WS_SC = WS_DC + (size_t)8 * 256 * 4160 * 4, WS_SS = WS_SC + 3 * 8 * 256 * 4, WS_END = WS_SS + (size_t)7 * T_ * 4;
static_assert(WS_XN % 256 == 0 && WS_HP % 256 == 0 && WS_BQ % 256 == 0 && WS_DC % 256 == 0 && (size_t)T_ * FF * 2 <= (size_t)T_ * PLD * 2, "ws map");
constexpr int LDS_BYTES = pg8::STAGE_BYTES + 1024;

DI unsigned pk2(float a, float b) { return pg8::cvt_pk_bf16(a, b); }
DI float bf2f(bf16_t h) { return __uint_as_float((unsigned)h << 16); }
DI float bflo(unsigned w) { return __uint_as_float(w << 16); }
DI float bfhi(unsigned w) { return __uint_as_float(w & 0xffff0000u); }
DI float ex2(float x) { return __builtin_amdgcn_exp2f(x); }
DI float lg2(float x) { return __builtin_amdgcn_logf(x); }
DI float rcpf_(float x) { return __builtin_amdgcn_rcpf(x); }
DI int crow(int r, int hi) { return (r & 3) + 8 * (r >> 2) + 4 * hi; }
#define MFMA32(a, b, c) __builtin_amdgcn_mfma_f32_32x32x16_bf16((a), (b), (c), 0, 0, 0)
DI f32x16 splat16(float v) { f32x16 r;
#pragma unroll
  for (int i = 0; i < 16; ++i) r[i] = v; return r; }
DI bf16x8 pack8(const f32x16& s, int kk) {
  u32x4 p; p.x = pk2(s[8 * kk], s[8 * kk + 1]); p.y = pk2(s[8 * kk + 2], s[8 * kk + 3]); p.z = pk2(s[8 * kk + 4], s[8 * kk + 5]); p.w = pk2(s[8 * kk + 6], s[8 * kk + 7]);
  return __builtin_bit_cast(bf16x8, p); }
DI bf16x8 cat4(s16x4 lo, s16x4 hi) { return __builtin_shufflevector(lo, hi, 0, 1, 2, 3, 4, 5, 6, 7); }

struct Args { const float* in[23]; float* out; unsigned char* ws; };

struct TDesc { const float* W0; const float* W1; const float* gk; bf16_t* WT; int kind, K, N, kt, nt; };
DI TDesc tt_decode(const Args& a, int it) {
  constexpr int I_GU = 16 * 88, I_D = 44 * 16, I_IN = 16 * 56, I_OUT = 16 * 16, I_L = 2 * I_GU + 2 * I_D + I_IN + I_OUT;
  const int l = it / I_L; int r = it % I_L; unsigned char* wl = a.ws + WS_W + (size_t)l * LW_SIZE; TDesc d;
  if (r < I_GU) { d.W0 = a.in[2] + (size_t)l * DM * FF; d.W1 = a.in[3] + (size_t)l * DM * FF; d.gk = a.in[1] + l * DM; d.WT = (bf16_t*)(wl + LW_WGU1); d.kind = 0; d.K = DM; d.N = FF; d.kt = r / 88; d.nt = r % 88; return d; } r -= I_GU;
  if (r < I_D) { d.W0 = a.in[4] + (size_t)l * FF * DM; d.W1 = nullptr; d.gk = nullptr; d.WT = (bf16_t*)(wl + LW_WD1); d.kind = 1; d.K = FF; d.N = DM; d.kt = r / 16; d.nt = r % 16; return d; } r -= I_D;
  if (r < I_IN) { d.W0 = a.in[6] + (size_t)l * DM * INC; d.W1 = nullptr; d.gk = a.in[5] + l * DM; d.WT = (bf16_t*)(wl + LW_WIN); d.kind = 2; d.K = DM; d.N = INC; d.kt = r / 56; d.nt = r % 56; return d; } r -= I_IN;
  if (r < I_OUT) { d.W0 = a.in[18] + (size_t)l * DM * DM; d.W1 = nullptr; d.gk = nullptr; d.WT = (bf16_t*)(wl + LW_WOUT); d.kind = 1; d.K = DM; d.N = DM; d.kt = r / 16; d.nt = r % 16; return d; } r -= I_OUT;
  if (r < I_GU) { d.W0 = a.in[20] + (size_t)l * DM * FF; d.W1 = a.in[21] + (size_t)l * DM * FF; d.gk = a.in[19] + l * DM; d.WT = (bf16_t*)(wl + LW_WGU2); d.kind = 0; d.K = DM; d.N = FF; d.kt = r / 88; d.nt = r % 88; return d; } r -= I_GU;
  d.W0 = a.in[22] + (size_t)l * FF * DM; d.W1 = nullptr; d.gk = nullptr; d.WT = (bf16_t*)(wl + LW_WD2); d.kind = 1; d.K = FF; d.N = DM; d.kt = r / 16; d.nt = r % 16; return d;
}
DI void tt_load(const TDesc& d, f32x4 (&v)[2], int tid) {
  const int n4 = tid & 15, np = d.nt * 64 + 4 * n4, k0 = d.kt * 64; const float* src = d.W0; int col;
  if (d.kind == 0) { const int pn = np >> 8, r = np & 255; src = (r < 128) ? d.W0 : d.W1; col = 128 * pn + (r & 127); }
  else if (d.kind == 1) col = np;
  else col = (np < 1792) ? np : (np < 3328) ? np + 8 : (np < 3336) ? 1792 + (np - 3328) : -1;
#pragma unroll
  for (int p = 0; p < 2; ++p) { const int kk = (tid >> 4) + 32 * p;
    v[p] = (col >= 0) ? *(const f32x4*)(src + (size_t)(k0 + kk) * d.N + col) * (d.gk ? d.gk[k0 + kk] : 1.f) : (f32x4){0.f, 0.f, 0.f, 0.f}; }
}
DI void prologue_weights(const Args& a, unsigned char* lds, int tid) {
  LAUNDER(tid);
  constexpr int NI = 6, NITEMS = NLAYER * (2 * 16 * 88 + 2 * 44 * 16 + 16 * 56 + 16 * 16);
  for (int it0 = blockIdx.x; it0 < NITEMS; it0 += NI * gridDim.x) {
    f32x4 v[NI][2]; TDesc d[NI];
#pragma unroll
    for (int q = 0; q < NI; ++q) { const int it = it0 + q * gridDim.x; if (it < NITEMS) { d[q] = tt_decode(a, it); tt_load(d[q], v[q], tid); } }
#pragma unroll
    for (int q = 0; q < NI; ++q) { float* scr = (float*)lds + q * (64 * 65);
#pragma unroll
      for (int p = 0; p < 2; ++p) { float* w = scr + ((tid >> 4) + 32 * p) * 65 + 4 * (tid & 15); w[0] = v[q][p].x; w[1] = v[q][p].y; w[2] = v[q][p].z; w[3] = v[q][p].w; } }
    __syncthreads();
#pragma unroll
    for (int q = 0; q < NI; ++q) { const int it = it0 + q * gridDim.x; if (it < NITEMS) {
      const int n = tid >> 3, kc = tid & 7; const float* sp = (const float*)lds + q * (64 * 65) + (8 * kc) * 65 + n;
      u32x4 o; o.x = pk2(sp[0], sp[65]); o.y = pk2(sp[2 * 65], sp[3 * 65]); o.z = pk2(sp[4 * 65], sp[5 * 65]); o.w = pk2(sp[6 * 65], sp[7 * 65]);
      *(u32x4*)(d[q].WT + (size_t)(d[q].nt * 64 + n) * d[q].K + d[q].kt * 64 + 8 * kc) = o; } }
    __syncthreads();
  }
}

DI float wave_sum(float v) {
#pragma unroll
  for (int o = 1; o < 64; o <<= 1) v += __shfl_xor(v, o);
  return v; }
DI float wave_max(float v) {
#pragma unroll
  for (int o = 1; o < 64; o <<= 1) v = fmaxf(v, __shfl_xor(v, o));
  return v; }
DI void cast_phase(const float* x, bf16_t* xb, float* ss, int tid) {
  LAUNDER(tid);
  const int lane = tid & 63, gw = blockIdx.x * 8 + (tid >> 6), ngw = gridDim.x * 8;
  for (int i = blockIdx.x * 512 + tid; i < 6 * T_; i += gridDim.x * 512) ss[T_ + i] = 0.f;
  for (int m0 = gw; m0 < T_; m0 += 2 * ngw) {
    f32x4 v[2][4];
#pragma unroll
    for (int r = 0; r < 2; ++r) { const int m = m0 + r * ngw; if (m < T_) { const f32x4* xr = (const f32x4*)(x + (size_t)m * DM) + lane;
#pragma unroll
      for (int j = 0; j < 4; ++j) v[r][j] = xr[64 * j]; } }
#pragma unroll
    for (int r = 0; r < 2; ++r) { const int m = m0 + r * ngw; if (m < T_) { float q = 0.f;
#pragma unroll
      for (int j = 0; j < 4; ++j) q += (v[r][j].x * v[r][j].x + v[r][j].y * v[r][j].y) + (v[r][j].z * v[r][j].z + v[r][j].w * v[r][j].w);
      q = wave_sum(q); if (lane == 0) ss[m] = q;
      u32x2* o = (u32x2*)(xb + (size_t)m * DM) + lane;
#pragma unroll
      for (int j = 0; j < 4; ++j) { u32x2 w; w.x = pk2(v[r][j].x, v[r][j].y); w.y = pk2(v[r][j].z, v[r][j].w); o[64 * j] = w; } } }
  }
}

struct PrepParams { const float *aqg, *akg, *cqg, *ckg, *convw, *convb; };
DI void prep_phase(bf16_t* P, bf16_t* BQ, bf16_t* BK, bf16_t* BKt, bf16_t* Vt, const PrepParams& pp, unsigned char* lds, int tid) {
  LAUNDER(tid);
  float* gt = (float*)lds;
  if (tid < 64) { gt[tid] = pp.aqg[tid]; gt[64 + tid] = pp.akg[tid]; gt[128 + tid] = pp.cqg[tid & 31]; gt[192 + tid] = pp.ckg[tid & 31]; gt[256 + tid] = 1.f; }
  __syncthreads();
  for (int tile = blockIdx.x; tile < T_ / 64; tile += gridDim.x) {
    const int tok0 = tile * 64, b = tok0 / SEQ, s0 = tok0 % SEQ;
    for (int id0 = tid; id0 < 64 * 160; id0 += 10 * 512) {
      u32x4 w4[10]; bf16_t* p4[10];
#pragma unroll
      for (int u = 0; u < 10; ++u) { const int id = id0 + 512 * u, tk = id / 160, ci = id % 160, seg = ci >> 5, within = (ci & 31) * 8;
        const int colb = (seg == 0) ? C_AQ : (seg == 1) ? C_AK : (seg == 2) ? C_CQ : (seg == 3) ? C_CK : C_DQ;
        p4[u] = P + (size_t)(tok0 + tk) * PLD + colb + within; w4[u] = *(const u32x4*)p4[u]; }
#pragma unroll
      for (int u = 0; u < 10; ++u) { const int id = id0 + 512 * u, ci = id % 160, seg = ci >> 5, within = (ci & 31) * 8;
        const u32x4 w = w4[u]; float v[8];
        v[0] = bflo(w.x); v[1] = bfhi(w.x); v[2] = bflo(w.y); v[3] = bfhi(w.y); v[4] = bflo(w.z); v[5] = bfhi(w.z); v[6] = bflo(w.w); v[7] = bfhi(w.w);
        float ss = 0.f;
#pragma unroll
        for (int j = 0; j < 8; ++j) ss += v[j] * v[j];
        ss += __shfl_xor(ss, 1); ss += __shfl_xor(ss, 2);
        const float ss32 = ss; ss += __shfl_xor(ss, 4);
        float sc;
        if (seg < 2) { sc = rsqrtf(ss * (1.f / 64.f) + EPS_) * (seg == 0 ? 0.125f * LOG2E : 1.f); }
        else if (seg < 4) { sc = rsqrtf(ss32 * (1.f / 32.f) + EPS_) * (seg == 2 ? 0.17677669529663687f * LOG2E : 1.f); }
        else { sc = 0.125f * LOG2E; }
        const float* gp = gt + seg * 64 + (within & 63);
        const f32x4 ga = *(const f32x4*)gp, gb = *(const f32x4*)(gp + 4);
        u32x4 o; o.x = pk2(v[0] * sc * ga.x, v[1] * sc * ga.y); o.y = pk2(v[2] * sc * ga.z, v[3] * sc * ga.w); o.z = pk2(v[4] * sc * gb.x, v[5] * sc * gb.y); o.w = pk2(v[6] * sc * gb.z, v[7] * sc * gb.w);
        *(u32x4*)p4[u] = o; }
    }
    bf16_t* Lin = (bf16_t*)(lds + 2048); bf16_t* Lout = Lin + 67 * 264;
    u32x4 r[5];
#define PREP_LOAD_GROUP(G) do { const int col0_ = ((G) == 0) ? C_AV : ((G) == 1) ? C_BV : ((G) == 2) ? C_CV : ((G) == 3) ? C_DV : ((G) == 4) ? C_BQ : C_BK; \
      _Pragma("unroll") for (int u = 0; u < 5; ++u) { const int idx = tid + 512 * u, row = idx >> 5, pc = idx & 31, srow = s0 - 3 + row; \
        r[u] = (u32x4){0u, 0u, 0u, 0u}; \
        if (idx < 67 * 32 && srow >= 0) r[u] = *(const u32x4*)(P + (size_t)(b * SEQ + srow) * PLD + col0_ + 8 * pc); } } while (0)
    PREP_LOAD_GROUP(0);
#pragma unroll
    for (int g = 0; g < 6; ++g) {
      __syncthreads();
#pragma unroll
      for (int u = 0; u < 5; ++u) { const int idx = tid + 512 * u, row = idx >> 5, pc = idx & 31; if (idx < 67 * 32) *(u32x4*)(Lin + row * 264 + 8 * pc) = r[u]; }
      __syncthreads();
      if (g + 1 < 6) PREP_LOAD_GROUP(g + 1);
      const int c = tid & 255, th = tid >> 8; const bf16_t* colp = Lin + (32 * th) * 264 + c;
      if (g < 4) {
        unsigned w[16];
#pragma unroll
        for (int q = 0; q < 16; ++q) { const int p = 2 * q, i = (p & ~12) | ((p & 4) << 1) | ((p & 8) >> 1);
          w[q] = (unsigned)colp[(3 + i) * 264] | ((unsigned)colp[(3 + i + 1) * 264] << 16); }
        bf16_t* vd = Vt + (size_t)g * T_ * 256 + (((size_t)(b * 4 + (c >> 6)) * 256 + (s0 >> 6)) * 64 + (c & 63)) * 64 + 32 * th;
#pragma unroll
        for (int q4 = 0; q4 < 4; ++q4) { u32x4 o; o.x = w[4 * q4]; o.y = w[4 * q4 + 1]; o.z = w[4 * q4 + 2]; o.w = w[4 * q4 + 3]; *(u32x4*)(vd + 8 * q4) = o; }
      } else {
        const int cq = (g - 4) * 256 + c;
        const float w0 = pp.convw[cq], w1 = pp.convw[512 + cq], w2 = pp.convw[1024 + cq], w3 = pp.convw[1536 + cq], bb = pp.convb[cq], sc = (g == 4) ? 1.f : 0.125f;
        float x[35];
#pragma unroll
        for (int i = 0; i < 35; ++i) x[i] = bf2f(colp[i * 264]);
        unsigned short yb[32];
#pragma unroll
        for (int i = 0; i < 32; ++i) { const float y = bb + x[i] * w0 + x[i + 1] * w1 + x[i + 2] * w2 + x[i + 3] * w3; yb[i] = (unsigned short)(pk2(pg8::silu_f(y) * sc, 0.f) & 0xffffu); Lout[(32 * th + i) * 264 + c] = yb[i]; }
        if (g == 5) {
          bf16_t* kd = BKt + (((size_t)(b * 4 + (c >> 6)) * 256 + (s0 >> 6)) * 64 + (c & 63)) * 64 + 32 * th;
#pragma unroll
          for (int q4 = 0; q4 < 4; ++q4) { unsigned w[4];
#pragma unroll
            for (int q = 0; q < 4; ++q) { const int p = 2 * (4 * q4 + q), i = (p & ~12) | ((p & 4) << 1) | ((p & 8) >> 1); w[q] = (unsigned)yb[i] | ((unsigned)yb[i + 1] << 16); }
            u32x4 o; o.x = w[0]; o.y = w[1]; o.z = w[2]; o.w = w[3]; *(u32x4*)(kd + 8 * q4) = o; }
        }
        __syncthreads();
        bf16_t* dst = (g == 4) ? BQ : BK;
#pragma unroll
        for (int u = 0; u < 4; ++u) { const int idx = tid + 512 * u, row = idx >> 5, pc = idx & 31; *(u32x4*)(dst + (size_t)(tok0 + row) * 256 + 8 * pc) = *(const u32x4*)(Lout + row * 264 + 8 * pc); }
      }
    }
    __syncthreads();
  }
}

#undef PREP_LOAD_GROUP
DI float wave_scan_add(float v, int lane) {
#pragma unroll
  for (int o = 1; o < 64; o <<= 1) { const float t = __shfl_up(v, o); if (lane >= o) v += t; }
  return v; }
DI float wave_scan_max(float v, int lane) {
#pragma unroll
  for (int o = 1; o < 64; o <<= 1) { const float t = __shfl_up(v, o); if (lane >= o) v = fmaxf(v, t); }
  return v; }
DI float fexp(float x) { return ex2(x * LOG2E); }
DI float log_sigmoid_f(float x) { return fminf(x, 0.f) - lg2(1.0f + fexp(-fabsf(x))) * 0.6931471805599453f; }
DI void lds_wave_sync() { asm volatile("s_waitcnt lgkmcnt(0)" ::: "memory"); __builtin_amdgcn_wave_barrier(); }

DI void b1_phase(const bf16_t* P, const bf16_t* BKt, const bf16_t* VtB, float* DC, float* SC, const float* gate_bias, unsigned char* lds, int tid) {
  LAUNDER(tid);
  const int lane = tid & 63, wave = tid >> 6, r32 = lane & 31, hi = lane >> 5;
  float* wsc = (float*)(lds + wave * 1024);
  for (int item = blockIdx.x * 8 + wave; item < 2048; item += gridDim.x * 8) {
    const int bh = item >> 8, c = item & 255, b = bh >> 2, h = bh & 3, s0 = c * 64; const size_t tok0 = (size_t)b * SEQ + s0;
    const float gf = bf2f(P[(tok0 + lane) * PLD + C_GF + h]) + gate_bias[4 + h], gi = bf2f(P[(tok0 + lane) * PLD + C_GI + h]) + gate_bias[h];
    const float lf = log_sigmoid_f(gf), bcum = wave_scan_add(lf, lane), btot = __shfl(bcum, 63);
    const float g = btot - bcum + gi, mloc = wave_max(g), w = fexp(g - mloc);
    wsc[lane] = w; lds_wave_sync();
    f32x16 acc[2][2];
#pragma unroll
    for (int i = 0; i < 2; ++i)
#pragma unroll
      for (int j = 0; j < 2; ++j) acc[i][j] = splat16(0.f);
    float dn[2] = {0.f, 0.f};
#pragma unroll
    for (int ks = 0; ks < 4; ++ks) {
      const f32x4 wa = *(const f32x4*)(wsc + 16 * ks + 4 * hi), wb = *(const f32x4*)(wsc + 16 * ks + 8 + 4 * hi);
      bf16x8 vf[2], kf[2];
#pragma unroll
      for (int eb = 0; eb < 2; ++eb) {
        vf[eb] = *(const bf16x8*)(VtB + (((size_t)bh * 256 + c) * 64 + 32 * eb + r32) * 64 + 16 * ks + 8 * hi);
        const u32x4 kw = *(const u32x4*)(BKt + (((size_t)bh * 256 + c) * 64 + 32 * eb + r32) * 64 + 16 * ks + 8 * hi);
        const float k0 = bflo(kw.x) * wa.x, k1 = bfhi(kw.x) * wa.y, k2 = bflo(kw.y) * wa.z, k3 = bfhi(kw.y) * wa.w, k4 = bflo(kw.z) * wb.x, k5 = bfhi(kw.z) * wb.y, k6 = bflo(kw.w) * wb.z, k7 = bfhi(kw.w) * wb.w;
        dn[eb] += ((k0 + k1) + (k2 + k3)) + ((k4 + k5) + (k6 + k7));
        u32x4 o; o.x = pk2(k0, k1); o.y = pk2(k2, k3); o.z = pk2(k4, k5); o.w = pk2(k6, k7); kf[eb] = __builtin_bit_cast(bf16x8, o);
      }
#pragma unroll
      for (int eb = 0; eb < 2; ++eb)
#pragma unroll
        for (int db = 0; db < 2; ++db) acc[eb][db] = MFMA32(vf[eb], kf[db], acc[eb][db]);
    }
    float* dc = DC + ((size_t)bh * 256 + c) * 4160;
#pragma unroll
    for (int eb = 0; eb < 2; ++eb)
#pragma unroll
      for (int db = 0; db < 2; ++db)
#pragma unroll
        for (int i = 0; i < 16; ++i) dc[(32 * eb + crow(i, hi)) * 64 + 32 * db + r32] = acc[eb][db][i];
#pragma unroll
    for (int db = 0; db < 2; ++db) { const float t = dn[db] + __shfl_xor(dn[db], 32); if (hi == 0) dc[4096 + 32 * db + r32] = t; }
    if (lane == 0) { SC[bh * 256 + c] = btot; SC[2048 + bh * 256 + c] = mloc; }
    lds_wave_sync();
  }
}

DI void b2_item(float* DC, float* SC, int j, unsigned char* lds, int tid) {
  LAUNDER(tid);
  float* L = (float*)lds;
  const int ge = j * 512 + tid, bh0 = (j * 512) / 1040, bh1 = (j * 512 + 511) / 1040;
  { const int slot = tid >> 8, c = tid & 255, bh = slot ? bh1 : bh0;
    if (bh < 8) { L[slot * 1024 + c] = SC[bh * 256 + c]; L[slot * 1024 + 256 + c] = SC[2048 + bh * 256 + c]; } }
  __syncthreads();
  if ((tid & 63) == 0 && (tid >> 6) < 2) { const int slot = tid >> 6, bh = slot ? bh1 : bh0;
    if (bh < 8 && (slot == 0 || bh1 != bh0)) { float* q = L + slot * 1024; float m = 0.f; const bool wr = (j * 512 <= bh * 1040) && (bh * 1040 < j * 512 + 512);
      for (int c = 0; c < 256; ++c) { const float b = q[c], l = q[256 + c], mn = fmaxf(b + m, l); q[512 + c] = fexp(b + m - mn); q[768 + c] = fexp(l - mn); if (wr) SC[4096 + bh * 256 + c] = m; m = mn; } } }
  __syncthreads();
  if (ge < 8 * 1040) {
    const int bh = ge / 1040, el = (ge % 1040) * 4; const float* q = L + ((bh == bh0) ? 0 : 1024);
    float* p = DC + (size_t)bh * 256 * 4160 + el; float z0 = 0.f; LAUNDER(z0); f32x4 C = {z0, z0, z0, z0};
    for (int c0 = 0; c0 < 256; c0 += 8) {
      f32x4 d[8];
#pragma unroll
      for (int u = 0; u < 8; ++u) d[u] = *(const f32x4*)(p + (size_t)(c0 + u) * 4160);
#pragma unroll
      for (int u = 0; u < 8; ++u) { *(f32x4*)(p + (size_t)(c0 + u) * 4160) = C; C = C * q[512 + c0 + u] + d[u] * q[768 + c0 + u]; }
    }
  }
}

DI void b3_phase(const bf16_t* P, const bf16_t* BQ, const bf16_t* BK, const bf16_t* VtB, const float* DC, const float* SC, const float* gate_bias, const float* onorm, bf16_t* Y, unsigned char* lds, int tid) {
  LAUNDER(tid);
  const int lane = tid & 63, wave = tid >> 6, r32 = lane & 31, hi = lane >> 5;
  float* R = (float*)(lds + wave * 2048); float* MU = R + 64; float* SI = R + 128; float* EM = R + 192; float* NV = R + 256;
  for (int item = blockIdx.x * 8 + wave; item < 2048; item += gridDim.x * 8) {
    const int bh = item >> 8, c = item & 255, b = bh >> 2, h = bh & 3, s0 = c * 64; const size_t tok0 = (size_t)b * SEQ + s0;
    const float* dc = DC + ((size_t)bh * 256 + c) * 4160;
    {
      const float gf = bf2f(P[(tok0 + lane) * PLD + C_GF + h]) + gate_bias[4 + h], gi = bf2f(P[(tok0 + lane) * PLD + C_GI + h]) + gate_bias[h];
      const float lf = log_sigmoid_f(gf), bcum = wave_scan_add(lf, lane), r = gi - bcum, pmax = wave_scan_max(r, lane);
      const float m_in = SC[4096 + bh * 256 + c], mu = fmaxf(m_in, pmax);
      R[lane] = r; MU[lane] = mu; SI[lane] = fexp(m_in - mu); EM[lane] = fexp(-bcum - mu); NV[lane] = dc[4096 + lane];
    }
    lds_wave_sync();
    bf16x8 cfr[2][4];
#pragma unroll
    for (int eb = 0; eb < 2; ++eb)
#pragma unroll
      for (int ks = 0; ks < 4; ++ks) { const float* cp = dc + (32 * eb + r32) * 64 + 16 * ks + 8 * hi; const f32x4 ca = *(const f32x4*)cp, cb = *(const f32x4*)(cp + 4);
        u32x4 o; o.x = pk2(ca.x, ca.y); o.y = pk2(ca.z, ca.w); o.z = pk2(cb.x, cb.y); o.w = pk2(cb.z, cb.w); cfr[eb][ks] = __builtin_bit_cast(bf16x8, o); }
#pragma unroll
    for (int tq = 0; tq < 2; ++tq) {
      const int t = 32 * tq + r32; const float mu_t = MU[t], si_t = SI[t], em_t = EM[t];
      bf16x8 qf[4]; float qn = 0.f;
#pragma unroll
      for (int ks = 0; ks < 4; ++ks) {
        const u32x4 qw = *(const u32x4*)(BQ + (tok0 + t) * 256 + h * 64 + 16 * ks + 8 * hi); qf[ks] = __builtin_bit_cast(bf16x8, qw);
        const f32x4 na = *(const f32x4*)(NV + 16 * ks + 8 * hi), nb = *(const f32x4*)(NV + 16 * ks + 8 * hi + 4);
        qn += bflo(qw.x) * na.x + bfhi(qw.x) * na.y + bflo(qw.y) * na.z + bfhi(qw.y) * na.w + bflo(qw.z) * nb.x + bfhi(qw.z) * nb.y + bflo(qw.w) * nb.z + bfhi(qw.w) * nb.w;
      }
      qn += __shfl_xor(qn, 32);
      f32x16 G[2], num[2];
#pragma unroll
      for (int eb = 0; eb < 2; ++eb) { G[eb] = splat16(0.f); num[eb] = splat16(0.f);
#pragma unroll
        for (int ks = 0; ks < 4; ++ks) G[eb] = MFMA32(cfr[eb][ks], qf[ks], G[eb]); }
      float dsum = 0.f;
#pragma unroll
      for (int tk = 0; tk < 2; ++tk) {
        if (tk <= tq) {
          f32x16 S = splat16(0.f);
#pragma unroll
          for (int ks = 0; ks < 4; ++ks) { const bf16x8 kf = *(const bf16x8*)(BK + (tok0 + 32 * tk + r32) * 256 + h * 64 + 16 * ks + 8 * hi); S = MFMA32(kf, qf[ks], S); }
          asm volatile("" ::: "memory");
#pragma unroll
          for (int g4 = 0; g4 < 4; ++g4) { const f32x4 rv = *(const f32x4*)(R + 32 * tk + 8 * g4 + 4 * hi);
#pragma unroll
            for (int j = 0; j < 4; ++j) { const int s = 32 * tk + 8 * g4 + 4 * hi + j; const float w = (s <= t) ? fexp(rv[j] - mu_t) : 0.f; const float val = S[4 * g4 + j] * w; dsum += val; S[4 * g4 + j] = val; } }
#pragma unroll
          for (int kk = 0; kk < 2; ++kk) { const bf16x8 pf = pack8(S, kk);
#pragma unroll
            for (int eb = 0; eb < 2; ++eb) { const bf16_t* vp = VtB + (((size_t)bh * 256 + c) * 64 + 32 * eb + r32) * 64 + 32 * tk + 16 * kk + 8 * hi;
              const bf16x8 vf = *(const bf16x8*)vp; num[eb] = MFMA32(vf, pf, num[eb]); } }
          asm volatile("" ::: "memory");
        }
      }
      dsum += __shfl_xor(dsum, 32);
      const float den = si_t * qn + dsum, inv = 1.0f / fmaxf(fabsf(den), em_t);
      float ss = 0.f;
#pragma unroll
      for (int eb = 0; eb < 2; ++eb)
#pragma unroll
        for (int i = 0; i < 16; ++i) { const float hv = (num[eb][i] + si_t * G[eb][i]) * inv; num[eb][i] = hv; ss += hv * hv; }
      ss += __shfl_xor(ss, 32);
      const float rstd = rsqrtf(ss * (1.f / 64.f) + EPS_);
      const bf16_t* bo = P + (tok0 + t) * PLD + C_BO + h * 64; bf16_t* yo = Y + (tok0 + t) * DM + 256 + h * 64;
#pragma unroll
      for (int eb = 0; eb < 2; ++eb)
#pragma unroll
        for (int g4 = 0; g4 < 4; ++g4) { const int e = 32 * eb + 8 * g4 + 4 * hi; const u32x2 bw = *(const u32x2*)(bo + e); const f32x4 gn = *(const f32x4*)(onorm + h * 64 + e);
          const float o0 = num[eb][4 * g4] * rstd * gn.x * rcpf_(1.f + fexp(-bflo(bw.x))), o1 = num[eb][4 * g4 + 1] * rstd * gn.y * rcpf_(1.f + fexp(-bfhi(bw.x)));
          const float o2 = num[eb][4 * g4 + 2] * rstd * gn.z * rcpf_(1.f + fexp(-bflo(bw.y))), o3 = num[eb][4 * g4 + 3] * rstd * gn.w * rcpf_(1.f + fexp(-bfhi(bw.y)));
          u32x2 ow; ow.x = pk2(o0, o1); ow.y = pk2(o2, o3); *(u32x2*)(yo + e) = ow; }
    }
    lds_wave_sync();
  }
}

struct AttnParams { const bf16_t* P; const bf16_t* Vt; bf16_t* Y; const float* biasL; float negM; float lam; float oscale; const float* cgain; };
constexpr int NCH = 1;
template <int MODE>
DI void attn_unit(unsigned char* lds, const AttnParams& ap, int b, int h, int qb, int tid) {
  LAUNDER(tid);
  const int wave = tid >> 6, lane = tid & 63, r32 = lane & 31, hi = lane >> 5, bh = b * 4 + h;
  constexpr int qcol0 = (MODE == 0) ? C_AQ : (MODE == 1) ? C_CQ : C_DQ, kcol0 = (MODE == 0) ? C_AK : (MODE == 1) ? C_CK : C_DK, ycol0 = (MODE == 0) ? 0 : (MODE == 1) ? 512 : 768;
  const bf16_t* Vt = ap.Vt + (size_t)((MODE == 0) ? 0 : (MODE == 1) ? 2 : 3) * T_ * 256;
  const size_t tokb = (size_t)b * SEQ;
  const int qpos = qb * 256 + wave * 32 + r32, cw = qb * 4 + (wave >> 1);
  bf16x8 qf[4];
  { const bf16_t* qp = ap.P + (tokb + qpos) * PLD + qcol0 + h * 64 + 8 * hi;
#pragma unroll
    for (int ks = 0; ks < 4; ++ks) qf[ks] = *(const bf16x8*)(qp + 16 * ks); }
  bf16_t* Ks0 = (bf16_t*)lds; bf16_t* Vs0 = Ks0 + NCH * 64 * 72; volatile int* flags = (volatile int*)(lds + 2 * NCH * 64 * 72 * 2);
  const int jhi = 4 * qb + 3, jlo = (MODE == 0) ? ((4 * qb - 8 > 0) ? 4 * qb - 8 : 0) : 0, ntiles = jhi - jlo + 1;
  const int lrow = tid >> 3, lch = tid & 7;
  const bf16_t* kg = ap.P + (tokb + lrow) * PLD + kcol0 + h * 64 + 8 * lch;
  const bf16_t* vg = Vt + (size_t)bh * 256 * 4096 + lrow * 64 + 8 * lch;
  const int j0 = (MODE == 2) ? jhi : jlo;
  u32x4 kreg[NCH], vreg[NCH];
#pragma unroll
  for (int c = 0; c < NCH; ++c) { const int jc = (MODE == 2) ? j0 - c : j0 + c; kreg[c] = *(const u32x4*)(kg + (size_t)jc * 64 * PLD); vreg[c] = *(const u32x4*)(vg + (size_t)jc * 4096); }
  f32x16 O0[2], O1[2]; float l0 = 0.f, l1 = 0.f, cum = 0.f;
#pragma unroll
  for (int eb = 0; eb < 2; ++eb) { O0[eb] = splat16(0.f); O1[eb] = splat16(0.f); }
  bool wdone = false;
  if (MODE == 2 && D_EARLY) { if (tid < 8) flags[tid] = 0; }
  for (int n = 0; n < ntiles; n += NCH) {
    const int jb = (MODE == 2) ? jhi - n : jlo + n;
    __syncthreads();
    if (MODE == 2 && D_EARLY) { int alld = 1;
#pragma unroll
      for (int w = 0; w < 8; ++w) alld &= flags[w];
      if (alld) break; }
#pragma unroll
    for (int c = 0; c < NCH; ++c) { *(u32x4*)(Ks0 + (c * 64 + lrow) * 72 + 8 * lch) = kreg[c]; *(u32x4*)(Vs0 + (c * 64 + lrow) * 72 + 8 * lch) = vreg[c]; }
    __syncthreads();
    if (n + NCH < ntiles) {
#pragma unroll
      for (int c = 0; c < NCH; ++c) { const int jn = (MODE == 2) ? jb - NCH - c : jb + NCH + c; kreg[c] = *(const u32x4*)(kg + (size_t)jn * 64 * PLD); vreg[c] = *(const u32x4*)(vg + (size_t)jn * 4096); } }
#pragma unroll
    for (int c = 0; c < NCH; ++c) {
    const int j = (MODE == 2) ? jb - c : jb + c;
    const bf16_t* Ks = Ks0 + c * 64 * 72; const bf16_t* Vs = Vs0 + c * 64 * 72;
    const bool active = (j <= cw) && (MODE != 0 || j >= cw - 8);
    if (!active) continue;
    if (MODE == 2 && D_EARLY && wdone) continue;
    if (MODE == 1) {
#pragma unroll
      for (int kh = 0; kh < 2; ++kh) {
        const bf16_t* kb = Ks + (32 * kh + r32) * 72 + 8 * hi;
        bf16x8 p0[2], p1[2];
        { f32x16 s0 = splat16(ap.negM);
          s0 = MFMA32(*(const bf16x8*)(kb), qf[0], s0); s0 = MFMA32(*(const bf16x8*)(kb + 16), qf[1], s0);
#pragma unroll
          for (int i = 0; i < 16; ++i) { s0[i] = ex2(s0[i]); l0 += s0[i]; }
          p0[0] = pack8(s0, 0); p0[1] = pack8(s0, 1); }
        { f32x16 s1 = splat16(ap.negM);
          s1 = MFMA32(*(const bf16x8*)(kb + 32), qf[2], s1); s1 = MFMA32(*(const bf16x8*)(kb + 48), qf[3], s1);
#pragma unroll
          for (int i = 0; i < 16; ++i) { s1[i] = ex2(s1[i]); l1 += s1[i]; }
          p1[0] = pack8(s1, 0); p1[1] = pack8(s1, 1); }
#pragma unroll
        for (int kk = 0; kk < 2; ++kk) {
#pragma unroll
          for (int eb = 0; eb < 2; ++eb) { const bf16_t* vb = Vs + (32 * eb + r32) * 72 + 32 * kh + 16 * kk + 8 * hi; const bf16x8 vf = *(const bf16x8*)vb;
            O0[eb] = MFMA32(vf, p0[kk], O0[eb]); O1[eb] = MFMA32(vf, p1[kk], O1[eb]); } }
      }
    } else if (MODE == 0) {
      const int dch = cw - j; const float binit = ap.negM + ((dch >= 3) ? ap.biasL[256] : 0.f);
#pragma unroll
      for (int kh = 0; kh < 2; ++kh) {
        const bf16_t* kb = Ks + (32 * kh + r32) * 72 + 8 * hi;
        f32x16 s0 = splat16(binit);
#pragma unroll
        for (int ks = 0; ks < 4; ++ks) s0 = MFMA32(*(const bf16x8*)(kb + 16 * ks), qf[ks], s0);
        if (dch < 3) {
#pragma unroll
          for (int i = 0; i < 16; ++i) { int rel = qpos - (64 * j + 32 * kh + crow(i, hi)); rel = rel > 128 ? 128 : (rel < -128 ? -128 : rel); s0[i] += ap.biasL[rel + 128]; } }
#pragma unroll
        for (int i = 0; i < 16; ++i) { s0[i] = ex2(s0[i]); l0 += s0[i]; }
#pragma unroll
        for (int kk = 0; kk < 2; ++kk) { const bf16x8 p0 = pack8(s0, kk);
#pragma unroll
          for (int eb = 0; eb < 2; ++eb) { const bf16_t* vb = Vs + (32 * eb + r32) * 72 + 32 * kh + 16 * kk + 8 * hi; const bf16x8 vf = *(const bf16x8*)vb;
            O0[eb] = MFMA32(vf, p0, O0[eb]); } }
      }
    } else {
      f32x16 z[2];
#pragma unroll
      for (int kh = 0; kh < 2; ++kh) { const bf16_t* kb = Ks + (32 * kh + r32) * 72 + 8 * hi; z[kh] = splat16(0.f);
#pragma unroll
        for (int ks = 0; ks < 4; ++ks) z[kh] = MFMA32(*(const bf16x8*)(kb + 16 * ks), qf[ks], z[kh]); }
      const bool diag = (j == cw); f32x16 sp[2]; float bs[8], ob[8];
#pragma unroll
      for (int kh = 0; kh < 2; ++kh)
#pragma unroll
        for (int g4 = 0; g4 < 4; ++g4) { float t = 0.f;
#pragma unroll
          for (int jj = 0; jj < 4; ++jj) { const int i = 4 * g4 + jj; const bool before = !diag || (64 * j + 32 * kh + crow(i, hi) < qpos);
            const float v = before ? lg2(1.0f + ex2(z[kh][i])) : 0.f; sp[kh][i] = v; t += v; }
          bs[4 * kh + g4] = t; }
#pragma unroll
      for (int p = 0; p < 8; ++p) ob[p] = __shfl_xor(bs[p], 32);
      float Rr = 0.f, saf[8];
#pragma unroll
      for (int p = 7; p >= 0; --p) { const float ev = hi ? ob[p] : bs[p], od = hi ? bs[p] : ob[p]; saf[p] = Rr + (hi ? 0.f : od); Rr += ev + od; }
#pragma unroll
      for (int kh = 0; kh < 2; ++kh)
#pragma unroll
        for (int g4 = 0; g4 < 4; ++g4) { float e = saf[4 * kh + g4];
#pragma unroll
          for (int jj = 3; jj >= 0; --jj) { const int i = 4 * g4 + jj; const bool before = !diag || (64 * j + 32 * kh + crow(i, hi) < qpos);
            const float a = before ? ex2(z[kh][i] - sp[kh][i] - e + cum) : 0.f; e += sp[kh][i]; z[kh][i] = a; } }
      cum -= Rr;
#pragma unroll
      for (int kh = 0; kh < 2; ++kh)
#pragma unroll
        for (int kk = 0; kk < 2; ++kk) { const bf16x8 p0 = pack8(z[kh], kk);
#pragma unroll
          for (int eb = 0; eb < 2; ++eb) { const bf16_t* vb = Vs + (32 * eb + r32) * 72 + 32 * kh + 16 * kk + 8 * hi; const bf16x8 vf = *(const bf16x8*)vb;
            O0[eb] = MFMA32(vf, p0, O0[eb]); } }
      if (D_EARLY) { const int done = __all(cum <= -151.0f); if (lane == 0) flags[wave] = done; wdone = (done != 0); }
    }
    }
  }
  bf16_t* yo = ap.Y + (tokb + qpos) * DM + ycol0 + h * 64;
  if (MODE == 0) { l0 += __shfl_xor(l0, 32); const float inv = 1.0f / l0;
#pragma unroll
    for (int eb = 0; eb < 2; ++eb)
#pragma unroll
      for (int i = 0; i < 16; ++i) O0[eb][i] *= inv;
  } else if (MODE == 1) { l0 += __shfl_xor(l0, 32); l1 += __shfl_xor(l1, 32); const float i0 = 1.0f / l0, i1 = ap.lam / l1; float ss = 0.f;
#pragma unroll
    for (int eb = 0; eb < 2; ++eb)
#pragma unroll
      for (int i = 0; i < 16; ++i) { const float o = O0[eb][i] * i0 - O1[eb][i] * i1; O0[eb][i] = o; ss += o * o; }
    ss += __shfl_xor(ss, 32); const float rstd = rsqrtf(ss * (1.f / 64.f) + EPS_) * ap.oscale;
#pragma unroll
    for (int eb = 0; eb < 2; ++eb)
#pragma unroll
      for (int i = 0; i < 16; ++i) O0[eb][i] *= rstd * ap.cgain[32 * eb + crow(i, hi)];
  }
#pragma unroll
  for (int eb = 0; eb < 2; ++eb)
#pragma unroll
    for (int g4 = 0; g4 < 4; ++g4) { u32x2 ow; ow.x = pk2(O0[eb][4 * g4], O0[eb][4 * g4 + 1]); ow.y = pk2(O0[eb][4 * g4 + 2], O0[eb][4 * g4 + 3]); *(u32x2*)(yo + 32 * eb + 8 * g4 + 4 * hi) = ow; }
}

struct MixParams { AttnParams ap; float* DC; float* SC; const float* relb; const float *aqg, *akg, *cqg, *ckg, *clam, *cog; float lam_init; unsigned* ctr; };
DI void mix_phase(unsigned char* lds, const MixParams& mp, int tid) {
  LAUNDER(tid);
  volatile int* misc = (volatile int*)(lds + pg8::STAGE_BYTES);
  float* biasT = (float*)(lds + 81920);
  float* red = (float*)(lds + 81920 + 4 * 260 * 4);
  for (int i = tid; i < 4 * 257; i += 512) biasT[(i / 257) * 260 + (i % 257)] = mp.relb[i] * LOG2E;
  if (tid < 64) {
    const int lane = tid;
    const float aq = wave_max(fabsf(mp.aqg[lane])), ak = wave_max(fabsf(mp.akg[lane]));
    const float cq = wave_max(fabsf(mp.cqg[lane & 31])), ck = wave_max(fabsf(mp.ckg[lane & 31]));
    const float d1 = wave_sum(lane < 32 ? mp.clam[lane] * mp.clam[32 + lane] : 0.f), d2 = wave_sum(lane < 32 ? mp.clam[64 + lane] * mp.clam[96 + lane] : 0.f);
    if (lane == 0) { red[0] = 8.0f * aq * ak * LOG2E * 1.02f; red[1] = 5.656854249f * cq * ck * LOG2E * 1.02f; red[2] = fexp(d1) - fexp(d2) + mp.lam_init; }
  }
  __syncthreads();
  if (tid < 256) { const int hh = tid >> 6, ln = tid & 63; float m = -1e30f;
#pragma unroll
    for (int i = 0; i < 5; ++i) { const int e = ln + 64 * i; if (e < 257) m = fmaxf(m, biasT[hh * 260 + e]); }
    m = wave_max(m); if (ln == 0) red[4 + hh] = m; }
  __syncthreads();
  const float MA = red[0], MC = red[1], lam = red[2];
  AttnParams ap = mp.ap;
  for (;;) {
    __syncthreads();
    if (tid == 0) misc[0] = (int)atomicAdd(mp.ctr, 1u);
    __syncthreads();
    const int it = misc[0];
    constexpr int NB2 = 17;
    if (it >= NB2 + 3 * 512) break;
    if (it < NB2) { b2_item(mp.DC, mp.SC, it, lds, tid); continue; }
    const int r = (it - NB2) & 511, kind = (it - NB2) >> 9, qb = 63 - (r >> 3), bh = r & 7, b = bh >> 2, h = bh & 3;
    if (kind == 0) { ap.negM = -MC; ap.lam = lam; ap.oscale = 1.0f - mp.lam_init; ap.cgain = mp.cog; attn_unit<1>(lds, ap, b, h, qb, tid); }
    else if (kind == 1) { attn_unit<2>(lds, ap, b, h, qb, tid); }
    else { ap.negM = -(MA + red[4 + h]); ap.biasL = biasT + h * 260; attn_unit<0>(lds, ap, b, h, qb, tid); }
  }
}

DI const float* ldp(const unsigned char* lds, int i) {
  const volatile __attribute__((address_space(3))) unsigned* t = (const volatile __attribute__((address_space(3))) unsigned*)(lds + pg8::STAGE_BYTES + 64);
  const unsigned lo = __builtin_amdgcn_readfirstlane(t[2 * i]), hi = __builtin_amdgcn_readfirstlane(t[2 * i + 1]);
  return (const float*)(const __attribute__((address_space(1))) float*)(((unsigned long long)hi << 32) | lo); }
DI int fresh_tid(int wave_s) { int lane; asm volatile("v_mbcnt_lo_u32_b32 %0, -1, 0\n\tv_mbcnt_hi_u32_b32 %0, -1, %0" : "=v"(lane)); return wave_s * 64 + lane; }

DI void gbar(unsigned* bw, unsigned& k, int tid) {
  ++k;
  asm volatile("s_waitcnt vmcnt(0)" ::: "memory");
  __syncthreads();
  if (tid == 0) {
    __builtin_amdgcn_fence(__ATOMIC_RELEASE, "agent");
    const unsigned G = gridDim.x, x = blockIdx.x & 7u, nloc = (G - x + 7u) >> 3, ngrp = G < 8u ? G : 8u;
    unsigned* xcnt = bw + 64 * x; unsigned* xgen = bw + 64 * (8 + x); unsigned* top = bw + 64 * 16; unsigned* topgen = bw + 64 * 17;
    const unsigned old = __hip_atomic_fetch_add(xcnt, 1u, __ATOMIC_RELAXED, __HIP_MEMORY_SCOPE_AGENT);
    if (old + 1u == k * nloc) {
      const unsigned o2 = __hip_atomic_fetch_add(top, 1u, __ATOMIC_RELAXED, __HIP_MEMORY_SCOPE_AGENT);
      if (o2 + 1u == k * ngrp) __hip_atomic_store(topgen, k, __ATOMIC_RELAXED, __HIP_MEMORY_SCOPE_AGENT);
      else while (__hip_atomic_load(topgen, __ATOMIC_RELAXED, __HIP_MEMORY_SCOPE_AGENT) < k) __builtin_amdgcn_s_sleep(1);
      __hip_atomic_store(xgen, k, __ATOMIC_RELAXED, __HIP_MEMORY_SCOPE_AGENT);
    } else {
      while (__hip_atomic_load(xgen, __ATOMIC_RELAXED, __HIP_MEMORY_SCOPE_AGENT) < k) __builtin_amdgcn_s_sleep(1);
    }
    __builtin_amdgcn_fence(__ATOMIC_ACQUIRE, "agent");
  }
  __syncthreads();
}
#define WSP(off) ((unsigned char*)ldp(lds, 24) + (off))
__global__ void __launch_bounds__(512) fwd_kernel(Args a) {
  extern __shared__ __attribute__((aligned(16))) unsigned char lds[];
  cg::grid_group grid = cg::this_grid();
  const int wave_s = __builtin_amdgcn_readfirstlane(threadIdx.x >> 6);
  if (threadIdx.x == 0) {
    const float** t = (const float**)(lds + pg8::STAGE_BYTES + 64);
#pragma unroll
    for (int i = 0; i < 23; ++i) t[i] = a.in[i];
    t[23] = a.out; t[24] = (const float*)a.ws;
  }
  if (blockIdx.x == 0) { unsigned* ctl = (unsigned*)(a.ws + WS_CTL); for (int i = threadIdx.x; i < 2048; i += 512) ctl[i] = 0u; }
  __syncthreads();
  unsigned bk = 0u;
  PG8_LAS unsigned char* ldsL = (PG8_LAS unsigned char*)lds;
  typedef pg8::StaticOrder SO;

  { Args a2;
#pragma unroll
    for (int i = 0; i < 23; ++i) a2.in[i] = ldp(lds, i);
    a2.out = nullptr; a2.ws = WSP(0);
    prologue_weights(a2, lds, fresh_tid(wave_s)); }
  cast_phase(ldp(lds, 0), (bf16_t*)WSP(WS_XN), (float*)WSP(WS_SS), fresh_tid(wave_s));
  grid.sync();
  for (int l = 0; l < NLAYER; ++l) {
    const size_t wlo = WS_W + (size_t)l * LW_SIZE;
    { const float* xin = (l == 0) ? ldp(lds, 0) : ldp(lds, 23); (void)xin;
      pg8::Gemm g{(bf16_t*)WSP(WS_XN), (const bf16_t*)WSP(wlo + LW_WGU1), T_, 2 * FF, DM}; SO S; S.init(T_, 2 * FF, gridDim.x, blockIdx.x); pg8::EpiSwiGLU E{(bf16_t*)WSP(WS_HP), FF, (const float*)WSP(WS_SS) + (size_t)(3 * l) * T_};
      pg8::gemm_phase<pg8::EpiSwiGLU, SO, true, true>(ldsL, g, S, E, fresh_tid(wave_s)); }
    gbar((unsigned*)WSP(WS_CTL) + 64, bk, fresh_tid(wave_s));
    { const float* xin = (l == 0) ? ldp(lds, 0) : ldp(lds, 23);
      pg8::Gemm g{(bf16_t*)WSP(WS_HP), (const bf16_t*)WSP(wlo + LW_WD1), T_, DM, FF}; SO S; S.init(T_, DM, gridDim.x, blockIdx.x); pg8::EpiResid E{xin, (float*)ldp(lds, 23), DM, 0.5f, (bf16_t*)WSP(WS_XN), (float*)WSP(WS_SS) + (size_t)(3 * l + 1) * T_};
      pg8::gemm_phase<pg8::EpiResid, SO, true, true>(ldsL, g, S, E, fresh_tid(wave_s)); }
    gbar((unsigned*)WSP(WS_CTL) + 64, bk, fresh_tid(wave_s));
    { pg8::Gemm g{(bf16_t*)WSP(WS_XN), (const bf16_t*)WSP(wlo + LW_WIN), T_, INP, DM}; SO S; S.init(T_, INP, gridDim.x, blockIdx.x); pg8::EpiBf16Lim E{(bf16_t*)WSP(WS_HP), PLD, PLD, (const float*)WSP(WS_SS) + (size_t)(3 * l + 1) * T_};
      pg8::gemm_phase<pg8::EpiBf16Lim, SO, true, true>(ldsL, g, S, E, fresh_tid(wave_s)); }
    gbar((unsigned*)WSP(WS_CTL) + 64, bk, fresh_tid(wave_s));
    { PrepParams pp{ldp(lds, 7) + l * 64, ldp(lds, 8) + l * 64, ldp(lds, 14) + l * 32, ldp(lds, 15) + l * 32, ldp(lds, 10) + l * 2048, ldp(lds, 11) + l * 512};
      prep_phase((bf16_t*)WSP(WS_HP), (bf16_t*)WSP(WS_BQ), (bf16_t*)WSP(WS_BK), (bf16_t*)WSP(WS_BKT), (bf16_t*)WSP(WS_VT), pp, lds, fresh_tid(wave_s)); }
    gbar((unsigned*)WSP(WS_CTL) + 64, bk, fresh_tid(wave_s));
    b1_phase((bf16_t*)WSP(WS_HP), (bf16_t*)WSP(WS_BKT), (bf16_t*)WSP(WS_VT) + (size_t)T_ * 256, (float*)WSP(WS_DC), (float*)WSP(WS_SC), ldp(lds, 12) + l * 8, lds, fresh_tid(wave_s));
    gbar((unsigned*)WSP(WS_CTL) + 64, bk, fresh_tid(wave_s));
    { const float lam_init = (l == 0) ? 0.2f : (0.8f - 0.6f * 0.7408182206817179f);
      MixParams mp; mp.ap.P = (bf16_t*)WSP(WS_HP); mp.ap.Vt = (bf16_t*)WSP(WS_VT); mp.ap.Y = (bf16_t*)WSP(WS_XN); mp.ap.biasL = nullptr; mp.ap.negM = 0.f; mp.ap.lam = 0.f; mp.ap.oscale = 1.f; mp.ap.cgain = nullptr;
      mp.DC = (float*)WSP(WS_DC); mp.SC = (float*)WSP(WS_SC); mp.relb = ldp(lds, 9) + l * 4 * 257; mp.aqg = ldp(lds, 7) + l * 64; mp.akg = ldp(lds, 8) + l * 64; mp.cqg = ldp(lds, 14) + l * 32; mp.ckg = ldp(lds, 15) + l * 32;
      mp.clam = ldp(lds, 16) + l * 128; mp.cog = ldp(lds, 17) + l * 64; mp.lam_init = lam_init; mp.ctr = (unsigned*)WSP(WS_CTL) + l;
      mix_phase(lds, mp, fresh_tid(wave_s)); }
    gbar((unsigned*)WSP(WS_CTL) + 64, bk, fresh_tid(wave_s));
    b3_phase((bf16_t*)WSP(WS_HP), (bf16_t*)WSP(WS_BQ), (bf16_t*)WSP(WS_BK), (bf16_t*)WSP(WS_VT) + (size_t)T_ * 256, (float*)WSP(WS_DC), (float*)WSP(WS_SC), ldp(lds, 12) + l * 8, ldp(lds, 13) + l * 256, (bf16_t*)WSP(WS_XN), lds, fresh_tid(wave_s));
    gbar((unsigned*)WSP(WS_CTL) + 64, bk, fresh_tid(wave_s));
    { float* xo = (float*)ldp(lds, 23);
      pg8::Gemm g{(bf16_t*)WSP(WS_XN), (const bf16_t*)WSP(wlo + LW_WOUT), T_, DM, DM}; SO S; S.init(T_, DM, gridDim.x, blockIdx.x); pg8::EpiResid E{xo, xo, DM, 1.0f, (bf16_t*)WSP(WS_BQ), (float*)WSP(WS_SS) + (size_t)(3 * l + 2) * T_};
      pg8::gemm_phase<pg8::EpiResid, SO, true, true>(ldsL, g, S, E, fresh_tid(wave_s)); }
    gbar((unsigned*)WSP(WS_CTL) + 64, bk, fresh_tid(wave_s));
    { pg8::Gemm g{(bf16_t*)WSP(WS_BQ), (const bf16_t*)WSP(wlo + LW_WGU2), T_, 2 * FF, DM}; SO S; S.init(T_, 2 * FF, gridDim.x, blockIdx.x); pg8::EpiSwiGLU E{(bf16_t*)WSP(WS_HP), FF, (const float*)WSP(WS_SS) + (size_t)(3 * l + 2) * T_};
      pg8::gemm_phase<pg8::EpiSwiGLU, SO, true, true>(ldsL, g, S, E, fresh_tid(wave_s)); }
    gbar((unsigned*)WSP(WS_CTL) + 64, bk, fresh_tid(wave_s));
    { float* xo = (float*)ldp(lds, 23);
      pg8::Gemm g{(bf16_t*)WSP(WS_HP), (const bf16_t*)WSP(wlo + LW_WD2), T_, DM, FF}; SO S; S.init(T_, DM, gridDim.x, blockIdx.x); pg8::EpiResid E{xo, xo, DM, 0.5f, (l + 1 < NLAYER) ? (bf16_t*)WSP(WS_XN) : nullptr, (float*)WSP(WS_SS) + (size_t)(3 * l + 3) * T_};
      pg8::gemm_phase<pg8::EpiResid, SO, true, true>(ldsL, g, S, E, fresh_tid(wave_s)); }
    if (l + 1 < NLAYER) gbar((unsigned*)WSP(WS_CTL) + 64, bk, fresh_tid(wave_s));
  }
}

extern "C" void kernel_launch(void* const* d_in, const int* in_sizes, int n_in, void* d_out, int out_size, void* d_ws, size_t ws_size, hipStream_t stream) {
  static int grid = 0;
  if (grid == 0) {
    if (n_in != 23 || out_size != T_ * DM || ws_size < WS_END) { fprintf(stderr, "kernel_launch: unexpected problem (n_in %d out %d ws %zu need %zu)\n", n_in, out_size, ws_size, (size_t)WS_END); grid = -1; return; }
    int dev = 0, cus = 0, per_cu = 0;
    hipGetDevice(&dev); hipDeviceGetAttribute(&cus, hipDeviceAttributeMultiprocessorCount, dev);
    if (hipFuncSetAttribute((const void*)fwd_kernel, hipFuncAttributeMaxDynamicSharedMemorySize, LDS_BYTES) != hipSuccess) fprintf(stderr, "kernel_launch: hipFuncSetAttribute failed\n");
    if (hipOccupancyMaxActiveBlocksPerMultiprocessor(&per_cu, (const void*)fwd_kernel, 512, LDS_BYTES) != hipSuccess || per_cu < 1) { fprintf(stderr, "kernel_launch: occupancy query gave %d\n", per_cu); per_cu = 1; }
    (void)hipGetLastError();
    grid = cus * per_cu;
  }
  if (grid < 0) return;
  Args a{};
  for (int i = 0; i < 23; ++i) a.in[i] = (const float*)d_in[i];
  a.out = (float*)d_out; a.ws = (unsigned char*)d_ws;
  void* args[] = {&a};
  hipError_t e = hipLaunchCooperativeKernel((const void*)fwd_kernel, dim3(grid), dim3(512), args, LDS_BYTES, stream);
  if (e != hipSuccess) fprintf(stderr, "cooperative launch failed: %s (grid %d)\n", hipGetErrorString(e), grid);
}
```

```cpp
#include <hip/hip_runtime.h>
#include <hip/hip_cooperative_groups.h>
#include <cstdio>
#include <cstdint>
namespace cg = cooperative_groups;

namespace pg8 {
#define PG8_LAS __attribute__((address_space(3)))
typedef unsigned short bf16_t;
typedef short bf16x8 __attribute__((ext_vector_type(8)));
typedef float f32x4 __attribute__((ext_vector_type(4)));
typedef unsigned u32x4 __attribute__((ext_vector_type(4)));
constexpr int BM = 256, BK = 64, HALF = 128, HTB = HALF * BK * 2  , STAGE_BYTES = 8 * HTB, NXCD = 8, WGM = 4;

__host__ __device__ __forceinline__ int lds_byte(int r, int c) { const int st = (r >> 4) * 2 + (c >> 5), rr = r & 15, cc = c & 31, ob = rr * 64 + cc * 2; return st * 1024 + (ob ^ (((ob >> 9) & 1) << 5)); }
__host__ __device__ __forceinline__ void stage_rc(int b, int& R, int& C) { const int st = b / 1024, sb = b % 1024, swz = sb ^ (((sb >> 9) & 1) << 5); R = (st >> 1) * 16 + swz / 64; C = (st & 1) * 32 + (swz % 64) / 2; }
__host__ __device__ __forceinline__ int perm32(int rho) { const int n = rho >> 4, i = rho & 15; return 8 * (i >> 2) + 4 * n + (i & 3); }

struct Unit { int pm, pn; };
struct Gemm { const bf16_t* A; const bf16_t* Bt; int M, N, K; };

struct StaticOrder {
    int nM, nN, nwg, G, c;
    __host__ __device__ void init(int M, int N, int G_, int c_) { nM = M / BM; nN = N / BM; nwg = nM * nN; G = G_; c = c_; }
    __host__ __device__ bool next(int i, Unit& u) const {
        const long L = (long)i * G + c; if (L >= nwg) return false;
        int wgid = (int)L; { const int q = nwg / NXCD, r = nwg % NXCD, xcd = wgid % NXCD, off = wgid / NXCD; wgid = (xcd < r ? xcd * (q + 1) : r * (q + 1) + (xcd - r) * q) + off; }
        const int nig = WGM * nN, gid = wgid / nig, fm = gid * WGM, gsz = (nM - fm) < WGM ? (nM - fm) : WGM;
        u.pm = fm + ((wgid % nig) % gsz); u.pn = (wgid % nig) / gsz; return true;
    }
    __device__ __forceinline__ void a_ready(const Unit&) const {}
    __device__ __forceinline__ void done(const Unit&) const {}
};


typedef float f32x2_t __attribute__((ext_vector_type(2))); typedef __bf16 bf16x2_t __attribute__((ext_vector_type(2)));
__device__ __forceinline__ unsigned cvt_pk_bf16(float lo, float hi) { f32x2_t v = {lo, hi}; bf16x2_t b = __builtin_convertvector(v, bf16x2_t); return __builtin_bit_cast(unsigned, b); }
__device__ __forceinline__ float silu_f(float x) { return x * __builtin_amdgcn_rcpf(1.0f + __builtin_amdgcn_exp2f(-1.4426950408889634f * x)); }

struct EpiBf16Lim {
    static constexpr bool PERM = true, AFTER_DRAIN = false;
    bf16_t* O; int ldc; int ncols; const float* ss;
    __device__ __forceinline__ void operator()(const f32x4 (&acc)[2][2][4][2], const Unit& u, int wr, int wc, int fr, int fq) const {
        const int row0 = u.pm * BM + wr * 64 + fr; const int col0 = u.pn * BM + wc * 32 + 8 * fq;
        float rsv[2][4];
#pragma unroll
        for (int ai = 0; ai < 2; ++ai)
#pragma unroll
            for (int m = 0; m < 4; ++m) rsv[ai][m] = ss[row0 + ai * HALF + m * 16];
#pragma unroll
        for (int ai = 0; ai < 2; ++ai)
#pragma unroll
            for (int m = 0; m < 4; ++m) { bf16_t* rowp = O + (size_t)(row0 + ai * HALF + m * 16) * ldc + col0;
                const float rs = __builtin_amdgcn_rsqf(rsv[ai][m] * (1.0f / 1024.0f) + 1e-6f);
#pragma unroll
                for (int bj = 0; bj < 2; ++bj) { const f32x4 v0 = acc[ai][bj][m][0] * rs, v1 = acc[ai][bj][m][1] * rs;
                    u32x4 w; w.x = cvt_pk_bf16(v0[0], v0[1]); w.y = cvt_pk_bf16(v0[2], v0[3]); w.z = cvt_pk_bf16(v1[0], v1[1]); w.w = cvt_pk_bf16(v1[2], v1[3]);
                    if (col0 + bj * HALF < ncols) *(u32x4*)(rowp + bj * HALF) = w; } }
    }
};
struct EpiSwiGLU {
    static constexpr bool PERM = true, AFTER_DRAIN = false;
    bf16_t* O; int ldc; const float* ss;
    __device__ __forceinline__ void operator()(const f32x4 (&acc)[2][2][4][2], const Unit& u, int wr, int wc, int fr, int fq) const {
        const int row0 = u.pm * BM + wr * 64 + fr; const int col0 = u.pn * HALF + wc * 32 + 8 * fq;
        float rsv[2][4];
#pragma unroll
        for (int ai = 0; ai < 2; ++ai)
#pragma unroll
            for (int m = 0; m < 4; ++m) rsv[ai][m] = ss[row0 + ai * HALF + m * 16];
#pragma unroll
        for (int ai = 0; ai < 2; ++ai)
#pragma unroll
            for (int m = 0; m < 4; ++m) { bf16_t* rowp = O + (size_t)(row0 + ai * HALF + m * 16) * ldc + col0;
                const float rs = __builtin_amdgcn_rsqf(rsv[ai][m] * (1.0f / 1024.0f) + 1e-6f), c1 = rs * -1.4426950408889634f, c2 = rs * rs;
                const f32x4 g0 = acc[ai][0][m][0], g1 = acc[ai][0][m][1];
                f32x4 e0 = g0 * c1, e1 = g1 * c1;
                const f32x4 p0 = g0 * acc[ai][1][m][0], p1 = g1 * acc[ai][1][m][1];
#pragma unroll
                for (int i = 0; i < 4; ++i) { e0[i] = __builtin_amdgcn_exp2f(e0[i]); e1[i] = __builtin_amdgcn_exp2f(e1[i]); }
                e0 = e0 + 1.0f; e1 = e1 + 1.0f;
#pragma unroll
                for (int i = 0; i < 4; ++i) { e0[i] = __builtin_amdgcn_rcpf(e0[i]); e1[i] = __builtin_amdgcn_rcpf(e1[i]); }
                const f32x4 o0 = p0 * (e0 * c2), o1 = p1 * (e1 * c2);
                u32x4 w; w.x = cvt_pk_bf16(o0[0], o0[1]); w.y = cvt_pk_bf16(o0[2], o0[3]); w.z = cvt_pk_bf16(o1[0], o1[1]); w.w = cvt_pk_bf16(o1[2], o1[3]);
                *(u32x4*)rowp = w; }
    }
};
typedef unsigned u32x2v __attribute__((ext_vector_type(2)));
struct EpiResid {
    static constexpr bool PERM = true, AFTER_DRAIN = false;
    const float* base; float* out; int ldc; float alpha; bf16_t* xb; float* ss;
    __device__ __forceinline__ void operator()(const f32x4 (&acc)[2][2][4][2], const Unit& u, int wr, int wc, int fr, int fq) const {
        const int row0 = u.pm * BM + wr * 64 + fr; const int col0 = u.pn * BM + wc * 32 + 8 * fq;
#pragma unroll
        for (int ai = 0; ai < 2; ++ai) {
            f32x4 pre[4][2][2];
#pragma unroll
            for (int m = 0; m < 4; ++m) { const size_t off = (size_t)(row0 + ai * HALF + m * 16) * ldc + col0;
#pragma unroll
                for (int bj = 0; bj < 2; ++bj)
#pragma unroll
                    for (int n = 0; n < 2; ++n) pre[m][bj][n] = *(const f32x4*)(base + off + bj * HALF + n * 4); }
#pragma unroll
            for (int m = 0; m < 4; ++m) { const size_t off = (size_t)(row0 + ai * HALF + m * 16) * ldc + col0; float q = 0.f;
#pragma unroll
                for (int bj = 0; bj < 2; ++bj) { const f32x4 o0 = pre[m][bj][0] + acc[ai][bj][m][0] * alpha, o1 = pre[m][bj][1] + acc[ai][bj][m][1] * alpha;
                    *(f32x4*)(out + off + bj * HALF) = o0; *(f32x4*)(out + off + bj * HALF + 4) = o1;
                    if (xb) { q += ((o0[0] * o0[0] + o0[1] * o0[1]) + (o0[2] * o0[2] + o0[3] * o0[3])) + ((o1[0] * o1[0] + o1[1] * o1[1]) + (o1[2] * o1[2] + o1[3] * o1[3]));
                        u32x4 w; w.x = cvt_pk_bf16(o0[0], o0[1]); w.y = cvt_pk_bf16(o0[2], o0[3]); w.z = cvt_pk_bf16(o1[0], o1[1]); w.w = cvt_pk_bf16(o1[2], o1[3]); *(u32x4*)(xb + off + bj * HALF) = w; } }
                if (xb) { q += __shfl_xor(q, 16); q += __shfl_xor(q, 32); if (fq == 0) atomicAdd(ss + row0 + ai * HALF + m * 16, q); } }
        }
    }
};

template <class Epi, class Sched, bool ALIGN_EPI = false, bool SP2 = false>
__device__ __forceinline__ void gemm_phase(PG8_LAS unsigned char* lds, const Gemm g, const Sched& S, const Epi& E, int tid_in) {
    int tid_l = tid_in; asm volatile("" : "+v"(tid_l)); const int tid = tid_l, wid = __builtin_amdgcn_readfirstlane(tid >> 6), lane = tid & 63, wr = wid >> 2, wc = wid & 3, fr = lane & 15, fq = lane >> 4;
    const int K = g.K, nt = K / BK;
    unsigned voffA[2], voffB[2];
#pragma unroll
    for (int i = 0; i < 2; ++i) { int R, C; stage_rc(tid * 16 + i * 8192, R, C); const int Rb = Epi::PERM ? ((R & ~31) + perm32(R & 31)) : R;
        voffA[i] = (unsigned)(R * K + C) * 2u; voffB[i] = (unsigned)(Rb * K + C) * 2u; }
    const size_t kstep = (size_t)(BK * 2);
    const size_t hstep = (size_t)HALF * K * 2;
    const size_t tstep = 2 * hstep;
    const unsigned ldsw = (unsigned)wid * 1024u;
    const int aoff = lds_byte(wr * 64 + fr, fq * 8), boff = lds_byte(wc * 32 + fr, fq * 8);
#define PG8_SA(b, h) (((b) * 2 + (h)) * HTB)
#define PG8_SB(b, h) ((4 + (b) * 2 + (h)) * HTB)
#define PG8_STAGE(bufoff, gbase, voff) do { _Pragma("unroll") for (int _i = 0; _i < 2; ++_i) \
        __builtin_amdgcn_global_load_lds((const unsigned*)((const char*)(gbase) + (voff)[_i]), (PG8_LAS unsigned*)(lds + (bufoff) + ldsw + _i * 8192), 16, 0, 0); } while (0)
#define PG8_LDA(dst, b, h) do { _Pragma("unroll") for (int m = 0; m < 4; ++m) _Pragma("unroll") for (int k = 0; k < 2; ++k) dst[m][k] = *(const PG8_LAS bf16x8*)(lds + PG8_SA(b, h) + aoff + m * 2048 + k * 1024); } while (0)
#define PG8_LDB(dst, b, h) do { _Pragma("unroll") for (int n = 0; n < 2; ++n) _Pragma("unroll") for (int k = 0; k < 2; ++k) dst[n][k] = *(const PG8_LAS bf16x8*)(lds + PG8_SB(b, h) + boff + n * 2048 + k * 1024); } while (0)
#define PG8_MMA(ai, bj, At, Bt) do { __builtin_amdgcn_s_setprio(1); _Pragma("unroll") for (int m = 0; m < 4; ++m) _Pragma("unroll") for (int n = 0; n < 2; ++n) _Pragma("unroll") for (int k = 0; k < 2; ++k) \
        acc[ai][bj][m][n] = __builtin_amdgcn_mfma_f32_16x16x32_bf16(Bt[n][k], At[m][k], acc[ai][bj][m][n], 0, 0, 0); __builtin_amdgcn_s_setprio(0); } while (0)
#define PG8_WAIT_V(n) asm volatile("s_waitcnt vmcnt(" #n ")" ::: "memory")
#define PG8_WAIT_L(n) asm volatile("s_waitcnt lgkmcnt(" #n ")" ::: "memory")
#define PG8_BAR __builtin_amdgcn_s_barrier()
#define PG8_SCHED __builtin_amdgcn_sched_barrier(0)
    Unit cur, nxt; int ui = 0;
    if (!S.next(0, cur)) return;
    f32x4 acc[2][2][4][2];
#pragma unroll
    for (int a = 0; a < 2; ++a)
#pragma unroll
        for (int b = 0; b < 2; ++b)
#pragma unroll
            for (int m = 0; m < 4; ++m)
#pragma unroll
                for (int n = 0; n < 2; ++n) acc[a][b][m][n] = (f32x4){0.f, 0.f, 0.f, 0.f};
    bf16x8 At[4][2], B0[2][2], B1[2][2];
    const char* cA = (const char*)g.A + (size_t)cur.pm * tstep; const char* cB = (const char*)g.Bt + (size_t)cur.pn * tstep;
    S.a_ready(cur);
    if constexpr (SP2) {
        PG8_STAGE(PG8_SB(0, 0), cB, voffB); PG8_STAGE(PG8_SB(0, 1), cB + hstep, voffB); PG8_STAGE(PG8_SA(0, 0), cA, voffA); PG8_STAGE(PG8_SA(0, 1), cA + hstep, voffA);
        if (wr == 1) PG8_BAR;
        PG8_WAIT_V(2); PG8_BAR;
        PG8_STAGE(PG8_SB(1, 0), cB + kstep, voffB); PG8_STAGE(PG8_SA(1, 0), cA + kstep, voffA); PG8_STAGE(PG8_SB(1, 1), cB + hstep + kstep, voffB);
        PG8_WAIT_V(6); PG8_BAR;
    } else {
        PG8_STAGE(PG8_SB(0, 0), cB, voffB); PG8_STAGE(PG8_SA(0, 0), cA, voffA); PG8_STAGE(PG8_SB(0, 1), cB + hstep, voffB); PG8_STAGE(PG8_SA(0, 1), cA + hstep, voffA);
        if (wr == 1) PG8_BAR;
        PG8_WAIT_V(4); PG8_BAR;
        PG8_STAGE(PG8_SB(1, 0), cB + kstep, voffB); PG8_STAGE(PG8_SA(1, 0), cA + kstep, voffA); PG8_STAGE(PG8_SB(1, 1), cB + hstep + kstep, voffB);
        PG8_WAIT_V(6); PG8_BAR;
    }
    for (;;) {
        const bool has_next = S.next(ui + 1, nxt);
        const char* nA = has_next ? (const char*)g.A + (size_t)nxt.pm * tstep : cA; const char* nB = has_next ? (const char*)g.Bt + (size_t)nxt.pn * tstep : cB;
        for (int t = 0; t < nt; t += 2) {
            const bool last = (t == nt - 2);
            const char* a1 = cA + (size_t)(t + 1) * kstep;
            const char* a2 = last ? nA : cA + (size_t)(t + 2) * kstep; const char* b2 = last ? nB : cB + (size_t)(t + 2) * kstep;
            const char* a3 = a2 + kstep; const char* b3 = b2 + kstep;
            if (last && has_next) S.a_ready(nxt);
            if constexpr (SP2) {
            PG8_LDB(B0, 0, 0); PG8_LDB(B1, 0, 1); PG8_SCHED; PG8_LDA(At, 0, 0); PG8_STAGE(PG8_SA(1, 1), a1 + hstep, voffA);
            PG8_WAIT_V(8); PG8_WAIT_L(0); PG8_BAR; PG8_MMA(0, 0, At, B0); PG8_MMA(0, 1, At, B1); PG8_BAR; PG8_SCHED;
            PG8_LDA(At, 0, 1); PG8_STAGE(PG8_SB(0, 0), b2, voffB); PG8_STAGE(PG8_SB(0, 1), b2 + hstep, voffB); PG8_STAGE(PG8_SA(0, 0), a2, voffA);
            PG8_WAIT_V(8); PG8_WAIT_L(0); PG8_BAR; PG8_MMA(1, 0, At, B0); PG8_MMA(1, 1, At, B1); PG8_BAR; PG8_SCHED;
            PG8_LDB(B0, 1, 0); PG8_LDB(B1, 1, 1); PG8_SCHED; PG8_LDA(At, 1, 0); PG8_STAGE(PG8_SA(0, 1), a2 + hstep, voffA);
            PG8_WAIT_V(8); PG8_WAIT_L(0); PG8_BAR; PG8_MMA(0, 0, At, B0); PG8_MMA(0, 1, At, B1); PG8_BAR; PG8_SCHED;
            PG8_LDA(At, 1, 1); PG8_STAGE(PG8_SB(1, 0), b3, voffB); PG8_STAGE(PG8_SB(1, 1), b3 + hstep, voffB); PG8_STAGE(PG8_SA(1, 0), a3, voffA);
            PG8_WAIT_V(8); PG8_WAIT_L(0); PG8_BAR; PG8_MMA(1, 0, At, B0); PG8_MMA(1, 1, At, B1); PG8_BAR; PG8_SCHED;
            } else {
            PG8_LDB(B0, 0, 0); PG8_SCHED; PG8_LDA(At, 0, 0); PG8_STAGE(PG8_SA(1, 1), a1 + hstep, voffA);
            PG8_WAIT_L(8); PG8_BAR; PG8_WAIT_L(0); PG8_MMA(0, 0, At, B0); PG8_BAR; PG8_SCHED;
            PG8_LDB(B1, 0, 1); PG8_STAGE(PG8_SB(0, 0), b2, voffB);
            PG8_BAR; PG8_WAIT_L(0); PG8_MMA(0, 1, At, B1); PG8_BAR;
            PG8_LDA(At, 0, 1); PG8_STAGE(PG8_SA(0, 0), a2, voffA);
            PG8_BAR; PG8_WAIT_L(0); PG8_MMA(1, 0, At, B0); PG8_BAR; PG8_SCHED;
            PG8_STAGE(PG8_SB(0, 1), b2 + hstep, voffB);
            PG8_WAIT_V(6); PG8_BAR; PG8_MMA(1, 1, At, B1); PG8_BAR;
            PG8_LDB(B0, 1, 0); PG8_SCHED; PG8_LDA(At, 1, 0); PG8_STAGE(PG8_SA(0, 1), a2 + hstep, voffA);
            PG8_WAIT_L(8); PG8_BAR; PG8_WAIT_L(0); PG8_MMA(0, 0, At, B0); PG8_BAR; PG8_SCHED;
            PG8_LDB(B1, 1, 1); PG8_STAGE(PG8_SB(1, 0), b3, voffB);
            PG8_BAR; PG8_WAIT_L(0); PG8_MMA(0, 1, At, B1); PG8_BAR;
            PG8_LDA(At, 1, 1); PG8_STAGE(PG8_SA(1, 0), a3, voffA);
            PG8_BAR; PG8_WAIT_L(0); PG8_MMA(1, 0, At, B0); PG8_BAR; PG8_SCHED;
            PG8_STAGE(PG8_SB(1, 1), b3 + hstep, voffB);
            PG8_WAIT_V(6); PG8_BAR; PG8_MMA(1, 1, At, B1); PG8_BAR;
            }
        }
        if constexpr (ALIGN_EPI) { if (wr == 0) PG8_BAR; }
        if constexpr (!Epi::AFTER_DRAIN) { E(acc, cur, wr, wc, fr, fq); S.done(cur); }
        if (!has_next) break;
#pragma unroll
        for (int a = 0; a < 2; ++a)
#pragma unroll
            for (int b = 0; b < 2; ++b)
#pragma unroll
                for (int m = 0; m < 4; ++m)
#pragma unroll
                    for (int n = 0; n < 2; ++n) acc[a][b][m][n] = (f32x4){0.f, 0.f, 0.f, 0.f};
        cur = nxt; cA = nA; cB = nB; ++ui;
        if constexpr (ALIGN_EPI) { if (wr == 1) PG8_BAR; }
    }
    PG8_WAIT_V(0);
    if constexpr (!ALIGN_EPI) { if (wr == 0) PG8_BAR; }
    PG8_BAR;
    if constexpr (Epi::AFTER_DRAIN) { E.fused(acc, cur, wr, wc, fr, fq, lds, wid, lane); S.done(cur); }
#undef PG8_SA
#undef PG8_SB
#undef PG8_STAGE
#undef PG8_LDA
#undef PG8_LDB
#undef PG8_MMA
#undef PG8_WAIT_V
#undef PG8_WAIT_L
#undef PG8_BAR
#undef PG8_SCHED
}
}

typedef unsigned short bf16_t;
typedef short bf16x8 __attribute__((ext_vector_type(8)));
typedef short s16x4 __attribute__((ext_vector_type(4)));
typedef float f32x4 __attribute__((ext_vector_type(4)));
typedef float f32x16 __attribute__((ext_vector_type(16)));
typedef unsigned u32x4 __attribute__((ext_vector_type(4)));
typedef unsigned u32x2 __attribute__((ext_vector_type(2)));
#define DI __device__ __forceinline__
#define LAUNDER(x) asm volatile("" : "+v"(x))

constexpr int T_ = 32768, DM = 1024, FF = 2816, SEQ = 16384, NLAYER = 2;
constexpr int INC = 3336, INP = 3584, PLD = 3344;
constexpr int C_AQ = 0, C_AK = 256, C_AV = 512, C_BQ = 768, C_BK = 1024, C_BV = 1280, C_BO = 1536, C_CQ = 1792, C_CK = 2048, C_CV = 2304, C_DQ = 2560, C_DK = 2816, C_DV = 3072, C_GI = 3328, C_GF = 3332;
constexpr float LOG2E = 1.4426950408889634f, EPS_ = 1e-6f;
#ifndef D_EARLY
#define D_EARLY 1
#endif

constexpr size_t SZ_WGU = (size_t)2 * FF * DM * 2, SZ_WD = (size_t)DM * FF * 2, SZ_WIN = (size_t)INP * DM * 2, SZ_WOUT = (size_t)DM * DM * 2;
constexpr size_t LW_WGU1 = 0, LW_WD1 = LW_WGU1 + SZ_WGU, LW_WIN = LW_WD1 + SZ_WD, LW_WOUT = LW_WIN + SZ_WIN, LW_WGU2 = LW_WOUT + SZ_WOUT, LW_WD2 = LW_WGU2 + SZ_WGU, LW_SIZE = LW_WD2 + SZ_WD;
constexpr size_t WS_CTL = 0, WS_W = 8192, WS_XN = WS_W + NLAYER * LW_SIZE, WS_HP = WS_XN + (size_t)T_ * DM * 2, WS_BQ = WS_HP + (size_t)T_ * PLD * 2,
                 WS_BK = WS_BQ + (size_t)T_ * 256 * 2, WS_BKT = WS_BK + (size_t)T_ * 256 * 2, WS_VT = WS_BKT + (size_t)T_ * 256 * 2, WS_DC = WS_VT + (size_t)4 * T_ * 256 * 2,
                 WS_SC = WS_DC + (size_t)8 * 256 * 4160 * 4, WS_SS = WS_SC + 3 * 8 * 256 * 4, WS_END = WS_SS + (size_t)7 * T_ * 4;
static_assert(WS_XN % 256 == 0 && WS_HP % 256 == 0 && WS_BQ % 256 == 0 && WS_DC % 256 == 0 && (size_t)T_ * FF * 2 <= (size_t)T_ * PLD * 2, "ws map");
constexpr int LDS_BYTES = pg8::STAGE_BYTES + 1024;

DI unsigned pk2(float a, float b) { return pg8::cvt_pk_bf16(a, b); }
DI float bf2f(bf16_t h) { return __uint_as_float((unsigned)h << 16); }
DI float bflo(unsigned w) { return __uint_as_float(w << 16); }
DI float bfhi(unsigned w) { return __uint_as_float(w & 0xffff0000u); }
DI float ex2(float x) { return __builtin_amdgcn_exp2f(x); }
DI float lg2(float x) { return __builtin_amdgcn_logf(x); }
DI float rcpf_(float x) { return __builtin_amdgcn_rcpf(x); }
DI int crow(int r, int hi) { return (r & 3) + 8 * (r >> 2) + 4 * hi; }
#define MFMA32(a, b, c) __builtin_amdgcn_mfma_f32_32x32x16_bf16((a), (b), (c), 0, 0, 0)
DI f32x16 splat16(float v) { f32x16 r;
#pragma unroll
  for (int i = 0; i < 16; ++i) r[i] = v; return r; }
DI bf16x8 pack8(const f32x16& s, int kk) {
  u32x4 p; p.x = pk2(s[8 * kk], s[8 * kk + 1]); p.y = pk2(s[8 * kk + 2], s[8 * kk + 3]); p.z = pk2(s[8 * kk + 4], s[8 * kk + 5]); p.w = pk2(s[8 * kk + 6], s[8 * kk + 7]);
  return __builtin_bit_cast(bf16x8, p); }
DI bf16x8 cat4(s16x4 lo, s16x4 hi) { return __builtin_shufflevector(lo, hi, 0, 1, 2, 3, 4, 5, 6, 7); }

struct Args { const float* in[23]; float* out; unsigned char* ws; };

struct TDesc { const float* W0; const float* W1; const float* gk; bf16_t* WT; int kind, K, N, kt, nt; };
DI TDesc tt_decode(const Args& a, int it) {
  constexpr int I_GU = 16 * 88, I_D = 44 * 16, I_IN = 16 * 56, I_OUT = 16 * 16, I_L = 2 * I_GU + 2 * I_D + I_IN + I_OUT;
  const int l = it / I_L; int r = it % I_L; unsigned char* wl = a.ws + WS_W + (size_t)l * LW_SIZE; TDesc d;
  if (r < I_GU) { d.W0 = a.in[2] + (size_t)l * DM * FF; d.W1 = a.in[3] + (size_t)l * DM * FF; d.gk = a.in[1] + l * DM; d.WT = (bf16_t*)(wl + LW_WGU1); d.kind = 0; d.K = DM; d.N = FF; d.kt = r / 88; d.nt = r % 88; return d; } r -= I_GU;
  if (r < I_D) { d.W0 = a.in[4] + (size_t)l * FF * DM; d.W1 = nullptr; d.gk = nullptr; d.WT = (bf16_t*)(wl + LW_WD1); d.kind = 1; d.K = FF; d.N = DM; d.kt = r / 16; d.nt = r % 16; return d; } r -= I_D;
  if (r < I_IN) { d.W0 = a.in[6] + (size_t)l * DM * INC; d.W1 = nullptr; d.gk = a.in[5] + l * DM; d.WT = (bf16_t*)(wl + LW_WIN); d.kind = 2; d.K = DM; d.N = INC; d.kt = r / 56; d.nt = r % 56; return d; } r -= I_IN;
  if (r < I_OUT) { d.W0 = a.in[18] + (size_t)l * DM * DM; d.W1 = nullptr; d.gk = nullptr; d.WT = (bf16_t*)(wl + LW_WOUT); d.kind = 1; d.K = DM; d.N = DM; d.kt = r / 16; d.nt = r % 16; return d; } r -= I_OUT;
  if (r < I_GU) { d.W0 = a.in[20] + (size_t)l * DM * FF; d.W1 = a.in[21] + (size_t)l * DM * FF; d.gk = a.in[19] + l * DM; d.WT = (bf16_t*)(wl + LW_WGU2); d.kind = 0; d.K = DM; d.N = FF; d.kt = r / 88; d.nt = r % 88; return d; } r -= I_GU;
  d.W0 = a.in[22] + (size_t)l * FF * DM; d.W1 = nullptr; d.gk = nullptr; d.WT = (bf16_t*)(wl + LW_WD2); d.kind = 1; d.K = FF; d.N = DM; d.kt = r / 16; d.nt = r % 16; return d;
}
DI void tt_load(const TDesc& d, f32x4 (&v)[2], int tid) {
  const int n4 = tid & 15, np = d.nt * 64 + 4 * n4, k0 = d.kt * 64; const float* src = d.W0; int col;
  if (d.kind == 0) { const int pn = np >> 8, r = np & 255; src = (r < 128) ? d.W0 : d.W1; col = 128 * pn + (r & 127); }
  else if (d.kind == 1) col = np;
  else col = (np < 1792) ? np : (np < 3328) ? np + 8 : (np < 3336) ? 1792 + (np - 3328) : -1;
#pragma unroll
  for (int p = 0; p < 2; ++p) { const int kk = (tid >> 4) + 32 * p;
    v[p] = (col >= 0) ? *(const f32x4*)(src + (size_t)(k0 + kk) * d.N + col) * (d.gk ? d.gk[k0 + kk] : 1.f) : (f32x4){0.f, 0.f, 0.f, 0.f}; }
}
DI void prologue_weights(const Args& a, unsigned char* lds, int tid) {
  LAUNDER(tid);
  constexpr int NI = 6, NITEMS = NLAYER * (2 * 16 * 88 + 2 * 44 * 16 + 16 * 56 + 16 * 16);
  for (int it0 = blockIdx.x; it0 < NITEMS; it0 += NI * gridDim.x) {
    f32x4 v[NI][2]; TDesc d[NI];
#pragma unroll
    for (int q = 0; q < NI; ++q) { const int it = it0 + q * gridDim.x; if (it < NITEMS) { d[q] = tt_decode(a, it); tt_load(d[q], v[q], tid); } }
#pragma unroll
    for (int q = 0; q < NI; ++q) { float* scr = (float*)lds + q * (64 * 65);
#pragma unroll
      for (int p = 0; p < 2; ++p) { float* w = scr + ((tid >> 4) + 32 * p) * 65 + 4 * (tid & 15); w[0] = v[q][p].x; w[1] = v[q][p].y; w[2] = v[q][p].z; w[3] = v[q][p].w; } }
    __syncthreads();
#pragma unroll
    for (int q = 0; q < NI; ++q) { const int it = it0 + q * gridDim.x; if (it < NITEMS) {
      const int n = tid >> 3, kc = tid & 7; const float* sp = (const float*)lds + q * (64 * 65) + (8 * kc) * 65 + n;
      u32x4 o; o.x = pk2(sp[0], sp[65]); o.y = pk2(sp[2 * 65], sp[3 * 65]); o.z = pk2(sp[4 * 65], sp[5 * 65]); o.w = pk2(sp[6 * 65], sp[7 * 65]);
      *(u32x4*)(d[q].WT + (size_t)(d[q].nt * 64 + n) * d[q].K + d[q].kt * 64 + 8 * kc) = o; } }
    __syncthreads();
  }
}

DI float wave_sum(float v) {
#pragma unroll
  for (int o = 1; o < 64; o <<= 1) v += __shfl_xor(v, o);
  return v; }
DI float wave_max(float v) {
#pragma unroll
  for (int o = 1; o < 64; o <<= 1) v = fmaxf(v, __shfl_xor(v, o));
  return v; }
DI void cast_phase(const float* x, bf16_t* xb, float* ss, int tid) {
  LAUNDER(tid);
  const int lane = tid & 63, gw = blockIdx.x * 8 + (tid >> 6), ngw = gridDim.x * 8;
  for (int i = blockIdx.x * 512 + tid; i < 6 * T_; i += gridDim.x * 512) ss[T_ + i] = 0.f;
  for (int m0 = gw; m0 < T_; m0 += 2 * ngw) {
    f32x4 v[2][4];
#pragma unroll
    for (int r = 0; r < 2; ++r) { const int m = m0 + r * ngw; if (m < T_) { const f32x4* xr = (const f32x4*)(x + (size_t)m * DM) + lane;
#pragma unroll
      for (int j = 0; j < 4; ++j) v[r][j] = xr[64 * j]; } }
#pragma unroll
    for (int r = 0; r < 2; ++r) { const int m = m0 + r * ngw; if (m < T_) { float q = 0.f;
#pragma unroll
      for (int j = 0; j < 4; ++j) q += (v[r][j].x * v[r][j].x + v[r][j].y * v[r][j].y) + (v[r][j].z * v[r][j].z + v[r][j].w * v[r][j].w);
      q = wave_sum(q); if (lane == 0) ss[m] = q;
      u32x2* o = (u32x2*)(xb + (size_t)m * DM) + lane;
#pragma unroll
      for (int j = 0; j < 4; ++j) { u32x2 w; w.x = pk2(v[r][j].x, v[r][j].y); w.y = pk2(v[r][j].z, v[r][j].w); o[64 * j] = w; } } }
  }
}

struct PrepParams { const float *aqg, *akg, *cqg, *ckg, *convw, *convb; };
DI void prep_phase(bf16_t* P, bf16_t* BQ, bf16_t* BK, bf16_t* BKt, bf16_t* Vt, const PrepParams& pp, unsigned char* lds, int tid) {
  LAUNDER(tid);
  float* gt = (float*)lds;
  if (tid < 64) { gt[tid] = pp.aqg[tid]; gt[64 + tid] = pp.akg[tid]; gt[128 + tid] = pp.cqg[tid & 31]; gt[192 + tid] = pp.ckg[tid & 31]; gt[256 + tid] = 1.f; }
  __syncthreads();
  for (int tile = blockIdx.x; tile < T_ / 64; tile += gridDim.x) {
    const int tok0 = tile * 64, b = tok0 / SEQ, s0 = tok0 % SEQ;
    for (int id0 = tid; id0 < 64 * 160; id0 += 10 * 512) {
      u32x4 w4[10]; bf16_t* p4[10];
#pragma unroll
      for (int u = 0; u < 10; ++u) { const int id = id0 + 512 * u, tk = id / 160, ci = id % 160, seg = ci >> 5, within = (ci & 31) * 8;
        const int colb = (seg == 0) ? C_AQ : (seg == 1) ? C_AK : (seg == 2) ? C_CQ : (seg == 3) ? C_CK : C_DQ;
        p4[u] = P + (size_t)(tok0 + tk) * PLD + colb + within; w4[u] = *(const u32x4*)p4[u]; }
#pragma unroll
      for (int u = 0; u < 10; ++u) { const int id = id0 + 512 * u, ci = id % 160, seg = ci >> 5, within = (ci & 31) * 8;
        const u32x4 w = w4[u]; float v[8];
        v[0] = bflo(w.x); v[1] = bfhi(w.x); v[2] = bflo(w.y); v[3] = bfhi(w.y); v[4] = bflo(w.z); v[5] = bfhi(w.z); v[6] = bflo(w.w); v[7] = bfhi(w.w);
        float ss = 0.f;
#pragma unroll
        for (int j = 0; j < 8; ++j) ss += v[j] * v[j];
        ss += __shfl_xor(ss, 1); ss += __shfl_xor(ss, 2);
        const float ss32 = ss; ss += __shfl_xor(ss, 4);
        float sc;
        if (seg < 2) { sc = rsqrtf(ss * (1.f / 64.f) + EPS_) * (seg == 0 ? 0.125f * LOG2E : 1.f); }
        else if (seg < 4) { sc = rsqrtf(ss32 * (1.f / 32.f) + EPS_) * (seg == 2 ? 0.17677669529663687f * LOG2E : 1.f); }
        else { sc = 0.125f * LOG2E; }
        const float* gp = gt + seg * 64 + (within & 63);
        const f32x4 ga = *(const f32x4*)gp, gb = *(const f32x4*)(gp + 4);
        u32x4 o; o.x = pk2(v[0] * sc * ga.x, v[1] * sc * ga.y); o.y = pk2(v[2] * sc * ga.z, v[3] * sc * ga.w); o.z = pk2(v[4] * sc * gb.x, v[5] * sc * gb.y); o.w = pk2(v[6] * sc * gb.z, v[7] * sc * gb.w);
        *(u32x4*)p4[u] = o; }
    }
    bf16_t* Lin = (bf16_t*)(lds + 2048); bf16_t* Lout = Lin + 67 * 264;
    u32x4 r[5];
#define PREP_LOAD_GROUP(G) do { const int col0_ = ((G) == 0) ? C_AV : ((G) == 1) ? C_BV : ((G) == 2) ? C_CV : ((G) == 3) ? C_DV : ((G) == 4) ? C_BQ : C_BK; \
      _Pragma("unroll") for (int u = 0; u < 5; ++u) { const int idx = tid + 512 * u, row = idx >> 5, pc = idx & 31, srow = s0 - 3 + row; \
        r[u] = (u32x4){0u, 0u, 0u, 0u}; \
        if (idx < 67 * 32 && srow >= 0) r[u] = *(const u32x4*)(P + (size_t)(b * SEQ + srow) * PLD + col0_ + 8 * pc); } } while (0)
    PREP_LOAD_GROUP(0);
#pragma unroll
    for (int g = 0; g < 6; ++g) {
      __syncthreads();
#pragma unroll
      for (int u = 0; u < 5; ++u) { const int idx = tid + 512 * u, row = idx >> 5, pc = idx & 31; if (idx < 67 * 32) *(u32x4*)(Lin + row * 264 + 8 * pc) = r[u]; }
      __syncthreads();
      if (g + 1 < 6) PREP_LOAD_GROUP(g + 1);
      const int c = tid & 255, th = tid >> 8; const bf16_t* colp = Lin + (32 * th) * 264 + c;
      if (g < 4) {
        unsigned w[16];
#pragma unroll
        for (int q = 0; q < 16; ++q) { const int p = 2 * q, i = (p & ~12) | ((p & 4) << 1) | ((p & 8) >> 1);
          w[q] = (unsigned)colp[(3 + i) * 264] | ((unsigned)colp[(3 + i + 1) * 264] << 16); }
        bf16_t* vd = Vt + (size_t)g * T_ * 256 + (((size_t)(b * 4 + (c >> 6)) * 256 + (s0 >> 6)) * 64 + (c & 63)) * 64 + 32 * th;
#pragma unroll
        for (int q4 = 0; q4 < 4; ++q4) { u32x4 o; o.x = w[4 * q4]; o.y = w[4 * q4 + 1]; o.z = w[4 * q4 + 2]; o.w = w[4 * q4 + 3]; *(u32x4*)(vd + 8 * q4) = o; }
      } else {
        const int cq = (g - 4) * 256 + c;
        const float w0 = pp.convw[cq], w1 = pp.convw[512 + cq], w2 = pp.convw[1024 + cq], w3 = pp.convw[1536 + cq], bb = pp.convb[cq], sc = (g == 4) ? 1.f : 0.125f;
        float x[35];
#pragma unroll
        for (int i = 0; i < 35; ++i) x[i] = bf2f(colp[i * 264]);
        unsigned short yb[32];
#pragma unroll
        for (int i = 0; i < 32; ++i) { const float y = bb + x[i] * w0 + x[i + 1] * w1 + x[i + 2] * w2 + x[i + 3] * w3; yb[i] = (unsigned short)(pk2(pg8::silu_f(y) * sc, 0.f) & 0xffffu); Lout[(32 * th + i) * 264 + c] = yb[i]; }
        if (g == 5) {
          bf16_t* kd = BKt + (((size_t)(b * 4 + (c >> 6)) * 256 + (s0 >> 6)) * 64 + (c & 63)) * 64 + 32 * th;
#pragma unroll
          for (int q4 = 0; q4 < 4; ++q4) { unsigned w[4];
#pragma unroll
            for (int q = 0; q < 4; ++q) { const int p = 2 * (4 * q4 + q), i = (p & ~12) | ((p & 4) << 1) | ((p & 8) >> 1); w[q] = (unsigned)yb[i] | ((unsigned)yb[i + 1] << 16); }
            u32x4 o; o.x = w[0]; o.y = w[1]; o.z = w[2]; o.w = w[3]; *(u32x4*)(kd + 8 * q4) = o; }
        }
        __syncthreads();
        bf16_t* dst = (g == 4) ? BQ : BK;
#pragma unroll
        for (int u = 0; u < 4; ++u) { const int idx = tid + 512 * u, row = idx >> 5, pc = idx & 31; *(u32x4*)(dst + (size_t)(tok0 + row) * 256 + 8 * pc) = *(const u32x4*)(Lout + row * 264 + 8 * pc); }
      }
    }
    __syncthreads();
  }
}

#undef PREP_LOAD_GROUP
DI float wave_scan_add(float v, int lane) {
#pragma unroll
  for (int o = 1; o < 64; o <<= 1) { const float t = __shfl_up(v, o); if (lane >= o) v += t; }
  return v; }
DI float wave_scan_max(float v, int lane) {
#pragma unroll
  for (int o = 1; o < 64; o <<= 1) { const float t = __shfl_up(v, o); if (lane >= o) v = fmaxf(v, t); }
  return v; }
DI float fexp(float x) { return ex2(x * LOG2E); }
DI float log_sigmoid_f(float x) { return fminf(x, 0.f) - lg2(1.0f + fexp(-fabsf(x))) * 0.6931471805599453f; }
DI void lds_wave_sync() { asm volatile("s_waitcnt lgkmcnt(0)" ::: "memory"); __builtin_amdgcn_wave_barrier(); }

DI void b1_phase(const bf16_t* P, const bf16_t* BKt, const bf16_t* VtB, float* DC, float* SC, const float* gate_bias, unsigned char* lds, int tid) {
  LAUNDER(tid);
  const int lane = tid & 63, wave = tid >> 6, r32 = lane & 31, hi = lane >> 5;
  float* wsc = (float*)(lds + wave * 1024);
  for (int item = blockIdx.x * 8 + wave; item < 2048; item += gridDim.x * 8) {
    const int bh = item >> 8, c = item & 255, b = bh >> 2, h = bh & 3, s0 = c * 64; const size_t tok0 = (size_t)b * SEQ + s0;
    const float gf = bf2f(P[(tok0 + lane) * PLD + C_GF + h]) + gate_bias[4 + h], gi = bf2f(P[(tok0 + lane) * PLD + C_GI + h]) + gate_bias[h];
    const float lf = log_sigmoid_f(gf), bcum = wave_scan_add(lf, lane), btot = __shfl(bcum, 63);
    const float g = btot - bcum + gi, mloc = wave_max(g), w = fexp(g - mloc);
    wsc[lane] = w; lds_wave_sync();
    f32x16 acc[2][2];
#pragma unroll
    for (int i = 0; i < 2; ++i)
#pragma unroll
      for (int j = 0; j < 2; ++j) acc[i][j] = splat16(0.f);
    float dn[2] = {0.f, 0.f};
#pragma unroll
    for (int ks = 0; ks < 4; ++ks) {
      const f32x4 wa = *(const f32x4*)(wsc + 16 * ks + 4 * hi), wb = *(const f32x4*)(wsc + 16 * ks + 8 + 4 * hi);
      bf16x8 vf[2], kf[2];
#pragma unroll
      for (int eb = 0; eb < 2; ++eb) {
        vf[eb] = *(const bf16x8*)(VtB + (((size_t)bh * 256 + c) * 64 + 32 * eb + r32) * 64 + 16 * ks + 8 * hi);
        const u32x4 kw = *(const u32x4*)(BKt + (((size_t)bh * 256 + c) * 64 + 32 * eb + r32) * 64 + 16 * ks + 8 * hi);
        const float k0 = bflo(kw.x) * wa.x, k1 = bfhi(kw.x) * wa.y, k2 = bflo(kw.y) * wa.z, k3 = bfhi(kw.y) * wa.w, k4 = bflo(kw.z) * wb.x, k5 = bfhi(kw.z) * wb.y, k6 = bflo(kw.w) * wb.z, k7 = bfhi(kw.w) * wb.w;
        dn[eb] += ((k0 + k1) + (k2 + k3)) + ((k4 + k5) + (k6 + k7));
        u32x4 o; o.x = pk2(k0, k1); o.y = pk2(k2, k3); o.z = pk2(k4, k5); o.w = pk2(k6, k7); kf[eb] = __builtin_bit_cast(bf16x8, o);
      }
#pragma unroll
      for (int eb = 0; eb < 2; ++eb)
#pragma unroll
        for (int db = 0; db < 2; ++db) acc[eb][db] = MFMA32(vf[eb], kf[db], acc[eb][db]);
    }
    float* dc = DC + ((size_t)bh * 256 + c) * 4160;
#pragma unroll
    for (int eb = 0; eb < 2; ++eb)
#pragma unroll
      for (int db = 0; db < 2; ++db)
#pragma unroll
        for (int i = 0; i < 16; ++i) dc[(32 * eb + crow(i, hi)) * 64 + 32 * db + r32] = acc[eb][db][i];
#pragma unroll
    for (int db = 0; db < 2; ++db) { const float t = dn[db] + __shfl_xor(dn[db], 32); if (hi == 0) dc[4096 + 32 * db + r32] = t; }
    if (lane == 0) { SC[bh * 256 + c] = btot; SC[2048 + bh * 256 + c] = mloc; }
    lds_wave_sync();
  }
}

DI void b2_item(float* DC, float* SC, int j, unsigned char* lds, int tid) {
  LAUNDER(tid);
  float* L = (float*)lds;
  const int ge = j * 512 + tid, bh0 = (j * 512) / 1040, bh1 = (j * 512 + 511) / 1040;
  { const int slot = tid >> 8, c = tid & 255, bh = slot ? bh1 : bh0;
    if (bh < 8) { L[slot * 1024 + c] = SC[bh * 256 + c]; L[slot * 1024 + 256 + c] = SC[2048 + bh * 256 + c]; } }
  __syncthreads();
  if ((tid & 63) == 0 && (tid >> 6) < 2) { const int slot = tid >> 6, bh = slot ? bh1 : bh0;
    if (bh < 8 && (slot == 0 || bh1 != bh0)) { float* q = L + slot * 1024; float m = 0.f; const bool wr = (j * 512 <= bh * 1040) && (bh * 1040 < j * 512 + 512);
      for (int c = 0; c < 256; ++c) { const float b = q[c], l = q[256 + c], mn = fmaxf(b + m, l); q[512 + c] = fexp(b + m - mn); q[768 + c] = fexp(l - mn); if (wr) SC[4096 + bh * 256 + c] = m; m = mn; } } }
  __syncthreads();
  if (ge < 8 * 1040) {
    const int bh = ge / 1040, el = (ge % 1040) * 4; const float* q = L + ((bh == bh0) ? 0 : 1024);
    float* p = DC + (size_t)bh * 256 * 4160 + el; float z0 = 0.f; LAUNDER(z0); f32x4 C = {z0, z0, z0, z0};
    for (int c0 = 0; c0 < 256; c0 += 8) {
      f32x4 d[8];
#pragma unroll
      for (int u = 0; u < 8; ++u) d[u] = *(const f32x4*)(p + (size_t)(c0 + u) * 4160);
#pragma unroll
      for (int u = 0; u < 8; ++u) { *(f32x4*)(p + (size_t)(c0 + u) * 4160) = C; C = C * q[512 + c0 + u] + d[u] * q[768 + c0 + u]; }
    }
  }
}

DI void b3_phase(const bf16_t* P, const bf16_t* BQ, const bf16_t* BK, const bf16_t* VtB, const float* DC, const float* SC, const float* gate_bias, const float* onorm, bf16_t* Y, unsigned char* lds, int tid) {
  LAUNDER(tid);
  const int lane = tid & 63, wave = tid >> 6, r32 = lane & 31, hi = lane >> 5;
  float* R = (float*)(lds + wave * 2048); float* MU = R + 64; float* SI = R + 128; float* EM = R + 192; float* NV = R + 256;
  for (int item = blockIdx.x * 8 + wave; item < 2048; item += gridDim.x * 8) {
    const int bh = item >> 8, c = item & 255, b = bh >> 2, h = bh & 3, s0 = c * 64; const size_t tok0 = (size_t)b * SEQ + s0;
    const float* dc = DC + ((size_t)bh * 256 + c) * 4160;
    {
      const float gf = bf2f(P[(tok0 + lane) * PLD + C_GF + h]) + gate_bias[4 + h], gi = bf2f(P[(tok0 + lane) * PLD + C_GI + h]) + gate_bias[h];
      const float lf = log_sigmoid_f(gf), bcum = wave_scan_add(lf, lane), r = gi - bcum, pmax = wave_scan_max(r, lane);
      const float m_in = SC[4096 + bh * 256 + c], mu = fmaxf(m_in, pmax);
      R[lane] = r; MU[lane] = mu; SI[lane] = fexp(m_in - mu); EM[lane] = fexp(-bcum - mu); NV[lane] = dc[4096 + lane];
    }
    lds_wave_sync();
    bf16x8 cfr[2][4];
#pragma unroll
    for (int eb = 0; eb < 2; ++eb)
#pragma unroll
      for (int ks = 0; ks < 4; ++ks) { const float* cp = dc + (32 * eb + r32) * 64 + 16 * ks + 8 * hi; const f32x4 ca = *(const f32x4*)cp, cb = *(const f32x4*)(cp + 4);
        u32x4 o; o.x = pk2(ca.x, ca.y); o.y = pk2(ca.z, ca.w); o.z = pk2(cb.x, cb.y); o.w = pk2(cb.z, cb.w); cfr[eb][ks] = __builtin_bit_cast(bf16x8, o); }
#pragma unroll
    for (int tq = 0; tq < 2; ++tq) {
      const int t = 32 * tq + r32; const float mu_t = MU[t], si_t = SI[t], em_t = EM[t];
      bf16x8 qf[4]; float qn = 0.f;
#pragma unroll
      for (int ks = 0; ks < 4; ++ks) {
        const u32x4 qw = *(const u32x4*)(BQ + (tok0 + t) * 256 + h * 64 + 16 * ks + 8 * hi); qf[ks] = __builtin_bit_cast(bf16x8, qw);
        const f32x4 na = *(const f32x4*)(NV + 16 * ks + 8 * hi), nb = *(const f32x4*)(NV + 16 * ks + 8 * hi + 4);
        qn += bflo(qw.x) * na.x + bfhi(qw.x) * na.y + bflo(qw.y) * na.z + bfhi(qw.y) * na.w + bflo(qw.z) * nb.x + bfhi(qw.z) * nb.y + bflo(qw.w) * nb.z + bfhi(qw.w) * nb.w;
      }
      qn += __shfl_xor(qn, 32);
      f32x16 G[2], num[2];
#pragma unroll
      for (int eb = 0; eb < 2; ++eb) { G[eb] = splat16(0.f); num[eb] = splat16(0.f);
#pragma unroll
        for (int ks = 0; ks < 4; ++ks) G[eb] = MFMA32(cfr[eb][ks], qf[ks], G[eb]); }
      float dsum = 0.f;
#pragma unroll
      for (int tk = 0; tk < 2; ++tk) {
        if (tk <= tq) {
          f32x16 S = splat16(0.f);
#pragma unroll
          for (int ks = 0; ks < 4; ++ks) { const bf16x8 kf = *(const bf16x8*)(BK + (tok0 + 32 * tk + r32) * 256 + h * 64 + 16 * ks + 8 * hi); S = MFMA32(kf, qf[ks], S); }
          asm volatile("" ::: "memory");
#pragma unroll
          for (int g4 = 0; g4 < 4; ++g4) { const f32x4 rv = *(const f32x4*)(R + 32 * tk + 8 * g4 + 4 * hi);
#pragma unroll
            for (int j = 0; j < 4; ++j) { const int s = 32 * tk + 8 * g4 + 4 * hi + j; const float w = (s <= t) ? fexp(rv[j] - mu_t) : 0.f; const float val = S[4 * g4 + j] * w; dsum += val; S[4 * g4 + j] = val; } }
#pragma unroll
          for (int kk = 0; kk < 2; ++kk) { const bf16x8 pf = pack8(S, kk);
#pragma unroll
            for (int eb = 0; eb < 2; ++eb) { const bf16_t* vp = VtB + (((size_t)bh * 256 + c) * 64 + 32 * eb + r32) * 64 + 32 * tk + 16 * kk + 8 * hi;
              const bf16x8 vf = *(const bf16x8*)vp; num[eb] = MFMA32(vf, pf, num[eb]); } }
          asm volatile("" ::: "memory");
        }
      }
      dsum += __shfl_xor(dsum, 32);
      const float den = si_t * qn + dsum, inv = 1.0f / fmaxf(fabsf(den), em_t);
      float ss = 0.f;
#pragma unroll
      for (int eb = 0; eb < 2; ++eb)
#pragma unroll
        for (int i = 0; i < 16; ++i) { const float hv = (num[eb][i] + si_t * G[eb][i]) * inv; num[eb][i] = hv; ss += hv * hv; }
      ss += __shfl_xor(ss, 32);
      const float rstd = rsqrtf(ss * (1.f / 64.f) + EPS_);
      const bf16_t* bo = P + (tok0 + t) * PLD + C_BO + h * 64; bf16_t* yo = Y + (tok0 + t) * DM + 256 + h * 64;
#pragma unroll
      for (int eb = 0; eb < 2; ++eb)
#pragma unroll
        for (int g4 = 0; g4 < 4; ++g4) { const int e = 32 * eb + 8 * g4 + 4 * hi; const u32x2 bw = *(const u32x2*)(bo + e); const f32x4 gn = *(const f32x4*)(onorm + h * 64 + e);
          const float o0 = num[eb][4 * g4] * rstd * gn.x * rcpf_(1.f + fexp(-bflo(bw.x))), o1 = num[eb][4 * g4 + 1] * rstd * gn.y * rcpf_(1.f + fexp(-bfhi(bw.x)));
          const float o2 = num[eb][4 * g4 + 2] * rstd * gn.z * rcpf_(1.f + fexp(-bflo(bw.y))), o3 = num[eb][4 * g4 + 3] * rstd * gn.w * rcpf_(1.f + fexp(-bfhi(bw.y)));
          u32x2 ow; ow.x = pk2(o0, o1); ow.y = pk2(o2, o3); *(u32x2*)(yo + e) = ow; }
    }
    lds_wave_sync();
  }
}

struct AttnParams { const bf16_t* P; const bf16_t* Vt; bf16_t* Y; const float* biasL; float negM; float lam; float oscale; const float* cgain; };
constexpr int NCH = 1;
template <int MODE>
DI void attn_unit(unsigned char* lds, const AttnParams& ap, int b, int h, int qb, int tid) {
  LAUNDER(tid);
  const int wave = tid >> 6, lane = tid & 63, r32 = lane & 31, hi = lane >> 5, bh = b * 4 + h;
  constexpr int qcol0 = (MODE == 0) ? C_AQ : (MODE == 1) ? C_CQ : C_DQ, kcol0 = (MODE == 0) ? C_AK : (MODE == 1) ? C_CK : C_DK, ycol0 = (MODE == 0) ? 0 : (MODE == 1) ? 512 : 768;
  const bf16_t* Vt = ap.Vt + (size_t)((MODE == 0) ? 0 : (MODE == 1) ? 2 : 3) * T_ * 256;
  const size_t tokb = (size_t)b * SEQ;
  const int qpos = qb * 256 + wave * 32 + r32, cw = qb * 4 + (wave >> 1);
  bf16x8 qf[4];
  { const bf16_t* qp = ap.P + (tokb + qpos) * PLD + qcol0 + h * 64 + 8 * hi;
#pragma unroll
    for (int ks = 0; ks < 4; ++ks) qf[ks] = *(const bf16x8*)(qp + 16 * ks); }
  bf16_t* Ks0 = (bf16_t*)lds; bf16_t* Vs0 = Ks0 + NCH * 64 * 72; volatile int* flags = (volatile int*)(lds + 2 * NCH * 64 * 72 * 2);
  const int jhi = 4 * qb + 3, jlo = (MODE == 0) ? ((4 * qb - 8 > 0) ? 4 * qb - 8 : 0) : 0, ntiles = jhi - jlo + 1;
  const int lrow = tid >> 3, lch = tid & 7;
  const bf16_t* kg = ap.P + (tokb + lrow) * PLD + kcol0 + h * 64 + 8 * lch;
  const bf16_t* vg = Vt + (size_t)bh * 256 * 4096 + lrow * 64 + 8 * lch;
  const int j0 = (MODE == 2) ? jhi : jlo;
  u32x4 kreg[NCH], vreg[NCH];
#pragma unroll
  for (int c = 0; c < NCH; ++c) { const int jc = (MODE == 2) ? j0 - c : j0 + c; kreg[c] = *(const u32x4*)(kg + (size_t)jc * 64 * PLD); vreg[c] = *(const u32x4*)(vg + (size_t)jc * 4096); }
  f32x16 O0[2], O1[2]; float l0 = 0.f, l1 = 0.f, cum = 0.f;
#pragma unroll
  for (int eb = 0; eb < 2; ++eb) { O0[eb] = splat16(0.f); O1[eb] = splat16(0.f); }
  bool wdone = false;
  if (MODE == 2 && D_EARLY) { if (tid < 8) flags[tid] = 0; }
  for (int n = 0; n < ntiles; n += NCH) {
    const int jb = (MODE == 2) ? jhi - n : jlo + n;
    __syncthreads();
    if (MODE == 2 && D_EARLY) { int alld = 1;
#pragma unroll
      for (int w = 0; w < 8; ++w) alld &= flags[w];
      if (alld) break; }
#pragma unroll
    for (int c = 0; c < NCH; ++c) { *(u32x4*)(Ks0 + (c * 64 + lrow) * 72 + 8 * lch) = kreg[c]; *(u32x4*)(Vs0 + (c * 64 + lrow) * 72 + 8 * lch) = vreg[c]; }
    __syncthreads();
    if (n + NCH < ntiles) {
#pragma unroll
      for (int c = 0; c < NCH; ++c) { const int jn = (MODE == 2) ? jb - NCH - c : jb + NCH + c; kreg[c] = *(const u32x4*)(kg + (size_t)jn * 64 * PLD); vreg[c] = *(const u32x4*)(vg + (size_t)jn * 4096); } }
#pragma unroll
    for (int c = 0; c < NCH; ++c) {
    const int j = (MODE == 2) ? jb - c : jb + c;
    const bf16_t* Ks = Ks0 + c * 64 * 72; const bf16_t* Vs = Vs0 + c * 64 * 72;
    const bool active = (j <= cw) && (MODE != 0 || j >= cw - 8);
    if (!active) continue;
    if (MODE == 2 && D_EARLY && wdone) continue;
    if (MODE == 1) {
#pragma unroll
      for (int kh = 0; kh < 2; ++kh) {
        const bf16_t* kb = Ks + (32 * kh + r32) * 72 + 8 * hi;
        bf16x8 p0[2], p1[2];
        { f32x16 s0 = splat16(ap.negM);
          s0 = MFMA32(*(const bf16x8*)(kb), qf[0], s0); s0 = MFMA32(*(const bf16x8*)(kb + 16), qf[1], s0);
#pragma unroll
          for (int i = 0; i < 16; ++i) { s0[i] = ex2(s0[i]); l0 += s0[i]; }
          p0[0] = pack8(s0, 0); p0[1] = pack8(s0, 1); }
        { f32x16 s1 = splat16(ap.negM);
          s1 = MFMA32(*(const bf16x8*)(kb + 32), qf[2], s1); s1 = MFMA32(*(const bf16x8*)(kb + 48), qf[3], s1);
#pragma unroll
          for (int i = 0; i < 16; ++i) { s1[i] = ex2(s1[i]); l1 += s1[i]; }
          p1[0] = pack8(s1, 0); p1[1] = pack8(s1, 1); }
#pragma unroll
        for (int kk = 0; kk < 2; ++kk) {
#pragma unroll
          for (int eb = 0; eb < 2; ++eb) { const bf16_t* vb = Vs + (32 * eb + r32) * 72 + 32 * kh + 16 * kk + 8 * hi; const bf16x8 vf = *(const bf16x8*)vb;
            O0[eb] = MFMA32(vf, p0[kk], O0[eb]); O1[eb] = MFMA32(vf, p1[kk], O1[eb]); } }
      }
    } else if (MODE == 0) {
      const int dch = cw - j; const float binit = ap.negM + ((dch >= 3) ? ap.biasL[256] : 0.f);
#pragma unroll
      for (int kh = 0; kh < 2; ++kh) {
        const bf16_t* kb = Ks + (32 * kh + r32) * 72 + 8 * hi;
        f32x16 s0 = splat16(binit);
#pragma unroll
        for (int ks = 0; ks < 4; ++ks) s0 = MFMA32(*(const bf16x8*)(kb + 16 * ks), qf[ks], s0);
        if (dch < 3) {
#pragma unroll
          for (int i = 0; i < 16; ++i) { int rel = qpos - (64 * j + 32 * kh + crow(i, hi)); rel = rel > 128 ? 128 : (rel < -128 ? -128 : rel); s0[i] += ap.biasL[rel + 128]; } }
#pragma unroll
        for (int i = 0; i < 16; ++i) { s0[i] = ex2(s0[i]); l0 += s0[i]; }
#pragma unroll
        for (int kk = 0; kk < 2; ++kk) { const bf16x8 p0 = pack8(s0, kk);
#pragma unroll
          for (int eb = 0; eb < 2; ++eb) { const bf16_t* vb = Vs + (32 * eb + r32) * 72 + 32 * kh + 16 * kk + 8 * hi; const bf16x8 vf = *(const bf16x8*)vb;
            O0[eb] = MFMA32(vf, p0, O0[eb]); } }
      }
    } else {
      f32x16 z[2];
#pragma unroll
      for (int kh = 0; kh < 2; ++kh) { const bf16_t* kb = Ks + (32 * kh + r32) * 72 + 8 * hi; z[kh] = splat16(0.f);
#pragma unroll
        for (int ks = 0; ks < 4; ++ks) z[kh] = MFMA32(*(const bf16x8*)(kb + 16 * ks), qf[ks], z[kh]); }
      const bool diag = (j == cw); f32x16 sp[2]; float bs[8], ob[8];
#pragma unroll
      for (int kh = 0; kh < 2; ++kh)
#pragma unroll
        for (int g4 = 0; g4 < 4; ++g4) { float t = 0.f;
#pragma unroll
          for (int jj = 0; jj < 4; ++jj) { const int i = 4 * g4 + jj; const bool before = !diag || (64 * j + 32 * kh + crow(i, hi) < qpos);
            const float v = before ? lg2(1.0f + ex2(z[kh][i])) : 0.f; sp[kh][i] = v; t += v; }
          bs[4 * kh + g4] = t; }
#pragma unroll
      for (int p = 0; p < 8; ++p) ob[p] = __shfl_xor(bs[p], 32);
      float Rr = 0.f, saf[8];
#pragma unroll
      for (int p = 7; p >= 0; --p) { const float ev = hi ? ob[p] : bs[p], od = hi ? bs[p] : ob[p]; saf[p] = Rr + (hi ? 0.f : od); Rr += ev + od; }
#pragma unroll
      for (int kh = 0; kh < 2; ++kh)
#pragma unroll
        for (int g4 = 0; g4 < 4; ++g4) { float e = saf[4 * kh + g4];
#pragma unroll
          for (int jj = 3; jj >= 0; --jj) { const int i = 4 * g4 + jj; const bool before = !diag || (64 * j + 32 * kh + crow(i, hi) < qpos);
            const float a = before ? ex2(z[kh][i] - sp[kh][i] - e + cum) : 0.f; e += sp[kh][i]; z[kh][i] = a; } }
      cum -= Rr;
#pragma unroll
      for (int kh = 0; kh < 2; ++kh)
#pragma unroll
        for (int kk = 0; kk < 2; ++kk) { const bf16x8 p0 = pack8(z[kh], kk);
#pragma unroll
          for (int eb = 0; eb < 2; ++eb) { const bf16_t* vb = Vs + (32 * eb + r32) * 72 + 32 * kh + 16 * kk + 8 * hi; const bf16x8 vf = *(const bf16x8*)vb;
            O0[eb] = MFMA32(vf, p0, O0[eb]); } }
      if (D_EARLY) { const int done = __all(cum <= -151.0f); if (lane == 0) flags[wave] = done; wdone = (done != 0); }
    }
    }
  }
  bf16_t* yo = ap.Y + (tokb + qpos) * DM + ycol0 + h * 64;
  if (MODE == 0) { l0 += __shfl_xor(l0, 32); const float inv = 1.0f / l0;
#pragma unroll
    for (int eb = 0; eb < 2; ++eb)
#pragma unroll
      for (int i = 0; i < 16; ++i) O0[eb][i] *= inv;
  } else if (MODE == 1) { l0 += __shfl_xor(l0, 32); l1 += __shfl_xor(l1, 32); const float i0 = 1.0f / l0, i1 = ap.lam / l1; float ss = 0.f;
#pragma unroll
    for (int eb = 0; eb < 2; ++eb)
#pragma unroll
      for (int i = 0; i < 16; ++i) { const float o = O0[eb][i] * i0 - O1[eb][i] * i1; O0[eb][i] = o; ss += o * o; }
    ss += __shfl_xor(ss, 32); const float rstd = rsqrtf(ss * (1.f / 64.f) + EPS_) * ap.oscale;
#pragma unroll
    for (int eb = 0; eb < 2; ++eb)
#pragma unroll
      for (int i = 0; i < 16; ++i) O0[eb][i] *= rstd * ap.cgain[32 * eb + crow(i, hi)];
  }
#pragma unroll
  for (int eb = 0; eb < 2; ++eb)
#pragma unroll
    for (int g4 = 0; g4 < 4; ++g4) { u32x2 ow; ow.x = pk2(O0[eb][4 * g4], O0[eb][4 * g4 + 1]); ow.y = pk2(O0[eb][4 * g4 + 2], O0[eb][4 * g4 + 3]); *(u32x2*)(yo + 32 * eb + 8 * g4 + 4 * hi) = ow; }
}

struct MixParams { AttnParams ap; float* DC; float* SC; const float* relb; const float *aqg, *akg, *cqg, *ckg, *clam, *cog; float lam_init; unsigned* ctr; };
DI void mix_phase(unsigned char* lds, const MixParams& mp, int tid) {
  LAUNDER(tid);
  volatile int* misc = (volatile int*)(lds + pg8::STAGE_BYTES);
  float* biasT = (float*)(lds + 81920);
  float* red = (float*)(lds + 81920 + 4 * 260 * 4);
  for (int i = tid; i < 4 * 257; i += 512) biasT[(i / 257) * 260 + (i % 257)] = mp.relb[i] * LOG2E;
  if (tid < 64) {
    const int lane = tid;
    const float aq = wave_max(fabsf(mp.aqg[lane])), ak = wave_max(fabsf(mp.akg[lane]));
    const float cq = wave_max(fabsf(mp.cqg[lane & 31])), ck = wave_max(fabsf(mp.ckg[lane & 31]));
    const float d1 = wave_sum(lane < 32 ? mp.clam[lane] * mp.clam[32 + lane] : 0.f), d2 = wave_sum(lane < 32 ? mp.clam[64 + lane] * mp.clam[96 + lane] : 0.f);
    if (lane == 0) { red[0] = 8.0f * aq * ak * LOG2E * 1.02f; red[1] = 5.656854249f * cq * ck * LOG2E * 1.02f; red[2] = fexp(d1) - fexp(d2) + mp.lam_init; }
  }
  __syncthreads();
  if (tid < 256) { const int hh = tid >> 6, ln = tid & 63; float m = -1e30f;
#pragma unroll
    for (int i = 0; i < 5; ++i) { const int e = ln + 64 * i; if (e < 257) m = fmaxf(m, biasT[hh * 260 + e]); }
    m = wave_max(m); if (ln == 0) red[4 + hh] = m; }
  __syncthreads();
  const float MA = red[0], MC = red[1], lam = red[2];
  AttnParams ap = mp.ap;
  for (;;) {
    __syncthreads();
    if (tid == 0) misc[0] = (int)atomicAdd(mp.ctr, 1u);
    __syncthreads();
    const int it = misc[0];
    constexpr int NB2 = 17;
    if (it >= NB2 + 3 * 512) break;
    if (it < NB2) { b2_item(mp.DC, mp.SC, it, lds, tid); continue; }
    const int r = (it - NB2) & 511, kind = (it - NB2) >> 9, qb = 63 - (r >> 3), bh = r & 7, b = bh >> 2, h = bh & 3;
    if (kind == 0) { ap.negM = -MC; ap.lam = lam; ap.oscale = 1.0f - mp.lam_init; ap.cgain = mp.cog; attn_unit<1>(lds, ap, b, h, qb, tid); }
    else if (kind == 1) { attn_unit<2>(lds, ap, b, h, qb, tid); }
    else { ap.negM = -(MA + red[4 + h]); ap.biasL = biasT + h * 260; attn_unit<0>(lds, ap, b, h, qb, tid); }
  }
}

DI const float* ldp(const unsigned char* lds, int i) {
  const volatile __attribute__((address_space(3))) unsigned* t = (const volatile __attribute__((address_space(3))) unsigned*)(lds + pg8::STAGE_BYTES + 64);
  const unsigned lo = __builtin_amdgcn_readfirstlane(t[2 * i]), hi = __builtin_amdgcn_readfirstlane(t[2 * i + 1]);
  return (const float*)(const __attribute__((address_space(1))) float*)(((unsigned long long)hi << 32) | lo); }
DI int fresh_tid(int wave_s) { int lane; asm volatile("v_mbcnt_lo_u32_b32 %0, -1, 0\n\tv_mbcnt_hi_u32_b32 %0, -1, %0" : "=v"(lane)); return wave_s * 64 + lane; }

DI void gbar(unsigned* bw, unsigned& k, int tid) {
  ++k;
  asm volatile("s_waitcnt vmcnt(0)" ::: "memory");
  __syncthreads();
  if (tid == 0) {
    __builtin_amdgcn_fence(__ATOMIC_RELEASE, "agent");
    const unsigned G = gridDim.x, x = blockIdx.x & 7u, nloc = (G - x + 7u) >> 3, ngrp = G < 8u ? G : 8u;
    unsigned* xcnt = bw + 64 * x; unsigned* xgen = bw + 64 * (8 + x); unsigned* top = bw + 64 * 16; unsigned* topgen = bw + 64 * 17;
    const unsigned old = __hip_atomic_fetch_add(xcnt, 1u, __ATOMIC_RELAXED, __HIP_MEMORY_SCOPE_AGENT);
    if (old + 1u == k * nloc) {
      const unsigned o2 = __hip_atomic_fetch_add(top, 1u, __ATOMIC_RELAXED, __HIP_MEMORY_SCOPE_AGENT);
      if (o2 + 1u == k * ngrp) __hip_atomic_store(topgen, k, __ATOMIC_RELAXED, __HIP_MEMORY_SCOPE_AGENT);
      else while (__hip_atomic_load(topgen, __ATOMIC_RELAXED, __HIP_MEMORY_SCOPE_AGENT) < k) __builtin_amdgcn_s_sleep(1);
      __hip_atomic_store(xgen, k, __ATOMIC_RELAXED, __HIP_MEMORY_SCOPE_AGENT);
    } else {
      while (__hip_atomic_load(xgen, __ATOMIC_RELAXED, __HIP_MEMORY_SCOPE_AGENT) < k) __builtin_amdgcn_s_sleep(1);
    }
    __builtin_amdgcn_fence(__ATOMIC_ACQUIRE, "agent");
  }
  __syncthreads();
}
#define WSP(off) ((unsigned char*)ldp(lds, 24) + (off))
__global__ void __launch_bounds__(512) fwd_kernel(Args a) {
  extern __shared__ __attribute__((aligned(16))) unsigned char lds[];
  cg::grid_group grid = cg::this_grid();
  const int wave_s = __builtin_amdgcn_readfirstlane(threadIdx.x >> 6);
  if (threadIdx.x == 0) {
    const float** t = (const float**)(lds + pg8::STAGE_BYTES + 64);
#pragma unroll
    for (int i = 0; i < 23; ++i) t[i] = a.in[i];
    t[23] = a.out; t[24] = (const float*)a.ws;
  }
  if (blockIdx.x == 0) { unsigned* ctl = (unsigned*)(a.ws + WS_CTL); for (int i = threadIdx.x; i < 2048; i += 512) ctl[i] = 0u; }
  __syncthreads();
  unsigned bk = 0u;
  PG8_LAS unsigned char* ldsL = (PG8_LAS unsigned char*)lds;
  typedef pg8::StaticOrder SO;

  { Args a2;
#pragma unroll
    for (int i = 0; i < 23; ++i) a2.in[i] = ldp(lds, i);
    a2.out = nullptr; a2.ws = WSP(0);
    prologue_weights(a2, lds, fresh_tid(wave_s)); }
  cast_phase(ldp(lds, 0), (bf16_t*)WSP(WS_XN), (float*)WSP(WS_SS), fresh_tid(wave_s));
  grid.sync();
  for (int l = 0; l < NLAYER; ++l) {
    const size_t wlo = WS_W + (size_t)l * LW_SIZE;
    { const float* xin = (l == 0) ? ldp(lds, 0) : ldp(lds, 23); (void)xin;
      pg8::Gemm g{(bf16_t*)WSP(WS_XN), (const bf16_t*)WSP(wlo + LW_WGU1), T_, 2 * FF, DM}; SO S; S.init(T_, 2 * FF, gridDim.x, blockIdx.x); pg8::EpiSwiGLU E{(bf16_t*)WSP(WS_HP), FF, (const float*)WSP(WS_SS) + (size_t)(3 * l) * T_};
      pg8::gemm_phase<pg8::EpiSwiGLU, SO, true, true>(ldsL, g, S, E, fresh_tid(wave_s)); }
    gbar((unsigned*)WSP(WS_CTL) + 64, bk, fresh_tid(wave_s));
    { const float* xin = (l == 0) ? ldp(lds, 0) : ldp(lds, 23);
      pg8::Gemm g{(bf16_t*)WSP(WS_HP), (const bf16_t*)WSP(wlo + LW_WD1), T_, DM, FF}; SO S; S.init(T_, DM, gridDim.x, blockIdx.x); pg8::EpiResid E{xin, (float*)ldp(lds, 23), DM, 0.5f, (bf16_t*)WSP(WS_XN), (float*)WSP(WS_SS) + (size_t)(3 * l + 1) * T_};
      pg8::gemm_phase<pg8::EpiResid, SO, true, true>(ldsL, g, S, E, fresh_tid(wave_s)); }
    gbar((unsigned*)WSP(WS_CTL) + 64, bk, fresh_tid(wave_s));
    { pg8::Gemm g{(bf16_t*)WSP(WS_XN), (const bf16_t*)WSP(wlo + LW_WIN), T_, INP, DM}; SO S; S.init(T_, INP, gridDim.x, blockIdx.x); pg8::EpiBf16Lim E{(bf16_t*)WSP(WS_HP), PLD, PLD, (const float*)WSP(WS_SS) + (size_t)(3 * l + 1) * T_};
      pg8::gemm_phase<pg8::EpiBf16Lim, SO, true, true>(ldsL, g, S, E, fresh_tid(wave_s)); }
    gbar((unsigned*)WSP(WS_CTL) + 64, bk, fresh_tid(wave_s));
    { PrepParams pp{ldp(lds, 7) + l * 64, ldp(lds, 8) + l * 64, ldp(lds, 14) + l * 32, ldp(lds, 15) + l * 32, ldp(lds, 10) + l * 2048, ldp(lds, 11) + l * 512};
      prep_phase((bf16_t*)WSP(WS_HP), (bf16_t*)WSP(WS_BQ), (bf16_t*)WSP(WS_BK), (bf16_t*)WSP(WS_BKT), (bf16_t*)WSP(WS_VT), pp, lds, fresh_tid(wave_s)); }
    gbar((unsigned*)WSP(WS_CTL) + 64, bk, fresh_tid(wave_s));
    b1_phase((bf16_t*)WSP(WS_HP), (bf16_t*)WSP(WS_BKT), (bf16_t*)WSP(WS_VT) + (size_t)T_ * 256, (float*)WSP(WS_DC), (float*)WSP(WS_SC), ldp(lds, 12) + l * 8, lds, fresh_tid(wave_s));
    gbar((unsigned*)WSP(WS_CTL) + 64, bk, fresh_tid(wave_s));
    { const float lam_init = (l == 0) ? 0.2f : (0.8f - 0.6f * 0.7408182206817179f);
      MixParams mp; mp.ap.P = (bf16_t*)WSP(WS_HP); mp.ap.Vt = (bf16_t*)WSP(WS_VT); mp.ap.Y = (bf16_t*)WSP(WS_XN); mp.ap.biasL = nullptr; mp.ap.negM = 0.f; mp.ap.lam = 0.f; mp.ap.oscale = 1.f; mp.ap.cgain = nullptr;
      mp.DC = (float*)WSP(WS_DC); mp.SC = (float*)WSP(WS_SC); mp.relb = ldp(lds, 9) + l * 4 * 257; mp.aqg = ldp(lds, 7) + l * 64; mp.akg = ldp(lds, 8) + l * 64; mp.cqg = ldp(lds, 14) + l * 32; mp.ckg = ldp(lds, 15) + l * 32;
      mp.clam = ldp(lds, 16) + l * 128; mp.cog = ldp(lds, 17) + l * 64; mp.lam_init = lam_init; mp.ctr = (unsigned*)WSP(WS_CTL) + l;
      mix_phase(lds, mp, fresh_tid(wave_s)); }
    gbar((unsigned*)WSP(WS_CTL) + 64, bk, fresh_tid(wave_s));
    b3_phase((bf16_t*)WSP(WS_HP), (bf16_t*)WSP(WS_BQ), (bf16_t*)WSP(WS_BK), (bf16_t*)WSP(WS_VT) + (size_t)T_ * 256, (float*)WSP(WS_DC), (float*)WSP(WS_SC), ldp(lds, 12) + l * 8, ldp(lds, 13) + l * 256, (bf16_t*)WSP(WS_XN), lds, fresh_tid(wave_s));
    gbar((unsigned*)WSP(WS_CTL) + 64, bk, fresh_tid(wave_s));
    { float* xo = (float*)ldp(lds, 23);
      pg8::Gemm g{(bf16_t*)WSP(WS_XN), (const bf16_t*)WSP(wlo + LW_WOUT), T_, DM, DM}; SO S; S.init(T_, DM, gridDim.x, blockIdx.x); pg8::EpiResid E{xo, xo, DM, 1.0f, (bf16_t*)WSP(WS_BQ), (float*)WSP(WS_SS) + (size_t)(3 * l + 2) * T_};
      pg8::gemm_phase<pg8::EpiResid, SO, true, true>(ldsL, g, S, E, fresh_tid(wave_s)); }
    gbar((unsigned*)WSP(WS_CTL) + 64, bk, fresh_tid(wave_s));
    { pg8::Gemm g{(bf16_t*)WSP(WS_BQ), (const bf16_t*)WSP(wlo + LW_WGU2), T_, 2 * FF, DM}; SO S; S.init(T_, 2 * FF, gridDim.x, blockIdx.x); pg8::EpiSwiGLU E{(bf16_t*)WSP(WS_HP), FF, (const float*)WSP(WS_SS) + (size_t)(3 * l + 2) * T_};
      pg8::gemm_phase<pg8::EpiSwiGLU, SO, true, true>(ldsL, g, S, E, fresh_tid(wave_s)); }
    gbar((unsigned*)WSP(WS_CTL) + 64, bk, fresh_tid(wave_s));
    { float* xo = (float*)ldp(lds, 23);
      pg8::Gemm g{(bf16_t*)WSP(WS_HP), (const bf16_t*)WSP(wlo + LW_WD2), T_, DM, FF}; SO S; S.init(T_, DM, gridDim.x, blockIdx.x); pg8::EpiResid E{xo, xo, DM, 0.5f, (l + 1 < NLAYER) ? (bf16_t*)WSP(WS_XN) : nullptr, (float*)WSP(WS_SS) + (size_t)(3 * l + 3) * T_};
      pg8::gemm_phase<pg8::EpiResid, SO, true, true>(ldsL, g, S, E, fresh_tid(wave_s)); }
    if (l + 1 < NLAYER) gbar((unsigned*)WSP(WS_CTL) + 64, bk, fresh_tid(wave_s));
  }
}

extern "C" void kernel_launch(void* const* d_in, const int* in_sizes, int n_in, void* d_out, int out_size, void* d_ws, size_t ws_size, hipStream_t stream) {
  static int grid = 0;
  if (grid == 0) {
    if (n_in != 23 || out_size != T_ * DM || ws_size < WS_END) { fprintf(stderr, "kernel_launch: unexpected problem (n_in %d out %d ws %zu need %zu)\n", n_in, out_size, ws_size, (size_t)WS_END); grid = -1; return; }
    int dev = 0, cus = 0, per_cu = 0;
    hipGetDevice(&dev); hipDeviceGetAttribute(&cus, hipDeviceAttributeMultiprocessorCount, dev);
    if (hipFuncSetAttribute((const void*)fwd_kernel, hipFuncAttributeMaxDynamicSharedMemorySize, LDS_BYTES) != hipSuccess) fprintf(stderr, "kernel_launch: hipFuncSetAttribute failed\n");
    if (hipOccupancyMaxActiveBlocksPerMultiprocessor(&per_cu, (const void*)fwd_kernel, 512, LDS_BYTES) != hipSuccess || per_cu < 1) { fprintf(stderr, "kernel_launch: occupancy query gave %d\n", per_cu); per_cu = 1; }
    (void)hipGetLastError();
    grid = cus * per_cu;
  }
  if (grid < 0) return;
  Args a{};
  for (int i = 0; i < 23; ++i) a.in[i] = (const float*)d_in[i];
  a.out = (float*)d_out; a.ws = (unsigned char*)d_ws;
  void* args[] = {&a};
  hipError_t e = hipLaunchCooperativeKernel((const void*)fwd_kernel, dim3(grid), dim3(512), args, LDS_BYTES, stream);
  if (e != hipSuccess) fprintf(stderr, "cooperative launch failed: %s (grid %d)\n", hipGetErrorString(e), grid);
}
```

```cpp
#include <hip/hip_runtime.h>
#include <hip/hip_cooperative_groups.h>
#include <cstdio>
#include <cstdint>
namespace cg = cooperative_groups;

namespace pg8 {
#define PG8_LAS __attribute__((address_space(3)))
typedef unsigned short bf16_t;
typedef short bf16x8 __attribute__((ext_vector_type(8)));
typedef float f32x4 __attribute__((ext_vector_type(4)));
typedef unsigned u32x4 __attribute__((ext_vector_type(4)));
constexpr int BM = 256, BK = 64, HALF = 128, HTB = HALF * BK * 2  , STAGE_BYTES = 8 * HTB, NXCD = 8, WGM = 4;

__host__ __device__ __forceinline__ int lds_byte(int r, int c) { const int st = (r >> 4) * 2 + (c >> 5), rr = r & 15, cc = c & 31, ob = rr * 64 + cc * 2; return st * 1024 + (ob ^ (((ob >> 9) & 1) << 5)); }
__host__ __device__ __forceinline__ void stage_rc(int b, int& R, int& C) { const int st = b / 1024, sb = b % 1024, swz = sb ^ (((sb >> 9) & 1) << 5); R = (st >> 1) * 16 + swz / 64; C = (st & 1) * 32 + (swz % 64) / 2; }
__host__ __device__ __forceinline__ int perm32(int rho) { const int n = rho >> 4, i = rho & 15; return 8 * (i >> 2) + 4 * n + (i & 3); }

struct Unit { int pm, pn; };
struct Gemm { const bf16_t* A; const bf16_t* Bt; int M, N, K; };

struct StaticOrder {
    int nM, nN, nwg, G, c;
    __host__ __device__ void init(int M, int N, int G_, int c_) { nM = M / BM; nN = N / BM; nwg = nM * nN; G = G_; c = c_; }
    __host__ __device__ bool next(int i, Unit& u) const {
        const long L = (long)i * G + c; if (L >= nwg) return false;
        int wgid = (int)L; { const int q = nwg / NXCD, r = nwg % NXCD, xcd = wgid % NXCD, off = wgid / NXCD; wgid = (xcd < r ? xcd * (q + 1) : r * (q + 1) + (xcd - r) * q) + off; }
        const int nig = WGM * nN, gid = wgid / nig, fm = gid * WGM, gsz = (nM - fm) < WGM ? (nM - fm) : WGM;
        u.pm = fm + ((wgid % nig) % gsz); u.pn = (wgid % nig) / gsz; return true;
    }
    __device__ __forceinline__ void a_ready(const Unit&) const {}
    __device__ __forceinline__ void done(const Unit&) const {}
};


typedef float f32x2_t __attribute__((ext_vector_type(2))); typedef __bf16 bf16x2_t __attribute__((ext_vector_type(2)));
__device__ __forceinline__ unsigned cvt_pk_bf16(float lo, float hi) { f32x2_t v = {lo, hi}; bf16x2_t b = __builtin_convertvector(v, bf16x2_t); return __builtin_bit_cast(unsigned, b); }
__device__ __forceinline__ float silu_f(float x) { return x * __builtin_amdgcn_rcpf(1.0f + __builtin_amdgcn_exp2f(-1.4426950408889634f * x)); }

struct EpiBf16Lim {
    static constexpr bool PERM = true, AFTER_DRAIN = false;
    bf16_t* O; int ldc; int ncols; const float* ss;
    __device__ __forceinline__ void operator()(const f32x4 (&acc)[2][2][4][2], const Unit& u, int wr, int wc, int fr, int fq) const {
        const int row0 = u.pm * BM + wr * 64 + fr; const int col0 = u.pn * BM + wc * 32 + 8 * fq;
        float rsv[2][4];
#pragma unroll
        for (int ai = 0; ai < 2; ++ai)
#pragma unroll
            for (int m = 0; m < 4; ++m) rsv[ai][m] = ss[row0 + ai * HALF + m * 16];
#pragma unroll
        for (int ai = 0; ai < 2; ++ai)
#pragma unroll
            for (int m = 0; m < 4; ++m) { bf16_t* rowp = O + (size_t)(row0 + ai * HALF + m * 16) * ldc + col0;
                const float rs = __builtin_amdgcn_rsqf(rsv[ai][m] * (1.0f / 1024.0f) + 1e-6f);
#pragma unroll
                for (int bj = 0; bj < 2; ++bj) { const f32x4 v0 = acc[ai][bj][m][0] * rs, v1 = acc[ai][bj][m][1] * rs;
                    u32x4 w; w.x = cvt_pk_bf16(v0[0], v0[1]); w.y = cvt_pk_bf16(v0[2], v0[3]); w.z = cvt_pk_bf16(v1[0], v1[1]); w.w = cvt_pk_bf16(v1[2], v1[3]);
                    if (col0 + bj * HALF < ncols) *(u32x4*)(rowp + bj * HALF) = w; } }
    }
};
struct EpiSwiGLU {
    static constexpr bool PERM = true, AFTER_DRAIN = false;
    bf16_t* O; int ldc; const float* ss;
    __device__ __forceinline__ void operator()(const f32x4 (&acc)[2][2][4][2], const Unit& u, int wr, int wc, int fr, int fq) const {
        const int row0 = u.pm * BM + wr * 64 + fr; const int col0 = u.pn * HALF + wc * 32 + 8 * fq;
        float rsv[2][4];
#pragma unroll
        for (int ai = 0; ai < 2; ++ai)
#pragma unroll
            for (int m = 0; m < 4; ++m) rsv[ai][m] = ss[row0 + ai * HALF + m * 16];
#pragma unroll
        for (int ai = 0; ai < 2; ++ai)
#pragma unroll
            for (int m = 0; m < 4; ++m) { bf16_t* rowp = O + (size_t)(row0 + ai * HALF + m * 16) * ldc + col0;
                const float rs = __builtin_amdgcn_rsqf(rsv[ai][m] * (1.0f / 1024.0f) + 1e-6f), c1 = rs * -1.4426950408889634f, c2 = rs * rs;
                const f32x4 g0 = acc[ai][0][m][0], g1 = acc[ai][0][m][1];
                f32x4 e0 = g0 * c1, e1 = g1 * c1;
                const f32x4 p0 = g0 * acc[ai][1][m][0], p1 = g1 * acc[ai][1][m][1];
#pragma unroll
                for (int i = 0; i < 4; ++i) { e0[i] = __builtin_amdgcn_exp2f(e0[i]); e1[i] = __builtin_amdgcn_exp2f(e1[i]); }
                e0 = e0 + 1.0f; e1 = e1 + 1.0f;
#pragma unroll
                for (int i = 0; i < 4; ++i) { e0[i] = __builtin_amdgcn_rcpf(e0[i]); e1[i] = __builtin_amdgcn_rcpf(e1[i]); }
                const f32x4 o0 = p0 * (e0 * c2), o1 = p1 * (e1 * c2);
                u32x4 w; w.x = cvt_pk_bf16(o0[0], o0[1]); w.y = cvt_pk_bf16(o0[2], o0[3]); w.z = cvt_pk_bf16(o1[0], o1[1]); w.w = cvt_pk_bf16(o1[2], o1[3]);
                *(u32x4*)rowp = w; }
    }
};
typedef unsigned u32x2v __attribute__((ext_vector_type(2)));
struct EpiResid {
    static constexpr bool PERM = true, AFTER_DRAIN = false;
    const float* base; float* out; int ldc; float alpha; bf16_t* xb; float* ss;
    __device__ __forceinline__ void operator()(const f32x4 (&acc)[2][2][4][2], const Unit& u, int wr, int wc, int fr, int fq) const {
        const int row0 = u.pm * BM + wr * 64 + fr; const int col0 = u.pn * BM + wc * 32 + 8 * fq;
#pragma unroll
        for (int ai = 0; ai < 2; ++ai) {
            f32x4 pre[4][2][2];
#pragma unroll
            for (int m = 0; m < 4; ++m) { const size_t off = (size_t)(row0 + ai * HALF + m * 16) * ldc + col0;
#pragma unroll
                for (int bj = 0; bj < 2; ++bj)
#pragma unroll
                    for (int n = 0; n < 2; ++n) pre[m][bj][n] = *(const f32x4*)(base + off + bj * HALF + n * 4); }
#pragma unroll
            for (int m = 0; m < 4; ++m) { const size_t off = (size_t)(row0 + ai * HALF + m * 16) * ldc + col0; float q = 0.f;
#pragma unroll
                for (int bj = 0; bj < 2; ++bj) { const f32x4 o0 = pre[m][bj][0] + acc[ai][bj][m][0] * alpha, o1 = pre[m][bj][1] + acc[ai][bj][m][1] * alpha;
                    *(f32x4*)(out + off + bj * HALF) = o0; *(f32x4*)(out + off + bj * HALF + 4) = o1;
                    if (xb) { q += ((o0[0] * o0[0] + o0[1] * o0[1]) + (o0[2] * o0[2] + o0[3] * o0[3])) + ((o1[0] * o1[0] + o1[1] * o1[1]) + (o1[2] * o1[2] + o1[3] * o1[3]));
                        u32x4 w; w.x = cvt_pk_bf16(o0[0], o0[1]); w.y = cvt_pk_bf16(o0[2], o0[3]); w.z = cvt_pk_bf16(o1[0], o1[1]); w.w = cvt_pk_bf16(o1[2], o1[3]); *(u32x4*)(xb + off + bj * HALF) = w; } }
                if (xb) { q += __shfl_xor(q, 16); q += __shfl_xor(q, 32); if (fq == 0) atomicAdd(ss + row0 + ai * HALF + m * 16, q); } }
        }
    }
};

template <class Epi, class Sched, bool ALIGN_EPI = false, bool SP2 = false>
__device__ __forceinline__ void gemm_phase(PG8_LAS unsigned char* lds, const Gemm g, const Sched& S, const Epi& E, int tid_in) {
    int tid_l = tid_in; asm volatile("" : "+v"(tid_l)); const int tid = tid_l, wid = __builtin_amdgcn_readfirstlane(tid >> 6), lane = tid & 63, wr = wid >> 2, wc = wid & 3, fr = lane & 15, fq = lane >> 4;
    const int K = g.K, nt = K / BK;
    unsigned voffA[2], voffB[2];
#pragma unroll
    for (int i = 0; i < 2; ++i) { int R, C; stage_rc(tid * 16 + i * 8192, R, C); const int Rb = Epi::PERM ? ((R & ~31) + perm32(R & 31)) : R;
        voffA[i] = (unsigned)(R * K + C) * 2u; voffB[i] = (unsigned)(Rb * K + C) * 2u; }
    const size_t kstep = (size_t)(BK * 2);
    const size_t hstep = (size_t)HALF * K * 2;
    const size_t tstep = 2 * hstep;
    const unsigned ldsw = (unsigned)wid * 1024u;
    const int aoff = lds_byte(wr * 64 + fr, fq * 8), boff = lds_byte(wc * 32 + fr, fq * 8);
#define PG8_SA(b, h) (((b) * 2 + (h)) * HTB)
#define PG8_SB(b, h) ((4 + (b) * 2 + (h)) * HTB)
#define PG8_STAGE(bufoff, gbase, voff) do { _Pragma("unroll") for (int _i = 0; _i < 2; ++_i) \
        __builtin_amdgcn_global_load_lds((const unsigned*)((const char*)(gbase) + (voff)[_i]), (PG8_LAS unsigned*)(lds + (bufoff) + ldsw + _i * 8192), 16, 0, 0); } while (0)
#define PG8_LDA(dst, b, h) do { _Pragma("unroll") for (int m = 0; m < 4; ++m) _Pragma("unroll") for (int k = 0; k < 2; ++k) dst[m][k] = *(const PG8_LAS bf16x8*)(lds + PG8_SA(b, h) + aoff + m * 2048 + k * 1024); } while (0)
#define PG8_LDB(dst, b, h) do { _Pragma("unroll") for (int n = 0; n < 2; ++n) _Pragma("unroll") for (int k = 0; k < 2; ++k) dst[n][k] = *(const PG8_LAS bf16x8*)(lds + PG8_SB(b, h) + boff + n * 2048 + k * 1024); } while (0)
#define PG8_MMA(ai, bj, At, Bt) do { __builtin_amdgcn_s_setprio(1); _Pragma("unroll") for (int m = 0; m < 4; ++m) _Pragma("unroll") for (int n = 0; n < 2; ++n) _Pragma("unroll") for (int k = 0; k < 2; ++k) \
        acc[ai][bj][m][n] = __builtin_amdgcn_mfma_f32_16x16x32_bf16(Bt[n][k], At[m][k], acc[ai][bj][m][n], 0, 0, 0); __builtin_amdgcn_s_setprio(0); } while (0)
#define PG8_WAIT_V(n) asm volatile("s_waitcnt vmcnt(" #n ")" ::: "memory")
#define PG8_WAIT_L(n) asm volatile("s_waitcnt lgkmcnt(" #n ")" ::: "memory")
#define PG8_BAR __builtin_amdgcn_s_barrier()
#define PG8_SCHED __builtin_amdgcn_sched_barrier(0)
    Unit cur, nxt; int ui = 0;
    if (!S.next(0, cur)) return;
    f32x4 acc[2][2][4][2];
#pragma unroll
    for (int a = 0; a < 2; ++a)
#pragma unroll
        for (int b = 0; b < 2; ++b)
#pragma unroll
            for (int m = 0; m < 4; ++m)
#pragma unroll
                for (int n = 0; n < 2; ++n) acc[a][b][m][n] = (f32x4){0.f, 0.f, 0.f, 0.f};
    bf16x8 At[4][2], B0[2][2], B1[2][2];
    const char* cA = (const char*)g.A + (size_t)cur.pm * tstep; const char* cB = (const char*)g.Bt + (size_t)cur.pn * tstep;
    S.a_ready(cur);
    if constexpr (SP2) {
        PG8_STAGE(PG8_SB(0, 0), cB, voffB); PG8_STAGE(PG8_SB(0, 1), cB + hstep, voffB); PG8_STAGE(PG8_SA(0, 0), cA, voffA); PG8_STAGE(PG8_SA(0, 1), cA + hstep, voffA);
        if (wr == 1) PG8_BAR;
        PG8_WAIT_V(2); PG8_BAR;
        PG8_STAGE(PG8_SB(1, 0), cB + kstep, voffB); PG8_STAGE(PG8_SA(1, 0), cA + kstep, voffA); PG8_STAGE(PG8_SB(1, 1), cB + hstep + kstep, voffB);
        PG8_WAIT_V(6); PG8_BAR;
    } else {
        PG8_STAGE(PG8_SB(0, 0), cB, voffB); PG8_STAGE(PG8_SA(0, 0), cA, voffA); PG8_STAGE(PG8_SB(0, 1), cB + hstep, voffB); PG8_STAGE(PG8_SA(0, 1), cA + hstep, voffA);
        if (wr == 1) PG8_BAR;
        PG8_WAIT_V(4); PG8_BAR;
        PG8_STAGE(PG8_SB(1, 0), cB + kstep, voffB); PG8_STAGE(PG8_SA(1, 0), cA + kstep, voffA); PG8_STAGE(PG8_SB(1, 1), cB + hstep + kstep, voffB);
        PG8_WAIT_V(6); PG8_BAR;
    }
    for (;;) {
        const bool has_next = S.next(ui + 1, nxt);
        const char* nA = has_next ? (const char*)g.A + (size_t)nxt.pm * tstep : cA; const char* nB = has_next ? (const char*)g.Bt + (size_t)nxt.pn * tstep : cB;
        for (int t = 0; t < nt; t += 2) {
            const bool last = (t == nt - 2);
            const char* a1 = cA + (size_t)(t + 1) * kstep;
            const char* a2 = last ? nA : cA + (size_t)(t + 2) * kstep; const char* b2 = last ? nB : cB + (size_t)(t + 2) * kstep;
            const char* a3 = a2 + kstep; const char* b3 = b2 + kstep;
            if (last && has_next) S.a_ready(nxt);
            if constexpr (SP2) {
            PG8_LDB(B0, 0, 0); PG8_LDB(B1, 0, 1); PG8_SCHED; PG8_LDA(At, 0, 0); PG8_STAGE(PG8_SA(1, 1), a1 + hstep, voffA);
            PG8_WAIT_V(8); PG8_WAIT_L(0); PG8_BAR; PG8_MMA(0, 0, At, B0); PG8_MMA(0, 1, At, B1); PG8_BAR; PG8_SCHED;
            PG8_LDA(At, 0, 1); PG8_STAGE(PG8_SB(0, 0), b2, voffB); PG8_STAGE(PG8_SB(0, 1), b2 + hstep, voffB); PG8_STAGE(PG8_SA(0, 0), a2, voffA);
            PG8_WAIT_V(8); PG8_WAIT_L(0); PG8_BAR; PG8_MMA(1, 0, At, B0); PG8_MMA(1, 1, At, B1); PG8_BAR; PG8_SCHED;
            PG8_LDB(B0, 1, 0); PG8_LDB(B1, 1, 1); PG8_SCHED; PG8_LDA(At, 1, 0); PG8_STAGE(PG8_SA(0, 1), a2 + hstep, voffA);
            PG8_WAIT_V(8); PG8_WAIT_L(0); PG8_BAR; PG8_MMA(0, 0, At, B0); PG8_MMA(0, 1, At, B1); PG8_BAR; PG8_SCHED;
            PG8_LDA(At, 1, 1); PG8_STAGE(PG8_SB(1, 0), b3, voffB); PG8_STAGE(PG8_SB(1, 1), b3 + hstep, voffB); PG8_STAGE(PG8_SA(1, 0), a3, voffA);
            PG8_WAIT_V(8); PG8_WAIT_L(0); PG8_BAR; PG8_MMA(1, 0, At, B0); PG8_MMA(1, 1, At, B1); PG8_BAR; PG8_SCHED;
            } else {
            PG8_LDB(B0, 0, 0); PG8_SCHED; PG8_LDA(At, 0, 0); PG8_STAGE(PG8_SA(1, 1), a1 + hstep, voffA);
            PG8_WAIT_L(8); PG8_BAR; PG8_WAIT_L(0); PG8_MMA(0, 0, At, B0); PG8_BAR; PG8_SCHED;
            PG8_LDB(B1, 0, 1); PG8_STAGE(PG8_SB(0, 0), b2, voffB);
            PG8_BAR; PG8_WAIT_L(0); PG8_MMA(0, 1, At, B1); PG8_BAR;
            PG8_LDA(At, 0, 1); PG8_STAGE(PG8_SA(0, 0), a2, voffA);
            PG8_BAR; PG8_WAIT_L(0); PG8_MMA(1, 0, At, B0); PG8_BAR; PG8_SCHED;
            PG8_STAGE(PG8_SB(0, 1), b2 + hstep, voffB);
            PG8_WAIT_V(6); PG8_BAR; PG8_MMA(1, 1, At, B1); PG8_BAR;
            PG8_LDB(B0, 1, 0); PG8_SCHED; PG8_LDA(At, 1, 0); PG8_STAGE(PG8_SA(0, 1), a2 + hstep, voffA);
            PG8_WAIT_L(8); PG8_BAR; PG8_WAIT_L(0); PG8_MMA(0, 0, At, B0); PG8_BAR; PG8_SCHED;
            PG8_LDB(B1, 1, 1); PG8_STAGE(PG8_SB(1, 0), b3, voffB);
            PG8_BAR; PG8_WAIT_L(0); PG8_MMA(0, 1, At, B1); PG8_BAR;
            PG8_LDA(At, 1, 1); PG8_STAGE(PG8_SA(1, 0), a3, voffA);
            PG8_BAR; PG8_WAIT_L(0); PG8_MMA(1, 0, At, B0); PG8_BAR; PG8_SCHED;
            PG8_STAGE(PG8_SB(1, 1), b3 + hstep, voffB);
            PG8_WAIT_V(6); PG8_BAR; PG8_MMA(1, 1, At, B1); PG8_BAR;
            }
        }
        if constexpr (ALIGN_EPI) { if (wr == 0) PG8_BAR; }
        if constexpr (!Epi::AFTER_DRAIN) { E(acc, cur, wr, wc, fr, fq); S.done(cur); }
        if (!has_next) break;
#pragma unroll
        for (int a = 0; a < 2; ++a)
#pragma unroll
            for (int b = 0; b < 2; ++b)
#pragma unroll
                for (int m = 0; m < 4; ++m)
#pragma unroll
                    for (int n = 0; n < 2; ++n) acc[a][b][m][n] = (f32x4){0.f, 0.f, 0.f, 0.f};
        cur = nxt; cA = nA; cB = nB; ++ui;
        if constexpr (ALIGN_EPI) { if (wr == 1) PG8_BAR; }
    }
    PG8_WAIT_V(0);
    if constexpr (!ALIGN_EPI) { if (wr == 0) PG8_BAR; }
    PG8_BAR;
    if constexpr (Epi::AFTER_DRAIN) { E.fused(acc, cur, wr, wc, fr, fq, lds, wid, lane); S.done(cur); }
#undef PG8_SA
#undef PG8_SB
#undef PG8_STAGE
#undef PG8_LDA
#undef PG8_LDB
#undef PG8_MMA
#undef PG8_WAIT_V
#undef PG8_WAIT_L
#undef PG8_BAR
#undef PG8_SCHED
}
}

typedef unsigned short bf16_t;
typedef short bf16x8 __attribute__((ext_vector_type(8)));
typedef short s16x4 __attribute__((ext_vector_type(4)));
typedef float f32x4 __attribute__((ext_vector_type(4)));
typedef float f32x16 __attribute__((ext_vector_type(16)));
typedef unsigned u32x4 __attribute__((ext_vector_type(4)));
typedef unsigned u32x2 __attribute__((ext_vector_type(2)));
#define DI __device__ __forceinline__
#define LAUNDER(x) asm volatile("" : "+v"(x))

constexpr int T_ = 32768, DM = 1024, FF = 2816, SEQ = 16384, NLAYER = 2;
constexpr int INC = 3336, INP = 3584, PLD = 3344;
constexpr int C_AQ = 0, C_AK = 256, C_AV = 512, C_BQ = 768, C_BK = 1024, C_BV = 1280, C_BO = 1536, C_CQ = 1792, C_CK = 2048, C_CV = 2304, C_DQ = 2560, C_DK = 2816, C_DV = 3072, C_GI = 3328, C_GF = 3332;
constexpr float LOG2E = 1.4426950408889634f, EPS_ = 1e-6f;
#ifndef D_EARLY
#define D_EARLY 1
#endif

constexpr size_t SZ_WGU = (size_t)2 * FF * DM * 2, SZ_WD = (size_t)DM * FF * 2, SZ_WIN = (size_t)INP * DM * 2, SZ_WOUT = (size_t)DM * DM * 2;
constexpr size_t LW_WGU1 = 0, LW_WD1 = LW_WGU1 + SZ_WGU, LW_WIN = LW_WD1 + SZ_WD, LW_WOUT = LW_WIN + SZ_WIN, LW_WGU2 = LW_WOUT + SZ_WOUT, LW_WD2 = LW_WGU2 + SZ_WGU, LW_SIZE = LW_WD2 + SZ_WD;
constexpr size_t WS_CTL = 0, WS_W = 8192, WS_XN = WS_W + NLAYER * LW_SIZE, WS_HP = WS_XN + (size_t)T_ * DM * 2, WS_BQ = WS_HP + (size_t)T_ * PLD * 2,
                 WS_BK = WS_BQ + (size_t)T_ * 256 * 2, WS_BKT = WS_BK + (size_t)T_ * 256 * 2, WS_VT = WS_BKT + (size_t)T_ * 256 * 2, WS_DC = WS_VT + (size_t)4 * T_ * 256 * 2,
                 WS_SC = WS_DC + (size_t)8 * 256 * 4160 * 4, WS_SS = WS_SC + 3 * 8 * 256 * 4, WS_END = WS_SS + (size_t)7 * T_ * 4;
static_assert(WS_XN % 256 == 0 && WS_HP % 256 == 0 && WS_BQ % 256 == 0 && WS_DC % 256 == 0 && (size_t)T_ * FF * 2 <= (size_t)T_ * PLD * 2, "ws map");
constexpr int LDS_BYTES = pg8::STAGE_BYTES + 1024;

DI unsigned pk2(float a, float b) { return pg8::cvt_pk_bf16(a, b); }
DI float bf2f(bf16_t h) { return __uint_as_float((unsigned)h << 16); }
DI float bflo(unsigned w) { return __uint_as_float(w << 16); }
DI float bfhi(unsigned w) { return __uint_as_float(w & 0xffff0000u); }
DI float ex2(float x) { return __builtin_amdgcn_exp2f(x); }
DI float lg2(float x) { return __builtin_amdgcn_logf(x); }
DI float rcpf_(float x) { return __builtin_amdgcn_rcpf(x); }
DI int crow(int r, int hi) { return (r & 3) + 8 * (r >> 2) + 4 * hi; }
#define MFMA32(a, b, c) __builtin_amdgcn_mfma_f32_32x32x16_bf16((a), (b), (c), 0, 0, 0)
DI f32x16 splat16(float v) { f32x16 r;
#pragma unroll
  for (int i = 0; i < 16; ++i) r[i] = v; return r; }
DI bf16x8 pack8(const f32x16& s, int kk) {
  u32x4 p; p.x = pk2(s[8 * kk], s[8 * kk + 1]); p.y = pk2(s[8 * kk + 2], s[8 * kk + 3]); p.z = pk2(s[8 * kk + 4], s[8 * kk + 5]); p.w = pk2(s[8 * kk + 6], s[8 * kk + 7]);
  return __builtin_bit_cast(bf16x8, p); }
DI bf16x8 cat4(s16x4 lo, s16x4 hi) { return __builtin_shufflevector(lo, hi, 0, 1, 2, 3, 4, 5, 6, 7); }

struct Args { const float* in[23]; float* out; unsigned char* ws; };

struct TDesc { const float* W0; const float* W1; const float* gk; bf16_t* WT; int kind, K, N, kt, nt; };
DI TDesc tt_decode(const Args& a, int it) {
  constexpr int I_GU = 16 * 88, I_D = 44 * 16, I_IN = 16 * 56, I_OUT = 16 * 16, I_L = 2 * I_GU + 2 * I_D + I_IN + I_OUT;
  const int l = it / I_L; int r = it % I_L; unsigned char* wl = a.ws + WS_W + (size_t)l * LW_SIZE; TDesc d;
  if (r < I_GU) { d.W0 = a.in[2] + (size_t)l * DM * FF; d.W1 = a.in[3] + (size_t)l * DM * FF; d.gk = a.in[1] + l * DM; d.WT = (bf16_t*)(wl + LW_WGU1); d.kind = 0; d.K = DM; d.N = FF; d.kt = r / 88; d.nt = r % 88; return d; } r -= I_GU;
  if (r < I_D) { d.W0 = a.in[4] + (size_t)l * FF * DM; d.W1 = nullptr; d.gk = nullptr; d.WT = (bf16_t*)(wl + LW_WD1); d.kind = 1; d.K = FF; d.N = DM; d.kt = r / 16; d.nt = r % 16; return d; } r -= I_D;
  if (r < I_IN) { d.W0 = a.in[6] + (size_t)l * DM * INC; d.W1 = nullptr; d.gk = a.in[5] + l * DM; d.WT = (bf16_t*)(wl + LW_WIN); d.kind = 2; d.K = DM; d.N = INC; d.kt = r / 56; d.nt = r % 56; return d; } r -= I_IN;
  if (r < I_OUT) { d.W0 = a.in[18] + (size_t)l * DM * DM; d.W1 = nullptr; d.gk = nullptr; d.WT = (bf16_t*)(wl + LW_WOUT); d.kind = 1; d.K = DM; d.N = DM; d.kt = r / 16; d.nt = r % 16; return d; } r -= I_OUT;
  if (r < I_GU) { d.W0 = a.in[20] + (size_t)l * DM * FF; d.W1 = a.in[21] + (size_t)l * DM * FF; d.gk = a.in[19] + l * DM; d.WT = (bf16_t*)(wl + LW_WGU2); d.kind = 0; d.K = DM; d.N = FF; d.kt = r / 88; d.nt = r % 88; return d; } r -= I_GU;
  d.W0 = a.in[22] + (size_t)l * FF * DM; d.W1 = nullptr; d.gk = nullptr; d.WT = (bf16_t*)(wl + LW_WD2); d.kind = 1; d.K = FF; d.N = DM; d.kt = r / 16; d.nt = r % 16; return d;
}
DI void tt_load(const TDesc& d, f32x4 (&v)[2], int tid) {
  const int n4 = tid & 15, np = d.nt * 64 + 4 * n4, k0 = d.kt * 64; const float* src = d.W0; int col;
  if (d.kind == 0) { const int pn = np >> 8, r = np & 255; src = (r < 128) ? d.W0 : d.W1; col = 128 * pn + (r & 127); }
  else if (d.kind == 1) col = np;
  else col = (np < 1792) ? np : (np < 3328) ? np + 8 : (np < 3336) ? 1792 + (np - 3328) : -1;
#pragma unroll
  for (int p = 0; p < 2; ++p) { const int kk = (tid >> 4) + 32 * p;
    v[p] = (col >= 0) ? *(const f32x4*)(src + (size_t)(k0 + kk) * d.N + col) * (d.gk ? d.gk[k0 + kk] : 1.f) : (f32x4){0.f, 0.f, 0.f, 0.f}; }
}
DI void prologue_weights(const Args& a, unsigned char* lds, int tid) {
  LAUNDER(tid);
  constexpr int NI = 6, NITEMS = NLAYER * (2 * 16 * 88 + 2 * 44 * 16 + 16 * 56 + 16 * 16);
  for (int it0 = blockIdx.x; it0 < NITEMS; it0 += NI * gridDim.x) {
    f32x4 v[NI][2]; TDesc d[NI];
#pragma unroll
    for (int q = 0; q < NI; ++q) { const int it = it0 + q * gridDim.x; if (it < NITEMS) { d[q] = tt_decode(a, it); tt_load(d[q], v[q], tid); } }
#pragma unroll
    for (int q = 0; q < NI; ++q) { float* scr = (float*)lds + q * (64 * 65);
#pragma unroll
      for (int p = 0; p < 2; ++p) { float* w = scr + ((tid >> 4) + 32 * p) * 65 + 4 * (tid & 15); w[0] = v[q][p].x; w[1] = v[q][p].y; w[2] = v[q][p].z; w[3] = v[q][p].w; } }
    __syncthreads();
#pragma unroll
    for (int q = 0; q < NI; ++q) { const int it = it0 + q * gridDim.x; if (it < NITEMS) {
      const int n = tid >> 3, kc = tid & 7; const float* sp = (const float*)lds + q * (64 * 65) + (8 * kc) * 65 + n;
      u32x4 o; o.x = pk2(sp[0], sp[65]); o.y = pk2(sp[2 * 65], sp[3 * 65]); o.z = pk2(sp[4 * 65], sp[5 * 65]); o.w = pk2(sp[6 * 65], sp[7 * 65]);
      *(u32x4*)(d[q].WT + (size_t)(d[q].nt * 64 + n) * d[q].K + d[q].kt * 64 + 8 * kc) = o; } }
    __syncthreads();
  }
}

DI float wave_sum(float v) {
#pragma unroll
  for (int o = 1; o < 64; o <<= 1) v += __shfl_xor(v, o);
  return v; }
DI float wave_max(float v) {
#pragma unroll
  for (int o = 1; o < 64; o <<= 1) v = fmaxf(v, __shfl_xor(v, o));
  return v; }
DI void cast_phase(const float* x, bf16_t* xb, float* ss, int tid) {
  LAUNDER(tid);
  const int lane = tid & 63, gw = blockIdx.x * 8 + (tid >> 6), ngw = gridDim.x * 8;
  for (int i = blockIdx.x * 512 + tid; i < 6 * T_; i += gridDim.x * 512) ss[T_ + i] = 0.f;
  for (int m0 = gw; m0 < T_; m0 += 2 * ngw) {
    f32x4 v[2][4];
#pragma unroll
    for (int r = 0; r < 2; ++r) { const int m = m0 + r * ngw; if (m < T_) { const f32x4* xr = (const f32x4*)(x + (size_t)m * DM) + lane;
#pragma unroll
      for (int j = 0; j < 4; ++j) v[r][j] = xr[64 * j]; } }
#pragma unroll
    for (int r = 0; r < 2; ++r) { const int m = m0 + r * ngw; if (m < T_) { float q = 0.f;
#pragma unroll
      for (int j = 0; j < 4; ++j) q += (v[r][j].x * v[r][j].x + v[r][j].y * v[r][j].y) + (v[r][j].z * v[r][j].z + v[r][j].w * v[r][j].w);
      q = wave_sum(q); if (lane == 0) ss[m] = q;
      u32x2* o = (u32x2*)(xb + (size_t)m * DM) + lane;
#pragma unroll
      for (int j = 0; j < 4; ++j) { u32x2 w; w.x = pk2(v[r][j].x, v[r][j].y); w.y = pk2(v[r][j].z, v[r][j].w); o[64 * j] = w; } } }
  }
}

struct PrepParams { const float *aqg, *akg, *cqg, *ckg, *convw, *convb; };
DI void prep_phase(bf16_t* P, bf16_t* BQ, bf16_t* BK, bf16_t* BKt, bf16_t* Vt, const PrepParams& pp, unsigned char* lds, int tid) {
  LAUNDER(tid);
  float* gt = (float*)lds;
  if (tid < 64) { gt[tid] = pp.aqg[tid]; gt[64 + tid] = pp.akg[tid]; gt[128 + tid] = pp.cqg[tid & 31]; gt[192 + tid] = pp.ckg[tid & 31]; gt[256 + tid] = 1.f; }
  __syncthreads();
  for (int tile = blockIdx.x; tile < T_ / 64; tile += gridDim.x) {
    const int tok0 = tile * 64, b = tok0 / SEQ, s0 = tok0 % SEQ;
    for (int id0 = tid; id0 < 64 * 160; id0 += 10 * 512) {
      u32x4 w4[10]; bf16_t* p4[10];
#pragma unroll
      for (int u = 0; u < 10; ++u) { const int id = id0 + 512 * u, tk = id / 160, ci = id % 160, seg = ci >> 5, within = (ci & 31) * 8;
        const int colb = (seg == 0) ? C_AQ : (seg == 1) ? C_AK : (seg == 2) ? C_CQ : (seg == 3) ? C_CK : C_DQ;
        p4[u] = P + (size_t)(tok0 + tk) * PLD + colb + within; w4[u] = *(const u32x4*)p4[u]; }
#pragma unroll
      for (int u = 0; u < 10; ++u) { const int id = id0 + 512 * u, ci = id % 160, seg = ci >> 5, within = (ci & 31) * 8;
        const u32x4 w = w4[u]; float v[8];
        v[0] = bflo(w.x); v[1] = bfhi(w.x); v[2] = bflo(w.y); v[3] = bfhi(w.y); v[4] = bflo(w.z); v[5] = bfhi(w.z); v[6] = bflo(w.w); v[7] = bfhi(w.w);
        float ss = 0.f;
#pragma unroll
        for (int j = 0; j < 8; ++j) ss += v[j] * v[j];
        ss += __shfl_xor(ss, 1); ss += __shfl_xor(ss, 2);
        const float ss32 = ss; ss += __shfl_xor(ss, 4);
        float sc;
        if (seg < 2) { sc = rsqrtf(ss * (1.f / 64.f) + EPS_) * (seg == 0 ? 0.125f * LOG2E : 1.f); }
        else if (seg < 4) { sc = rsqrtf(ss32 * (1.f / 32.f) + EPS_) * (seg == 2 ? 0.17677669529663687f * LOG2E : 1.f); }
        else { sc = 0.125f * LOG2E; }
        const float* gp = gt + seg * 64 + (within & 63);
        const f32x4 ga = *(const f32x4*)gp, gb = *(const f32x4*)(gp + 4);
        u32x4 o; o.x = pk2(v[0] * sc * ga.x, v[1] * sc * ga.y); o.y = pk2(v[2] * sc * ga.z, v[3] * sc * ga.w); o.z = pk2(v[4] * sc * gb.x, v[5] * sc * gb.y); o.w = pk2(v[6] * sc * gb.z, v[7] * sc * gb.w);
        *(u32x4*)p4[u] = o; }
    }
    bf16_t* Lin = (bf16_t*)(lds + 2048); bf16_t* Lout = Lin + 67 * 264;
    u32x4 r[5];
#define PREP_LOAD_GROUP(G) do { const int col0_ = ((G) == 0) ? C_AV : ((G) == 1) ? C_BV : ((G) == 2) ? C_CV : ((G) == 3) ? C_DV : ((G) == 4) ? C_BQ : C_BK; \
      _Pragma("unroll") for (int u = 0; u < 5; ++u) { const int idx = tid + 512 * u, row = idx >> 5, pc = idx & 31, srow = s0 - 3 + row; \
        r[u] = (u32x4){0u, 0u, 0u, 0u}; \
        if (idx < 67 * 32 && srow >= 0) r[u] = *(const u32x4*)(P + (size_t)(b * SEQ + srow) * PLD + col0_ + 8 * pc); } } while (0)
    PREP_LOAD_GROUP(0);
#pragma unroll
    for (int g = 0; g < 6; ++g) {
      __syncthreads();
#pragma unroll
      for (int u = 0; u < 5; ++u) { const int idx = tid + 512 * u, row = idx >> 5, pc = idx & 31; if (idx < 67 * 32) *(u32x4*)(Lin + row * 264 + 8 * pc) = r[u]; }
      __syncthreads();
      if (g + 1 < 6) PREP_LOAD_GROUP(g + 1);
      const int c = tid & 255, th = tid >> 8; const bf16_t* colp = Lin + (32 * th) * 264 + c;
      if (g < 4) {
        unsigned w[16];
#pragma unroll
        for (int q = 0; q < 16; ++q) { const int p = 2 * q, i = (p & ~12) | ((p & 4) << 1) | ((p & 8) >> 1);
          w[q] = (unsigned)colp[(3 + i) * 264] | ((unsigned)colp[(3 + i + 1) * 264] << 16); }
        bf16_t* vd = Vt + (size_t)g * T_ * 256 + (((size_t)(b * 4 + (c >> 6)) * 256 + (s0 >> 6)) * 64 + (c & 63)) * 64 + 32 * th;
#pragma unroll
        for (int q4 = 0; q4 < 4; ++q4) { u32x4 o; o.x = w[4 * q4]; o.y = w[4 * q4 + 1]; o.z = w[4 * q4 + 2]; o.w = w[4 * q4 + 3]; *(u32x4*)(vd + 8 * q4) = o; }
      } else {
        const int cq = (g - 4) * 256 + c;
        const float w0 = pp.convw[cq], w1 = pp.convw[512 + cq], w2 = pp.convw[1024 + cq], w3 = pp.convw[1536 + cq], bb = pp.convb[cq], sc = (g == 4) ? 1.f : 0.125f;
        float x[35];
#pragma unroll
        for (int i = 0; i < 35; ++i) x[i] = bf2f(colp[i * 264]);
        unsigned short yb[32];
#pragma unroll
        for (int i = 0; i < 32; ++i) { const float y = bb + x[i] * w0 + x[i + 1] * w1 + x[i + 2] * w2 + x[i + 3] * w3; yb[i] = (unsigned short)(pk2(pg8::silu_f(y) * sc, 0.f) & 0xffffu); Lout[(32 * th + i) * 264 + c] = yb[i]; }
        if (g == 5) {
          bf16_t* kd = BKt + (((size_t)(b * 4 + (c >> 6)) * 256 + (s0 >> 6)) * 64 + (c & 63)) * 64 + 32 * th;
#pragma unroll
          for (int q4 = 0; q4 < 4; ++q4) { unsigned w[4];
#pragma unroll
            for (int q = 0; q < 4; ++q) { const int p = 2 * (4 * q4 + q), i = (p & ~12) | ((p & 4) << 1) | ((p & 8) >> 1); w[q] = (unsigned)yb[i] | ((unsigned)yb[i + 1] << 16); }
            u32x4 o; o.x = w[0]; o.y = w[1]; o.z = w[2]; o.w = w[3]; *(u32x4*)(kd + 8 * q4) = o; }
        }
        __syncthreads();
        bf16_t* dst = (g == 4) ? BQ : BK;
#pragma unroll
        for (int u = 0; u < 4; ++u) { const int idx = tid + 512 * u, row = idx >> 5, pc = idx & 31; *(u32x4*)(dst + (size_t)(tok0 + row) * 256 + 8 * pc) = *(const u32x4*)(Lout + row * 264 + 8 * pc); }
      }
    }
    __syncthreads();
  }
}

#undef PREP_LOAD_GROUP
DI float wave_scan_add(float v, int lane) {
#pragma unroll
  for (int o = 1; o < 64; o <<= 1) { const float t = __shfl_up(v, o); if (lane >= o) v += t; }
  return v; }
DI float wave_scan_max(float v, int lane) {
#pragma unroll
  for (int o = 1; o < 64; o <<= 1) { const float t = __shfl_up(v, o); if (lane >= o) v = fmaxf(v, t); }
  return v; }
DI float fexp(float x) { return ex2(x * LOG2E); }
DI float log_sigmoid_f(float x) { return fminf(x, 0.f) - lg2(1.0f + fexp(-fabsf(x))) * 0.6931471805599453f; }
DI void lds_wave_sync() { asm volatile("s_waitcnt lgkmcnt(0)" ::: "memory"); __builtin_amdgcn_wave_barrier(); }

DI void b1_phase(const bf16_t* P, const bf16_t* BKt, const bf16_t* VtB, float* DC, float* SC, const float* gate_bias, unsigned char* lds, int tid) {
  LAUNDER(tid);
  const int lane = tid & 63, wave = tid >> 6, r32 = lane & 31, hi = lane >> 5;
  float* wsc = (float*)(lds + wave * 1024);
  for (int item = blockIdx.x * 8 + wave; item < 2048; item += gridDim.x * 8) {
    const int bh = item >> 8, c = item & 255, b = bh >> 2, h = bh & 3, s0 = c * 64; const size_t tok0 = (size_t)b * SEQ + s0;
    const float gf = bf2f(P[(tok0 + lane) * PLD + C_GF + h]) + gate_bias[4 + h], gi = bf2f(P[(tok0 + lane) * PLD + C_GI + h]) + gate_bias[h];
    const float lf = log_sigmoid_f(gf), bcum = wave_scan_add(lf, lane), btot = __shfl(bcum, 63);
    const float g = btot - bcum + gi, mloc = wave_max(g), w = fexp(g - mloc);
    wsc[lane] = w; lds_wave_sync();
    f32x16 acc[2][2];
#pragma unroll
    for (int i = 0; i < 2; ++i)
#pragma unroll
      for (int j = 0; j < 2; ++j) acc[i][j] = splat16(0.f);
    float dn[2] = {0.f, 0.f};
#pragma unroll
    for (int ks = 0; ks < 4; ++ks) {
      const f32x4 wa = *(const f32x4*)(wsc + 16 * ks + 4 * hi), wb = *(const f32x4*)(wsc + 16 * ks + 8 + 4 * hi);
      bf16x8 vf[2], kf[2];
#pragma unroll
      for (int eb = 0; eb < 2; ++eb) {
        vf[eb] = *(const bf16x8*)(VtB + (((size_t)bh * 256 + c) * 64 + 32 * eb + r32) * 64 + 16 * ks + 8 * hi);
        const u32x4 kw = *(const u32x4*)(BKt + (((size_t)bh * 256 + c) * 64 + 32 * eb + r32) * 64 + 16 * ks + 8 * hi);
        const float k0 = bflo(kw.x) * wa.x, k1 = bfhi(kw.x) * wa.y, k2 = bflo(kw.y) * wa.z, k3 = bfhi(kw.y) * wa.w, k4 = bflo(kw.z) * wb.x, k5 = bfhi(kw.z) * wb.y, k6 = bflo(kw.w) * wb.z, k7 = bfhi(kw.w) * wb.w;
        dn[eb] += ((k0 + k1) + (k2 + k3)) + ((k4 + k5) + (k6 + k7));
        u32x4 o; o.x = pk2(k0, k1); o.y = pk2(k2, k3); o.z = pk2(k4, k5); o.w = pk2(k6, k7); kf[eb] = __builtin_bit_cast(bf16x8, o);
      }
#pragma unroll
      for (int eb = 0; eb < 2; ++eb)
#pragma unroll
        for (int db = 0; db < 2; ++db) acc[eb][db] = MFMA32(vf[eb], kf[db], acc[eb][db]);
    }
    float* dc = DC + ((size_t)bh * 256 + c) * 4160;
#pragma unroll
    for (int eb = 0; eb < 2; ++eb)
#pragma unroll
      for (int db = 0; db < 2; ++db)
#pragma unroll
        for (int i = 0; i < 16; ++i) dc[(32 * eb + crow(i, hi)) * 64 + 32 * db + r32] = acc[eb][db][i];
#pragma unroll
    for (int db = 0; db < 2; ++db) { const float t = dn[db] + __shfl_xor(dn[db], 32); if (hi == 0) dc[4096 + 32 * db + r32] = t; }
    if (lane == 0) { SC[bh * 256 + c] = btot; SC[2048 + bh * 256 + c] = mloc; }
    lds_wave_sync();
  }
}

DI void b2_item(float* DC, float* SC, int j, unsigned char* lds, int tid) {
  LAUNDER(tid);
  float* L = (float*)lds;
  const int ge = j * 512 + tid, bh0 = (j * 512) / 1040, bh1 = (j * 512 + 511) / 1040;
  { const int slot = tid >> 8, c = tid & 255, bh = slot ? bh1 : bh0;
    if (bh < 8) { L[slot * 1024 + c] = SC[bh * 256 + c]; L[slot * 1024 + 256 + c] = SC[2048 + bh * 256 + c]; } }
  __syncthreads();
  if ((tid & 63) == 0 && (tid >> 6) < 2) { const int slot = tid >> 6, bh = slot ? bh1 : bh0;
    if (bh < 8 && (slot == 0 || bh1 != bh0)) { float* q = L + slot * 1024; float m = 0.f; const bool wr = (j * 512 <= bh * 1040) && (bh * 1040 < j * 512 + 512);
      for (int c = 0; c < 256; ++c) { const float b = q[c], l = q[256 + c], mn = fmaxf(b + m, l); q[512 + c] = fexp(b + m - mn); q[768 + c] = fexp(l - mn); if (wr) SC[4096 + bh * 256 + c] = m; m = mn; } } }
  __syncthreads();
  if (ge < 8 * 1040) {
    const int bh = ge / 1040, el = (ge % 1040) * 4; const float* q = L + ((bh == bh0) ? 0 : 1024);
    float* p = DC + (size_t)bh * 256 * 4160 + el; float z0 = 0.f; LAUNDER(z0); f32x4 C = {z0, z0, z0, z0};
    for (int c0 = 0; c0 < 256; c0 += 8) {
      f32x4 d[8];
#pragma unroll
      for (int u = 0; u < 8; ++u) d[u] = *(const f32x4*)(p + (size_t)(c0 + u) * 4160);
#pragma unroll
      for (int u = 0; u < 8; ++u) { *(f32x4*)(p + (size_t)(c0 + u) * 4160) = C; C = C * q[512 + c0 + u] + d[u] * q[768 + c0 + u]; }
    }
  }
}

DI void b3_phase(const bf16_t* P, const bf16_t* BQ, const bf16_t* BK, const bf16_t* VtB, const float* DC, const float* SC, const float* gate_bias, const float* onorm, bf16_t* Y, unsigned char* lds, int tid) {
  LAUNDER(tid);
  const int lane = tid & 63, wave = tid >> 6, r32 = lane & 31, hi = lane >> 5;
  float* R = (float*)(lds + wave * 2048); float* MU = R + 64; float* SI = R + 128; float* EM = R + 192; float* NV = R + 256;
  for (int item = blockIdx.x * 8 + wave; item < 2048; item += gridDim.x * 8) {
    const int bh = item >> 8, c = item & 255, b = bh >> 2, h = bh & 3, s0 = c * 64; const size_t tok0 = (size_t)b * SEQ + s0;
    const float* dc = DC + ((size_t)bh * 256 + c) * 4160;
    {
      const float gf = bf2f(P[(tok0 + lane) * PLD + C_GF + h]) + gate_bias[4 + h], gi = bf2f(P[(tok0 + lane) * PLD + C_GI + h]) + gate_bias[h];
      const float lf = log_sigmoid_f(gf), bcum = wave_scan_add(lf, lane), r = gi - bcum, pmax = wave_scan_max(r, lane);
      const float m_in = SC[4096 + bh * 256 + c], mu = fmaxf(m_in, pmax);
      R[lane] = r; MU[lane] = mu; SI[lane] = fexp(m_in - mu); EM[lane] = fexp(-bcum - mu); NV[lane] = dc[4096 + lane];
    }
    lds_wave_sync();
    bf16x8 cfr[2][4];
#pragma unroll
    for (int eb = 0; eb < 2; ++eb)
#pragma unroll
      for (int ks = 0; ks < 4; ++ks) { const float* cp = dc + (32 * eb + r32) * 64 + 16 * ks + 8 * hi; const f32x4 ca = *(const f32x4*)cp, cb = *(const f32x4*)(cp + 4);
        u32x4 o; o.x = pk2(ca.x, ca.y); o.y = pk2(ca.z, ca.w); o.z = pk2(cb.x, cb.y); o.w = pk2(cb.z, cb.w); cfr[eb][ks] = __builtin_bit_cast(bf16x8, o); }
#pragma unroll
    for (int tq = 0; tq < 2; ++tq) {
      const int t = 32 * tq + r32; const float mu_t = MU[t], si_t = SI[t], em_t = EM[t];
      bf16x8 qf[4]; float qn = 0.f;
#pragma unroll
      for (int ks = 0; ks < 4; ++ks) {
        const u32x4 qw = *(const u32x4*)(BQ + (tok0 + t) * 256 + h * 64 + 16 * ks + 8 * hi); qf[ks] = __builtin_bit_cast(bf16x8, qw);
        const f32x4 na = *(const f32x4*)(NV + 16 * ks + 8 * hi), nb = *(const f32x4*)(NV + 16 * ks + 8 * hi + 4);
        qn += bflo(qw.x) * na.x + bfhi(qw.x) * na.y + bflo(qw.y) * na.z + bfhi(qw.y) * na.w + bflo(qw.z) * nb.x + bfhi(qw.z) * nb.y + bflo(qw.w) * nb.z + bfhi(qw.w) * nb.w;
      }
      qn += __shfl_xor(qn, 32);
      f32x16 G[2], num[2];
#pragma unroll
      for (int eb = 0; eb < 2; ++eb) { G[eb] = splat16(0.f); num[eb] = splat16(0.f);
#pragma unroll
        for (int ks = 0; ks < 4; ++ks) G[eb] = MFMA32(cfr[eb][ks], qf[ks], G[eb]); }
      float dsum = 0.f;
#pragma unroll
      for (int tk = 0; tk < 2; ++tk) {
        if (tk <= tq) {
          f32x16 S = splat16(0.f);
#pragma unroll
          for (int ks = 0; ks < 4; ++ks) { const bf16x8 kf = *(const bf16x8*)(BK + (tok0 + 32 * tk + r32) * 256 + h * 64 + 16 * ks + 8 * hi); S = MFMA32(kf, qf[ks], S); }
          asm volatile("" ::: "memory");
#pragma unroll
          for (int g4 = 0; g4 < 4; ++g4) { const f32x4 rv = *(const f32x4*)(R + 32 * tk + 8 * g4 + 4 * hi);
#pragma unroll
            for (int j = 0; j < 4; ++j) { const int s = 32 * tk + 8 * g4 + 4 * hi + j; const float w = (s <= t) ? fexp(rv[j] - mu_t) : 0.f; const float val = S[4 * g4 + j] * w; dsum += val; S[4 * g4 + j] = val; } }
#pragma unroll
          for (int kk = 0; kk < 2; ++kk) { const bf16x8 pf = pack8(S, kk);
#pragma unroll
            for (int eb = 0; eb < 2; ++eb) { const bf16_t* vp = VtB + (((size_t)bh * 256 + c) * 64 + 32 * eb + r32) * 64 + 32 * tk + 16 * kk + 8 * hi;
              const bf16x8 vf = *(const bf16x8*)vp; num[eb] = MFMA32(vf, pf, num[eb]); } }
          asm volatile("" ::: "memory");
        }
      }
      dsum += __shfl_xor(dsum, 32);
      const float den = si_t * qn + dsum, inv = 1.0f / fmaxf(fabsf(den), em_t);
      float ss = 0.f;
#pragma unroll
      for (int eb = 0; eb < 2; ++eb)
#pragma unroll
        for (int i = 0; i < 16; ++i) { const float hv = (num[eb][i] + si_t * G[eb][i]) * inv; num[eb][i] = hv; ss += hv * hv; }
      ss += __shfl_xor(ss, 32);
      const float rstd = rsqrtf(ss * (1.f / 64.f) + EPS_);
      const bf16_t* bo = P + (tok0 + t) * PLD + C_BO + h * 64; bf16_t* yo = Y + (tok0 + t) * DM + 256 + h * 64;
#pragma unroll
      for (int eb = 0; eb < 2; ++eb)
#pragma unroll
        for (int g4 = 0; g4 < 4; ++g4) { const int e = 32 * eb + 8 * g4 + 4 * hi; const u32x2 bw = *(const u32x2*)(bo + e); const f32x4 gn = *(const f32x4*)(onorm + h * 64 + e);
          const float o0 = num[eb][4 * g4] * rstd * gn.x * rcpf_(1.f + fexp(-bflo(bw.x))), o1 = num[eb][4 * g4 + 1] * rstd * gn.y * rcpf_(1.f + fexp(-bfhi(bw.x)));
          const float o2 = num[eb][4 * g4 + 2] * rstd * gn.z * rcpf_(1.f + fexp(-bflo(bw.y))), o3 = num[eb][4 * g4 + 3] * rstd * gn.w * rcpf_(1.f + fexp(-bfhi(bw.y)));
          u32x2 ow; ow.x = pk2(o0, o1); ow.y = pk2(o2, o3); *(u32x2*)(yo + e) = ow; }
    }
    lds_wave_sync();
  }
}

template <bool DIAG>
DI void d_weights(f32x16 (&z)[2], float& cum, int j, int qpos, int hi) {
  f32x16 sp[2]; float bs[8], ob[8];
#pragma unroll
  for (int kh = 0; kh < 2; ++kh)
#pragma unroll
    for (int g4 = 0; g4 < 4; ++g4) { float t = 0.f;
#pragma unroll
      for (int jj = 0; jj < 4; ++jj) { const int i = 4 * g4 + jj; const bool before = !DIAG || (64 * j + 32 * kh + crow(i, hi) < qpos);
        const float v = before ? lg2(1.0f + ex2(z[kh][i])) : 0.f; sp[kh][i] = v; t += v; }
      bs[4 * kh + g4] = t; }
#pragma unroll
  for (int p = 0; p < 8; ++p) ob[p] = __shfl_xor(bs[p], 32);
  float Rr = 0.f, saf[8];
#pragma unroll
  for (int p = 7; p >= 0; --p) { const float ev = hi ? ob[p] : bs[p], od = hi ? bs[p] : ob[p]; saf[p] = Rr + (hi ? 0.f : od); Rr += ev + od; }
#pragma unroll
  for (int kh = 0; kh < 2; ++kh)
#pragma unroll
    for (int g4 = 0; g4 < 4; ++g4) { float e = saf[4 * kh + g4];
#pragma unroll
      for (int jj = 3; jj >= 0; --jj) { const int i = 4 * g4 + jj; const bool before = !DIAG || (64 * j + 32 * kh + crow(i, hi) < qpos);
        const float a = before ? ex2(z[kh][i] - sp[kh][i] - e + cum) : 0.f; e += sp[kh][i]; z[kh][i] = a; } }
  cum -= Rr;
}
struct AttnParams { const bf16_t* P; const bf16_t* Vt; bf16_t* Y; const float* biasL; float negM; float lam; float oscale; const float* cgain; };
constexpr int NCH = 1;
template <int MODE>
DI void attn_unit(unsigned char* lds, const AttnParams& ap, int b, int h, int qb, int tid) {
  LAUNDER(tid);
  const int wave = tid >> 6, lane = tid & 63, r32 = lane & 31, hi = lane >> 5, bh = b * 4 + h;
  constexpr int qcol0 = (MODE == 0) ? C_AQ : (MODE == 1) ? C_CQ : C_DQ, kcol0 = (MODE == 0) ? C_AK : (MODE == 1) ? C_CK : C_DK, ycol0 = (MODE == 0) ? 0 : (MODE == 1) ? 512 : 768;
  const bf16_t* Vt = ap.Vt + (size_t)((MODE == 0) ? 0 : (MODE == 1) ? 2 : 3) * T_ * 256;
  const size_t tokb = (size_t)b * SEQ;
  const int qpos = qb * 256 + wave * 32 + r32, cw = qb * 4 + (wave >> 1);
  bf16x8 qf[4];
  { const bf16_t* qp = ap.P + (tokb + qpos) * PLD + qcol0 + h * 64 + 8 * hi;
#pragma unroll
    for (int ks = 0; ks < 4; ++ks) qf[ks] = *(const bf16x8*)(qp + 16 * ks); }
  bf16_t* Ks0 = (bf16_t*)lds; bf16_t* Vs0 = Ks0 + NCH * 64 * 72; volatile int* flags = (volatile int*)(lds + 2 * NCH * 64 * 72 * 2);
  const int jhi = 4 * qb + 3, jlo = (MODE == 0) ? ((4 * qb - 8 > 0) ? 4 * qb - 8 : 0) : 0, ntiles = jhi - jlo + 1;
  const int lrow = tid >> 3, lch = tid & 7;
  const bf16_t* kg = ap.P + (tokb + lrow) * PLD + kcol0 + h * 64 + 8 * lch;
  const bf16_t* vg = Vt + (size_t)bh * 256 * 4096 + lrow * 64 + 8 * lch;
  const int j0 = (MODE == 2) ? jhi : jlo;
  u32x4 kreg[NCH], vreg[NCH];
#pragma unroll
  for (int c = 0; c < NCH; ++c) { const int jc = (MODE == 2) ? j0 - c : j0 + c; kreg[c] = *(const u32x4*)(kg + (size_t)jc * 64 * PLD); vreg[c] = *(const u32x4*)(vg + (size_t)jc * 4096); }
  f32x16 O0[2], O1[2]; float l0 = 0.f, l1 = 0.f, cum = 0.f;
#pragma unroll
  for (int eb = 0; eb < 2; ++eb) { O0[eb] = splat16(0.f); O1[eb] = splat16(0.f); }
  bool wdone = false;
  if (MODE == 2 && D_EARLY) { if (tid < 8) flags[tid] = 0; }
  for (int n = 0; n < ntiles; n += NCH) {
    const int jb = (MODE == 2) ? jhi - n : jlo + n;
    __syncthreads();
    if (MODE == 2 && D_EARLY) { int alld = 1;
#pragma unroll
      for (int w = 0; w < 8; ++w) alld &= flags[w];
      if (alld) break; }
#pragma unroll
    for (int c = 0; c < NCH; ++c) { *(u32x4*)(Ks0 + (c * 64 + lrow) * 72 + 8 * lch) = kreg[c]; *(u32x4*)(Vs0 + (c * 64 + lrow) * 72 + 8 * lch) = vreg[c]; }
    __syncthreads();
    if (n + NCH < ntiles) {
#pragma unroll
      for (int c = 0; c < NCH; ++c) { const int jn = (MODE == 2) ? jb - NCH - c : jb + NCH + c; kreg[c] = *(const u32x4*)(kg + (size_t)jn * 64 * PLD); vreg[c] = *(const u32x4*)(vg + (size_t)jn * 4096); } }
#pragma unroll
    for (int c = 0; c < NCH; ++c) {
    const int j = (MODE == 2) ? jb - c : jb + c;
    const bf16_t* Ks = Ks0 + c * 64 * 72; const bf16_t* Vs = Vs0 + c * 64 * 72;
    const bool active = (j <= cw) && (MODE != 0 || j >= cw - 8);
    if (!active) continue;
    if (MODE == 2 && D_EARLY && wdone) continue;
    if (MODE == 1) {
#pragma unroll
      for (int kh = 0; kh < 2; ++kh) {
        const bf16_t* kb = Ks + (32 * kh + r32) * 72 + 8 * hi;
        bf16x8 p0[2], p1[2];
        { f32x16 s0 = splat16(ap.negM);
          s0 = MFMA32(*(const bf16x8*)(kb), qf[0], s0); s0 = MFMA32(*(const bf16x8*)(kb + 16), qf[1], s0);
#pragma unroll
          for (int i = 0; i < 16; ++i) { s0[i] = ex2(s0[i]); l0 += s0[i]; }
          p0[0] = pack8(s0, 0); p0[1] = pack8(s0, 1); }
        { f32x16 s1 = splat16(ap.negM);
          s1 = MFMA32(*(const bf16x8*)(kb + 32), qf[2], s1); s1 = MFMA32(*(const bf16x8*)(kb + 48), qf[3], s1);
#pragma unroll
          for (int i = 0; i < 16; ++i) { s1[i] = ex2(s1[i]); l1 += s1[i]; }
          p1[0] = pack8(s1, 0); p1[1] = pack8(s1, 1); }
#pragma unroll
        for (int kk = 0; kk < 2; ++kk) {
#pragma unroll
          for (int eb = 0; eb < 2; ++eb) { const bf16_t* vb = Vs + (32 * eb + r32) * 72 + 32 * kh + 16 * kk + 8 * hi; const bf16x8 vf = *(const bf16x8*)vb;
            O0[eb] = MFMA32(vf, p0[kk], O0[eb]); O1[eb] = MFMA32(vf, p1[kk], O1[eb]); } }
      }
    } else if (MODE == 0) {
      const int dch = cw - j; const float binit = ap.negM + ((dch >= 3) ? ap.biasL[256] : 0.f);
#pragma unroll
      for (int kh = 0; kh < 2; ++kh) {
        const bf16_t* kb = Ks + (32 * kh + r32) * 72 + 8 * hi;
        f32x16 s0 = splat16(binit);
#pragma unroll
        for (int ks = 0; ks < 4; ++ks) s0 = MFMA32(*(const bf16x8*)(kb + 16 * ks), qf[ks], s0);
        if (dch < 3) {
#pragma unroll
          for (int i = 0; i < 16; ++i) { int rel = qpos - (64 * j + 32 * kh + crow(i, hi)); rel = rel > 128 ? 128 : (rel < -128 ? -128 : rel); s0[i] += ap.biasL[rel + 128]; } }
#pragma unroll
        for (int i = 0; i < 16; ++i) { s0[i] = ex2(s0[i]); l0 += s0[i]; }
#pragma unroll
        for (int kk = 0; kk < 2; ++kk) { const bf16x8 p0 = pack8(s0, kk);
#pragma unroll
          for (int eb = 0; eb < 2; ++eb) { const bf16_t* vb = Vs + (32 * eb + r32) * 72 + 32 * kh + 16 * kk + 8 * hi; const bf16x8 vf = *(const bf16x8*)vb;
            O0[eb] = MFMA32(vf, p0, O0[eb]); } }
      }
    } else {
      f32x16 z[2];
#pragma unroll
      for (int kh = 0; kh < 2; ++kh) { const bf16_t* kb = Ks + (32 * kh + r32) * 72 + 8 * hi; z[kh] = splat16(0.f);
#pragma unroll
        for (int ks = 0; ks < 4; ++ks) z[kh] = MFMA32(*(const bf16x8*)(kb + 16 * ks), qf[ks], z[kh]); }
      if (j == cw) d_weights<true>(z, cum, j, qpos, hi); else d_weights<false>(z, cum, j, qpos, hi);
#pragma unroll
      for (int kh = 0; kh < 2; ++kh)
#pragma unroll
        for (int kk = 0; kk < 2; ++kk) { const bf16x8 p0 = pack8(z[kh], kk);
#pragma unroll
          for (int eb = 0; eb < 2; ++eb) { const bf16_t* vb = Vs + (32 * eb + r32) * 72 + 32 * kh + 16 * kk + 8 * hi; const bf16x8 vf = *(const bf16x8*)vb;
            O0[eb] = MFMA32(vf, p0, O0[eb]); } }
      if (D_EARLY) { const int done = __all(cum <= -151.0f); if (lane == 0) flags[wave] = done; wdone = (done != 0); }
    }
    }
  }
  bf16_t* yo = ap.Y + (tokb + qpos) * DM + ycol0 + h * 64;
  if (MODE == 0) { l0 += __shfl_xor(l0, 32); const float inv = 1.0f / l0;
#pragma unroll
    for (int eb = 0; eb < 2; ++eb)
#pragma unroll
      for (int i = 0; i < 16; ++i) O0[eb][i] *= inv;
  } else if (MODE == 1) { l0 += __shfl_xor(l0, 32); l1 += __shfl_xor(l1, 32); const float i0 = 1.0f / l0, i1 = ap.lam / l1; float ss = 0.f;
#pragma unroll
    for (int eb = 0; eb < 2; ++eb)
#pragma unroll
      for (int i = 0; i < 16; ++i) { const float o = O0[eb][i] * i0 - O1[eb][i] * i1; O0[eb][i] = o; ss += o * o; }
    ss += __shfl_xor(ss, 32); const float rstd = rsqrtf(ss * (1.f / 64.f) + EPS_) * ap.oscale;
#pragma unroll
    for (int eb = 0; eb < 2; ++eb)
#pragma unroll
      for (int i = 0; i < 16; ++i) O0[eb][i] *= rstd * ap.cgain[32 * eb + crow(i, hi)];
  }
#pragma unroll
  for (int eb = 0; eb < 2; ++eb)
#pragma unroll
    for (int g4 = 0; g4 < 4; ++g4) { u32x2 ow; ow.x = pk2(O0[eb][4 * g4], O0[eb][4 * g4 + 1]); ow.y = pk2(O0[eb][4 * g4 + 2], O0[eb][4 * g4 + 3]); *(u32x2*)(yo + 32 * eb + 8 * g4 + 4 * hi) = ow; }
}

struct MixParams { AttnParams ap; float* DC; float* SC; const float* relb; const float *aqg, *akg, *cqg, *ckg, *clam, *cog; float lam_init; unsigned* ctr; };
DI void mix_phase(unsigned char* lds, const MixParams& mp, int tid) {
  LAUNDER(tid);
  volatile int* misc = (volatile int*)(lds + pg8::STAGE_BYTES);
  float* biasT = (float*)(lds + 81920);
  float* red = (float*)(lds + 81920 + 4 * 260 * 4);
  for (int i = tid; i < 4 * 257; i += 512) biasT[(i / 257) * 260 + (i % 257)] = mp.relb[i] * LOG2E;
  if (tid < 64) {
    const int lane = tid;
    const float aq = wave_max(fabsf(mp.aqg[lane])), ak = wave_max(fabsf(mp.akg[lane]));
    const float cq = wave_max(fabsf(mp.cqg[lane & 31])), ck = wave_max(fabsf(mp.ckg[lane & 31]));
    const float d1 = wave_sum(lane < 32 ? mp.clam[lane] * mp.clam[32 + lane] : 0.f), d2 = wave_sum(lane < 32 ? mp.clam[64 + lane] * mp.clam[96 + lane] : 0.f);
    if (lane == 0) { red[0] = 8.0f * aq * ak * LOG2E * 1.02f; red[1] = 5.656854249f * cq * ck * LOG2E * 1.02f; red[2] = fexp(d1) - fexp(d2) + mp.lam_init; }
  }
  __syncthreads();
  if (tid < 256) { const int hh = tid >> 6, ln = tid & 63; float m = -1e30f;
#pragma unroll
    for (int i = 0; i < 5; ++i) { const int e = ln + 64 * i; if (e < 257) m = fmaxf(m, biasT[hh * 260 + e]); }
    m = wave_max(m); if (ln == 0) red[4 + hh] = m; }
  __syncthreads();
  const float MA = red[0], MC = red[1], lam = red[2];
  AttnParams ap = mp.ap;
  for (;;) {
    __syncthreads();
    if (tid == 0) misc[0] = (int)atomicAdd(mp.ctr, 1u);
    __syncthreads();
    const int it = misc[0];
    constexpr int NB2 = 17;
    if (it >= NB2 + 3 * 512) break;
    if (it < NB2) { b2_item(mp.DC, mp.SC, it, lds, tid); continue; }
    const int r = (it - NB2) & 511, kind = (it - NB2) >> 9, qb = 63 - (r >> 3), bh = r & 7, b = bh >> 2, h = bh & 3;
    if (kind == 0) { ap.negM = -MC; ap.lam = lam; ap.oscale = 1.0f - mp.lam_init; ap.cgain = mp.cog; attn_unit<1>(lds, ap, b, h, qb, tid); }
    else if (kind == 1) { attn_unit<2>(lds, ap, b, h, qb, tid); }
    else { ap.negM = -(MA + red[4 + h]); ap.biasL = biasT + h * 260; attn_unit<0>(lds, ap, b, h, qb, tid); }
  }
}

DI const float* ldp(const unsigned char* lds, int i) {
  const volatile __attribute__((address_space(3))) unsigned* t = (const volatile __attribute__((address_space(3))) unsigned*)(lds + pg8::STAGE_BYTES + 64);
  const unsigned lo = __builtin_amdgcn_readfirstlane(t[2 * i]), hi = __builtin_amdgcn_readfirstlane(t[2 * i + 1]);
  return (const float*)(const __attribute__((address_space(1))) float*)(((unsigned long long)hi << 32) | lo); }
DI int fresh_tid(int wave_s) { int lane; asm volatile("v_mbcnt_lo_u32_b32 %0, -1, 0\n\tv_mbcnt_hi_u32_b32 %0, -1, %0" : "=v"(lane)); return wave_s * 64 + lane; }

DI void gbar(unsigned* bw, unsigned& k, int tid) {
  ++k;
  asm volatile("s_waitcnt vmcnt(0)" ::: "memory");
  __syncthreads();
  if (tid == 0) {
    __builtin_amdgcn_fence(__ATOMIC_RELEASE, "agent");
    const unsigned G = gridDim.x, x = blockIdx.x & 7u, nloc = (G - x + 7u) >> 3, ngrp = G < 8u ? G : 8u;
    unsigned* xcnt = bw + 64 * x; unsigned* xgen = bw + 64 * (8 + x); unsigned* top = bw + 64 * 16; unsigned* topgen = bw + 64 * 17;
    const unsigned old = __hip_atomic_fetch_add(xcnt, 1u, __ATOMIC_RELAXED, __HIP_MEMORY_SCOPE_AGENT);
    if (old + 1u == k * nloc) {
      const unsigned o2 = __hip_atomic_fetch_add(top, 1u, __ATOMIC_RELAXED, __HIP_MEMORY_SCOPE_AGENT);
      if (o2 + 1u == k * ngrp) __hip_atomic_store(topgen, k, __ATOMIC_RELAXED, __HIP_MEMORY_SCOPE_AGENT);
      else while (__hip_atomic_load(topgen, __ATOMIC_RELAXED, __HIP_MEMORY_SCOPE_AGENT) < k) __builtin_amdgcn_s_sleep(1);
      __hip_atomic_store(xgen, k, __ATOMIC_RELAXED, __HIP_MEMORY_SCOPE_AGENT);
    } else {
      while (__hip_atomic_load(xgen, __ATOMIC_RELAXED, __HIP_MEMORY_SCOPE_AGENT) < k) __builtin_amdgcn_s_sleep(1);
    }
    __builtin_amdgcn_fence(__ATOMIC_ACQUIRE, "agent");
  }
  __syncthreads();
}
#define WSP(off) ((unsigned char*)ldp(lds, 24) + (off))
__global__ void __launch_bounds__(512) fwd_kernel(Args a) {
  extern __shared__ __attribute__((aligned(16))) unsigned char lds[];
  cg::grid_group grid = cg::this_grid();
  const int wave_s = __builtin_amdgcn_readfirstlane(threadIdx.x >> 6);
  if (threadIdx.x == 0) {
    const float** t = (const float**)(lds + pg8::STAGE_BYTES + 64);
#pragma unroll
    for (int i = 0; i < 23; ++i) t[i] = a.in[i];
    t[23] = a.out; t[24] = (const float*)a.ws;
  }
  if (blockIdx.x == 0) { unsigned* ctl = (unsigned*)(a.ws + WS_CTL); for (int i = threadIdx.x; i < 2048; i += 512) ctl[i] = 0u; }
  __syncthreads();
  unsigned bk = 0u;
  PG8_LAS unsigned char* ldsL = (PG8_LAS unsigned char*)lds;
  typedef pg8::StaticOrder SO;

  { Args a2;
#pragma unroll
    for (int i = 0; i < 23; ++i) a2.in[i] = ldp(lds, i);
    a2.out = nullptr; a2.ws = WSP(0);
    prologue_weights(a2, lds, fresh_tid(wave_s)); }
  cast_phase(ldp(lds, 0), (bf16_t*)WSP(WS_XN), (float*)WSP(WS_SS), fresh_tid(wave_s));
  grid.sync();
  for (int l = 0; l < NLAYER; ++l) {
    const size_t wlo = WS_W + (size_t)l * LW_SIZE;
    { const float* xin = (l == 0) ? ldp(lds, 0) : ldp(lds, 23); (void)xin;
      pg8::Gemm g{(bf16_t*)WSP(WS_XN), (const bf16_t*)WSP(wlo + LW_WGU1), T_, 2 * FF, DM}; SO S; S.init(T_, 2 * FF, gridDim.x, blockIdx.x); pg8::EpiSwiGLU E{(bf16_t*)WSP(WS_HP), FF, (const float*)WSP(WS_SS) + (size_t)(3 * l) * T_};
      pg8::gemm_phase<pg8::EpiSwiGLU, SO, true, true>(ldsL, g, S, E, fresh_tid(wave_s)); }
    gbar((unsigned*)WSP(WS_CTL) + 64, bk, fresh_tid(wave_s));
    { const float* xin = (l == 0) ? ldp(lds, 0) : ldp(lds, 23);
      pg8::Gemm g{(bf16_t*)WSP(WS_HP), (const bf16_t*)WSP(wlo + LW_WD1), T_, DM, FF}; SO S; S.init(T_, DM, gridDim.x, blockIdx.x); pg8::EpiResid E{xin, (float*)ldp(lds, 23), DM, 0.5f, (bf16_t*)WSP(WS_XN), (float*)WSP(WS_SS) + (size_t)(3 * l + 1) * T_};
      pg8::gemm_phase<pg8::EpiResid, SO, true, true>(ldsL, g, S, E, fresh_tid(wave_s)); }
    gbar((unsigned*)WSP(WS_CTL) + 64, bk, fresh_tid(wave_s));
    { pg8::Gemm g{(bf16_t*)WSP(WS_XN), (const bf16_t*)WSP(wlo + LW_WIN), T_, INP, DM}; SO S; S.init(T_, INP, gridDim.x, blockIdx.x); pg8::EpiBf16Lim E{(bf16_t*)WSP(WS_HP), PLD, PLD, (const float*)WSP(WS_SS) + (size_t)(3 * l + 1) * T_};
      pg8::gemm_phase<pg8::EpiBf16Lim, SO, true, true>(ldsL, g, S, E, fresh_tid(wave_s)); }
    gbar((unsigned*)WSP(WS_CTL) + 64, bk, fresh_tid(wave_s));
    { PrepParams pp{ldp(lds, 7) + l * 64, ldp(lds, 8) + l * 64, ldp(lds, 14) + l * 32, ldp(lds, 15) + l * 32, ldp(lds, 10) + l * 2048, ldp(lds, 11) + l * 512};
      prep_phase((bf16_t*)WSP(WS_HP), (bf16_t*)WSP(WS_BQ), (bf16_t*)WSP(WS_BK), (bf16_t*)WSP(WS_BKT), (bf16_t*)WSP(WS_VT), pp, lds, fresh_tid(wave_s)); }
    gbar((unsigned*)WSP(WS_CTL) + 64, bk, fresh_tid(wave_s));
    b1_phase((bf16_t*)WSP(WS_HP), (bf16_t*)WSP(WS_BKT), (bf16_t*)WSP(WS_VT) + (size_t)T_ * 256, (float*)WSP(WS_DC), (float*)WSP(WS_SC), ldp(lds, 12) + l * 8, lds, fresh_tid(wave_s));
    gbar((unsigned*)WSP(WS_CTL) + 64, bk, fresh_tid(wave_s));
    { const float lam_init = (l == 0) ? 0.2f : (0.8f - 0.6f * 0.7408182206817179f);
      MixParams mp; mp.ap.P = (bf16_t*)WSP(WS_HP); mp.ap.Vt = (bf16_t*)WSP(WS_VT); mp.ap.Y = (bf16_t*)WSP(WS_XN); mp.ap.biasL = nullptr; mp.ap.negM = 0.f; mp.ap.lam = 0.f; mp.ap.oscale = 1.f; mp.ap.cgain = nullptr;
      mp.DC = (float*)WSP(WS_DC); mp.SC = (float*)WSP(WS_SC); mp.relb = ldp(lds, 9) + l * 4 * 257; mp.aqg = ldp(lds, 7) + l * 64; mp.akg = ldp(lds, 8) + l * 64; mp.cqg = ldp(lds, 14) + l * 32; mp.ckg = ldp(lds, 15) + l * 32;
      mp.clam = ldp(lds, 16) + l * 128; mp.cog = ldp(lds, 17) + l * 64; mp.lam_init = lam_init; mp.ctr = (unsigned*)WSP(WS_CTL) + l;
      mix_phase(lds, mp, fresh_tid(wave_s)); }
    gbar((unsigned*)WSP(WS_CTL) + 64, bk, fresh_tid(wave_s));
    b3_phase((bf16_t*)WSP(WS_HP), (bf16_t*)WSP(WS_BQ), (bf16_t*)WSP(WS_BK), (bf16_t*)WSP(WS_VT) + (size_t)T_ * 256, (float*)WSP(WS_DC), (float*)WSP(WS_SC), ldp(lds, 12) + l * 8, ldp(lds, 13) + l * 256, (bf16_t*)WSP(WS_XN), lds, fresh_tid(wave_s));
    gbar((unsigned*)WSP(WS_CTL) + 64, bk, fresh_tid(wave_s));
    { float* xo = (float*)ldp(lds, 23);
      pg8::Gemm g{(bf16_t*)WSP(WS_XN), (const bf16_t*)WSP(wlo + LW_WOUT), T_, DM, DM}; SO S; S.init(T_, DM, gridDim.x, blockIdx.x); pg8::EpiResid E{xo, xo, DM, 1.0f, (bf16_t*)WSP(WS_BQ), (float*)WSP(WS_SS) + (size_t)(3 * l + 2) * T_};
      pg8::gemm_phase<pg8::EpiResid, SO, true, true>(ldsL, g, S, E, fresh_tid(wave_s)); }
    gbar((unsigned*)WSP(WS_CTL) + 64, bk, fresh_tid(wave_s));
    { pg8::Gemm g{(bf16_t*)WSP(WS_BQ), (const bf16_t*)WSP(wlo + LW_WGU2), T_, 2 * FF, DM}; SO S; S.init(T_, 2 * FF, gridDim.x, blockIdx.x); pg8::EpiSwiGLU E{(bf16_t*)WSP(WS_HP), FF, (const float*)WSP(WS_SS) + (size_t)(3 * l + 2) * T_};
      pg8::gemm_phase<pg8::EpiSwiGLU, SO, true, true>(ldsL, g, S, E, fresh_tid(wave_s)); }
    gbar((unsigned*)WSP(WS_CTL) + 64, bk, fresh_tid(wave_s));
    { float* xo = (float*)ldp(lds, 23);
      pg8::Gemm g{(bf16_t*)WSP(WS_HP), (const bf16_t*)WSP(wlo + LW_WD2), T_, DM, FF}; SO S; S.init(T_, DM, gridDim.x, blockIdx.x); pg8::EpiResid E{xo, xo, DM, 0.5f, (l + 1 < NLAYER) ? (bf16_t*)WSP(WS_XN) : nullptr, (float*)WSP(WS_SS) + (size_t)(3 * l + 3) * T_};
      pg8::gemm_phase<pg8::EpiResid, SO, true, true>(ldsL, g, S, E, fresh_tid(wave_s)); }
    if (l + 1 < NLAYER) gbar((unsigned*)WSP(WS_CTL) + 64, bk, fresh_tid(wave_s));
  }
}

extern "C" void kernel_launch(void* const* d_in, const int* in_sizes, int n_in, void* d_out, int out_size, void* d_ws, size_t ws_size, hipStream_t stream) {
  static int grid = 0;
  if (grid == 0) {
    if (n_in != 23 || out_size != T_ * DM || ws_size < WS_END) { fprintf(stderr, "kernel_launch: unexpected problem (n_in %d out %d ws %zu need %zu)\n", n_in, out_size, ws_size, (size_t)WS_END); grid = -1; return; }
    int dev = 0, cus = 0, per_cu = 0;
    hipGetDevice(&dev); hipDeviceGetAttribute(&cus, hipDeviceAttributeMultiprocessorCount, dev);
    if (hipFuncSetAttribute((const void*)fwd_kernel, hipFuncAttributeMaxDynamicSharedMemorySize, LDS_BYTES) != hipSuccess) fprintf(stderr, "kernel_launch: hipFuncSetAttribute failed\n");
    if (hipOccupancyMaxActiveBlocksPerMultiprocessor(&per_cu, (const void*)fwd_kernel, 512, LDS_BYTES) != hipSuccess || per_cu < 1) { fprintf(stderr, "kernel_launch: occupancy query gave %d\n", per_cu); per_cu = 1; }
    (void)hipGetLastError();
    grid = cus * per_cu;
  }
  if (grid < 0) return;
  Args a{};
  for (int i = 0; i < 23; ++i) a.in[i] = (const float*)d_in[i];
  a.out = (float*)d_out; a.ws = (unsigned char*)d_ws;
  void* args[] = {&a};
  hipError_t e = hipLaunchCooperativeKernel((const void*)fwd_kernel, dim3(grid), dim3(512), args, LDS_BYTES, stream);
  if (e != hipSuccess) fprintf(stderr, "cooperative launch failed: %s (grid %d)\n", hipGetErrorString(e), grid);
}
```

```cpp
#include <hip/hip_runtime.h>
#include <hip/hip_cooperative_groups.h>
#include <cstdio>
#include <cstdint>
namespace cg = cooperative_groups;

namespace pg8 {
#define PG8_LAS __attribute__((address_space(3)))
typedef unsigned short bf16_t;
typedef short bf16x8 __attribute__((ext_vector_type(8)));
typedef float f32x4 __attribute__((ext_vector_type(4)));
typedef unsigned u32x4 __attribute__((ext_vector_type(4)));
constexpr int BM = 256, BK = 64, HALF = 128, HTB = HALF * BK * 2  , STAGE_BYTES = 8 * HTB, NXCD = 8, WGM = 4;

__host__ __device__ __forceinline__ int lds_byte(int r, int c) { const int st = (r >> 4) * 2 + (c >> 5), rr = r & 15, cc = c & 31, ob = rr * 64 + cc * 2; return st * 1024 + (ob ^ (((ob >> 9) & 1) << 5)); }
__host__ __device__ __forceinline__ void stage_rc(int b, int& R, int& C) { const int st = b / 1024, sb = b % 1024, swz = sb ^ (((sb >> 9) & 1) << 5); R = (st >> 1) * 16 + swz / 64; C = (st & 1) * 32 + (swz % 64) / 2; }
__host__ __device__ __forceinline__ int perm32(int rho) { const int n = rho >> 4, i = rho & 15; return 8 * (i >> 2) + 4 * n + (i & 3); }

struct Unit { int pm, pn; };
struct Gemm { const bf16_t* A; const bf16_t* Bt; int M, N, K; };

struct StaticOrder {
    int nM, nN, nwg, G, c;
    __host__ __device__ void init(int M, int N, int G_, int c_) { nM = M / BM; nN = N / BM; nwg = nM * nN; G = G_; c = c_; }
    __host__ __device__ bool next(int i, Unit& u) const {
        const long L = (long)i * G + c; if (L >= nwg) return false;
        int wgid = (int)L; { const int q = nwg / NXCD, r = nwg % NXCD, xcd = wgid % NXCD, off = wgid / NXCD; wgid = (xcd < r ? xcd * (q + 1) : r * (q + 1) + (xcd - r) * q) + off; }
        const int nig = WGM * nN, gid = wgid / nig, fm = gid * WGM, gsz = (nM - fm) < WGM ? (nM - fm) : WGM;
        u.pm = fm + ((wgid % nig) % gsz); u.pn = (wgid % nig) / gsz; return true;
    }
    __device__ __forceinline__ void a_ready(const Unit&) const {}
    __device__ __forceinline__ void done(const Unit&) const {}
};


typedef float f32x2_t __attribute__((ext_vector_type(2))); typedef __bf16 bf16x2_t __attribute__((ext_vector_type(2)));
__device__ __forceinline__ unsigned cvt_pk_bf16(float lo, float hi) { f32x2_t v = {lo, hi}; bf16x2_t b = __builtin_convertvector(v, bf16x2_t); return __builtin_bit_cast(unsigned, b); }
__device__ __forceinline__ float silu_f(float x) { return x * __builtin_amdgcn_rcpf(1.0f + __builtin_amdgcn_exp2f(-1.4426950408889634f * x)); }

struct EpiBf16Lim {
    static constexpr bool PERM = true, AFTER_DRAIN = false;
    bf16_t* O; int ldc; int ncols; const float* ss;
    __device__ __forceinline__ void operator()(const f32x4 (&acc)[2][2][4][2], const Unit& u, int wr, int wc, int fr, int fq) const {
        const int row0 = u.pm * BM + wr * 64 + fr; const int col0 = u.pn * BM + wc * 32 + 8 * fq;
        float rsv[2][4];
#pragma unroll
        for (int ai = 0; ai < 2; ++ai)
#pragma unroll
            for (int m = 0; m < 4; ++m) rsv[ai][m] = ss[row0 + ai * HALF + m * 16];
#pragma unroll
        for (int ai = 0; ai < 2; ++ai)
#pragma unroll
            for (int m = 0; m < 4; ++m) { bf16_t* rowp = O + (size_t)(row0 + ai * HALF + m * 16) * ldc + col0;
                const float rs = __builtin_amdgcn_rsqf(rsv[ai][m] * (1.0f / 1024.0f) + 1e-6f);
#pragma unroll
                for (int bj = 0; bj < 2; ++bj) { const f32x4 v0 = acc[ai][bj][m][0] * rs, v1 = acc[ai][bj][m][1] * rs;
                    u32x4 w; w.x = cvt_pk_bf16(v0[0], v0[1]); w.y = cvt_pk_bf16(v0[2], v0[3]); w.z = cvt_pk_bf16(v1[0], v1[1]); w.w = cvt_pk_bf16(v1[2], v1[3]);
                    if (col0 + bj * HALF < ncols) *(u32x4*)(rowp + bj * HALF) = w; } }
    }
};
struct EpiSwiGLU {
    static constexpr bool PERM = true, AFTER_DRAIN = false;
    bf16_t* O; int ldc; const float* ss;
    __device__ __forceinline__ void operator()(const f32x4 (&acc)[2][2][4][2], const Unit& u, int wr, int wc, int fr, int fq) const {
        const int row0 = u.pm * BM + wr * 64 + fr; const int col0 = u.pn * HALF + wc * 32 + 8 * fq;
        float rsv[2][4];
#pragma unroll
        for (int ai = 0; ai < 2; ++ai)
#pragma unroll
            for (int m = 0; m < 4; ++m) rsv[ai][m] = ss[row0 + ai * HALF + m * 16];
#pragma unroll
        for (int ai = 0; ai < 2; ++ai)
#pragma unroll
            for (int m = 0; m < 4; ++m) { bf16_t* rowp = O + (size_t)(row0 + ai * HALF + m * 16) * ldc + col0;
                const float rs = __builtin_amdgcn_rsqf(rsv[ai][m] * (1.0f / 1024.0f) + 1e-6f), c1 = rs * -1.4426950408889634f, c2 = rs * rs;
                const f32x4 g0 = acc[ai][0][m][0], g1 = acc[ai][0][m][1];
                f32x4 e0 = g0 * c1, e1 = g1 * c1;
                const f32x4 p0 = g0 * acc[ai][1][m][0], p1 = g1 * acc[ai][1][m][1];
#pragma unroll
                for (int i = 0; i < 4; ++i) { e0[i] = __builtin_amdgcn_exp2f(e0[i]); e1[i] = __builtin_amdgcn_exp2f(e1[i]); }
                e0 = e0 + 1.0f; e1 = e1 + 1.0f;
#pragma unroll
                for (int i = 0; i < 4; ++i) { e0[i] = __builtin_amdgcn_rcpf(e0[i]); e1[i] = __builtin_amdgcn_rcpf(e1[i]); }
                const f32x4 o0 = p0 * (e0 * c2), o1 = p1 * (e1 * c2);
                u32x4 w; w.x = cvt_pk_bf16(o0[0], o0[1]); w.y = cvt_pk_bf16(o0[2], o0[3]); w.z = cvt_pk_bf16(o1[0], o1[1]); w.w = cvt_pk_bf16(o1[2], o1[3]);
                *(u32x4*)rowp = w; }
    }
};
typedef unsigned u32x2v __attribute__((ext_vector_type(2)));
struct EpiResid {
    static constexpr bool PERM = true, AFTER_DRAIN = false;
    const float* base; float* out; int ldc; float alpha; bf16_t* xb; float* ss;
    __device__ __forceinline__ void operator()(const f32x4 (&acc)[2][2][4][2], const Unit& u, int wr, int wc, int fr, int fq) const {
        const int row0 = u.pm * BM + wr * 64 + fr; const int col0 = u.pn * BM + wc * 32 + 8 * fq;
#pragma unroll
        for (int ai = 0; ai < 2; ++ai) {
            f32x4 pre[4][2][2];
#pragma unroll
            for (int m = 0; m < 4; ++m) { const size_t off = (size_t)(row0 + ai * HALF + m * 16) * ldc + col0;
#pragma unroll
                for (int bj = 0; bj < 2; ++bj)
#pragma unroll
                    for (int n = 0; n < 2; ++n) pre[m][bj][n] = *(const f32x4*)(base + off + bj * HALF + n * 4); }
#pragma unroll
            for (int m = 0; m < 4; ++m) { const size_t off = (size_t)(row0 + ai * HALF + m * 16) * ldc + col0; f32x2_t q2 = {0.f, 0.f};
#pragma unroll
                for (int bj = 0; bj < 2; ++bj) { const f32x4 o0 = pre[m][bj][0] + acc[ai][bj][m][0] * alpha, o1 = pre[m][bj][1] + acc[ai][bj][m][1] * alpha;
                    *(f32x4*)(out + off + bj * HALF) = o0; *(f32x4*)(out + off + bj * HALF + 4) = o1;
                    if (xb) { { const f32x2_t a0 = {o0[0], o0[1]}, a1 = {o0[2], o0[3]}, a2 = {o1[0], o1[1]}, a3 = {o1[2], o1[3]}; q2 = a0 * a0 + q2; q2 = a1 * a1 + q2; q2 = a2 * a2 + q2; q2 = a3 * a3 + q2; }
                        u32x4 w; w.x = cvt_pk_bf16(o0[0], o0[1]); w.y = cvt_pk_bf16(o0[2], o0[3]); w.z = cvt_pk_bf16(o1[0], o1[1]); w.w = cvt_pk_bf16(o1[2], o1[3]); *(u32x4*)(xb + off + bj * HALF) = w; } }
                if (xb) { float q = q2.x + q2.y; q += __shfl_xor(q, 16); q += __shfl_xor(q, 32); if (fq == 0) atomicAdd(ss + row0 + ai * HALF + m * 16, q); } }
        }
    }
};

template <class Epi, class Sched, bool ALIGN_EPI = false, bool SP2 = false>
__device__ __forceinline__ void gemm_phase(PG8_LAS unsigned char* lds, const Gemm g, const Sched& S, const Epi& E, int tid_in) {
    int tid_l = tid_in; asm volatile("" : "+v"(tid_l)); const int tid = tid_l, wid = __builtin_amdgcn_readfirstlane(tid >> 6), lane = tid & 63, wr = wid >> 2, wc = wid & 3, fr = lane & 15, fq = lane >> 4;
    const int K = g.K, nt = K / BK;
    unsigned voffA[2], voffB[2];
#pragma unroll
    for (int i = 0; i < 2; ++i) { int R, C; stage_rc(tid * 16 + i * 8192, R, C); const int Rb = Epi::PERM ? ((R & ~31) + perm32(R & 31)) : R;
        voffA[i] = (unsigned)(R * K + C) * 2u; voffB[i] = (unsigned)(Rb * K + C) * 2u; }
    const size_t kstep = (size_t)(BK * 2);
    const size_t hstep = (size_t)HALF * K * 2;
    const size_t tstep = 2 * hstep;
    const unsigned ldsw = (unsigned)wid * 1024u;
    const int aoff = lds_byte(wr * 64 + fr, fq * 8), boff = lds_byte(wc * 32 + fr, fq * 8);
#define PG8_SA(b, h) (((b) * 2 + (h)) * HTB)
#define PG8_SB(b, h) ((4 + (b) * 2 + (h)) * HTB)
#define PG8_STAGE(bufoff, gbase, voff) do { _Pragma("unroll") for (int _i = 0; _i < 2; ++_i) \
        __builtin_amdgcn_global_load_lds((const unsigned*)((const char*)(gbase) + (voff)[_i]), (PG8_LAS unsigned*)(lds + (bufoff) + ldsw + _i * 8192), 16, 0, 0); } while (0)
#define PG8_LDA(dst, b, h) do { _Pragma("unroll") for (int m = 0; m < 4; ++m) _Pragma("unroll") for (int k = 0; k < 2; ++k) dst[m][k] = *(const PG8_LAS bf16x8*)(lds + PG8_SA(b, h) + aoff + m * 2048 + k * 1024); } while (0)
#define PG8_LDB(dst, b, h) do { _Pragma("unroll") for (int n = 0; n < 2; ++n) _Pragma("unroll") for (int k = 0; k < 2; ++k) dst[n][k] = *(const PG8_LAS bf16x8*)(lds + PG8_SB(b, h) + boff + n * 2048 + k * 1024); } while (0)
#define PG8_MMA(ai, bj, At, Bt) do { __builtin_amdgcn_s_setprio(1); _Pragma("unroll") for (int m = 0; m < 4; ++m) _Pragma("unroll") for (int n = 0; n < 2; ++n) _Pragma("unroll") for (int k = 0; k < 2; ++k) \
        acc[ai][bj][m][n] = __builtin_amdgcn_mfma_f32_16x16x32_bf16(Bt[n][k], At[m][k], acc[ai][bj][m][n], 0, 0, 0); __builtin_amdgcn_s_setprio(0); } while (0)
#define PG8_WAIT_V(n) asm volatile("s_waitcnt vmcnt(" #n ")" ::: "memory")
#define PG8_WAIT_L(n) asm volatile("s_waitcnt lgkmcnt(" #n ")" ::: "memory")
#define PG8_BAR __builtin_amdgcn_s_barrier()
#define PG8_SCHED __builtin_amdgcn_sched_barrier(0)
    Unit cur, nxt; int ui = 0;
    if (!S.next(0, cur)) return;
    f32x4 acc[2][2][4][2];
#pragma unroll
    for (int a = 0; a < 2; ++a)
#pragma unroll
        for (int b = 0; b < 2; ++b)
#pragma unroll
            for (int m = 0; m < 4; ++m)
#pragma unroll
                for (int n = 0; n < 2; ++n) acc[a][b][m][n] = (f32x4){0.f, 0.f, 0.f, 0.f};
    bf16x8 At[4][2], B0[2][2], B1[2][2];
    const char* cA = (const char*)g.A + (size_t)cur.pm * tstep; const char* cB = (const char*)g.Bt + (size_t)cur.pn * tstep;
    S.a_ready(cur);
    if constexpr (SP2) {
        PG8_STAGE(PG8_SB(0, 0), cB, voffB); PG8_STAGE(PG8_SB(0, 1), cB + hstep, voffB); PG8_STAGE(PG8_SA(0, 0), cA, voffA); PG8_STAGE(PG8_SA(0, 1), cA + hstep, voffA);
        if (wr == 1) PG8_BAR;
        PG8_WAIT_V(2); PG8_BAR;
        PG8_STAGE(PG8_SB(1, 0), cB + kstep, voffB); PG8_STAGE(PG8_SA(1, 0), cA + kstep, voffA); PG8_STAGE(PG8_SB(1, 1), cB + hstep + kstep, voffB);
        PG8_WAIT_V(6); PG8_BAR;
    } else {
        PG8_STAGE(PG8_SB(0, 0), cB, voffB); PG8_STAGE(PG8_SA(0, 0), cA, voffA); PG8_STAGE(PG8_SB(0, 1), cB + hstep, voffB); PG8_STAGE(PG8_SA(0, 1), cA + hstep, voffA);
        if (wr == 1) PG8_BAR;
        PG8_WAIT_V(4); PG8_BAR;
        PG8_STAGE(PG8_SB(1, 0), cB + kstep, voffB); PG8_STAGE(PG8_SA(1, 0), cA + kstep, voffA); PG8_STAGE(PG8_SB(1, 1), cB + hstep + kstep, voffB);
        PG8_WAIT_V(6); PG8_BAR;
    }
    for (;;) {
        const bool has_next = S.next(ui + 1, nxt);
        const char* nA = has_next ? (const char*)g.A + (size_t)nxt.pm * tstep : cA; const char* nB = has_next ? (const char*)g.Bt + (size_t)nxt.pn * tstep : cB;
        for (int t = 0; t < nt; t += 2) {
            const bool last = (t == nt - 2);
            const char* a1 = cA + (size_t)(t + 1) * kstep;
            const char* a2 = last ? nA : cA + (size_t)(t + 2) * kstep; const char* b2 = last ? nB : cB + (size_t)(t + 2) * kstep;
            const char* a3 = a2 + kstep; const char* b3 = b2 + kstep;
            if (last && has_next) S.a_ready(nxt);
            if constexpr (SP2) {
            PG8_LDB(B0, 0, 0); PG8_LDB(B1, 0, 1); PG8_SCHED; PG8_LDA(At, 0, 0); PG8_STAGE(PG8_SA(1, 1), a1 + hstep, voffA);
            PG8_WAIT_V(8); PG8_WAIT_L(0); PG8_BAR; PG8_MMA(0, 0, At, B0); PG8_MMA(0, 1, At, B1); PG8_BAR; PG8_SCHED;
            PG8_LDA(At, 0, 1); PG8_STAGE(PG8_SB(0, 0), b2, voffB); PG8_STAGE(PG8_SB(0, 1), b2 + hstep, voffB); PG8_STAGE(PG8_SA(0, 0), a2, voffA);
            PG8_WAIT_V(8); PG8_WAIT_L(0); PG8_BAR; PG8_MMA(1, 0, At, B0); PG8_MMA(1, 1, At, B1); PG8_BAR; PG8_SCHED;
            PG8_LDB(B0, 1, 0); PG8_LDB(B1, 1, 1); PG8_SCHED; PG8_LDA(At, 1, 0); PG8_STAGE(PG8_SA(0, 1), a2 + hstep, voffA);
            PG8_WAIT_V(8); PG8_WAIT_L(0); PG8_BAR; PG8_MMA(0, 0, At, B0); PG8_MMA(0, 1, At, B1); PG8_BAR; PG8_SCHED;
            PG8_LDA(At, 1, 1); PG8_STAGE(PG8_SB(1, 0), b3, voffB); PG8_STAGE(PG8_SB(1, 1), b3 + hstep, voffB); PG8_STAGE(PG8_SA(1, 0), a3, voffA);
            PG8_WAIT_V(8); PG8_WAIT_L(0); PG8_BAR; PG8_MMA(1, 0, At, B0); PG8_MMA(1, 1, At, B1); PG8_BAR; PG8_SCHED;
            } else {
            PG8_LDB(B0, 0, 0); PG8_SCHED; PG8_LDA(At, 0, 0); PG8_STAGE(PG8_SA(1, 1), a1 + hstep, voffA);
            PG8_WAIT_L(8); PG8_BAR; PG8_WAIT_L(0); PG8_MMA(0, 0, At, B0); PG8_BAR; PG8_SCHED;
            PG8_LDB(B1, 0, 1); PG8_STAGE(PG8_SB(0, 0), b2, voffB);
            PG8_BAR; PG8_WAIT_L(0); PG8_MMA(0, 1, At, B1); PG8_BAR;
            PG8_LDA(At, 0, 1); PG8_STAGE(PG8_SA(0, 0), a2, voffA);
            PG8_BAR; PG8_WAIT_L(0); PG8_MMA(1, 0, At, B0); PG8_BAR; PG8_SCHED;
            PG8_STAGE(PG8_SB(0, 1), b2 + hstep, voffB);
            PG8_WAIT_V(6); PG8_BAR; PG8_MMA(1, 1, At, B1); PG8_BAR;
            PG8_LDB(B0, 1, 0); PG8_SCHED; PG8_LDA(At, 1, 0); PG8_STAGE(PG8_SA(0, 1), a2 + hstep, voffA);
            PG8_WAIT_L(8); PG8_BAR; PG8_WAIT_L(0); PG8_MMA(0, 0, At, B0); PG8_BAR; PG8_SCHED;
            PG8_LDB(B1, 1, 1); PG8_STAGE(PG8_SB(1, 0), b3, voffB);
            PG8_BAR; PG8_WAIT_L(0); PG8_MMA(0, 1, At, B1); PG8_BAR;
            PG8_LDA(At, 1, 1); PG8_STAGE(PG8_SA(1, 0), a3, voffA);
            PG8_BAR; PG8_WAIT_L(0); PG8_MMA(1, 0, At, B0); PG8_BAR; PG8_SCHED;
            PG8_STAGE(PG8_SB(1, 1), b3 + hstep, voffB);
            PG8_WAIT_V(6); PG8_BAR; PG8_MMA(1, 1, At, B1); PG8_BAR;
            }
        }
        if constexpr (ALIGN_EPI) { if (wr == 0) PG8_BAR; }
        if constexpr (!Epi::AFTER_DRAIN) { E(acc, cur, wr, wc, fr, fq); S.done(cur); }
        if (!has_next) break;
#pragma unroll
        for (int a = 0; a < 2; ++a)
#pragma unroll
            for (int b = 0; b < 2; ++b)
#pragma unroll
                for (int m = 0; m < 4; ++m)
#pragma unroll
                    for (int n = 0; n < 2; ++n) acc[a][b][m][n] = (f32x4){0.f, 0.f, 0.f, 0.f};
        cur = nxt; cA = nA; cB = nB; ++ui;
        if constexpr (ALIGN_EPI) { if (wr == 1) PG8_BAR; }
    }
    PG8_WAIT_V(0);
    if constexpr (!ALIGN_EPI) { if (wr == 0) PG8_BAR; }
    PG8_BAR;
    if constexpr (Epi::AFTER_DRAIN) { E.fused(acc, cur, wr, wc, fr, fq, lds, wid, lane); S.done(cur); }
#undef PG8_SA
#undef PG8_SB
#undef PG8_STAGE
#undef PG8_LDA
#undef PG8_LDB
#undef PG8_MMA
#undef PG8_WAIT_V
#undef PG8_WAIT_L
#undef PG8_BAR
#undef PG8_SCHED
}
}

typedef unsigned short bf16_t;
typedef short bf16x8 __attribute__((ext_vector_type(8)));
typedef short s16x4 __attribute__((ext_vector_type(4)));
typedef float f32x4 __attribute__((ext_vector_type(4)));
typedef float f32x16 __attribute__((ext_vector_type(16)));
typedef unsigned u32x4 __attribute__((ext_vector_type(4)));
typedef unsigned u32x2 __attribute__((ext_vector_type(2)));
#define DI __device__ __forceinline__
#define LAUNDER(x) asm volatile("" : "+v"(x))

constexpr int T_ = 32768, DM = 1024, FF = 2816, SEQ = 16384, NLAYER = 2;
constexpr int INC = 3336, INP = 3584, PLD = 3344;
constexpr int C_AQ = 0, C_AK = 256, C_AV = 512, C_BQ = 768, C_BK = 1024, C_BV = 1280, C_BO = 1536, C_CQ = 1792, C_CK = 2048, C_CV = 2304, C_DQ = 2560, C_DK = 2816, C_DV = 3072, C_GI = 3328, C_GF = 3332;
constexpr float LOG2E = 1.4426950408889634f, EPS_ = 1e-6f;
#ifndef D_EARLY
#define D_EARLY 1
#endif

constexpr size_t SZ_WGU = (size_t)2 * FF * DM * 2, SZ_WD = (size_t)DM * FF * 2, SZ_WIN = (size_t)INP * DM * 2, SZ_WOUT = (size_t)DM * DM * 2;
constexpr size_t LW_WGU1 = 0, LW_WD1 = LW_WGU1 + SZ_WGU, LW_WIN = LW_WD1 + SZ_WD, LW_WOUT = LW_WIN + SZ_WIN, LW_WGU2 = LW_WOUT + SZ_WOUT, LW_WD2 = LW_WGU2 + SZ_WGU, LW_SIZE = LW_WD2 + SZ_WD;
constexpr size_t WS_CTL = 0, WS_W = 8192, WS_XN = WS_W + NLAYER * LW_SIZE, WS_HP = WS_XN + (size_t)T_ * DM * 2, WS_BQ = WS_HP + (size_t)T_ * PLD * 2,
                 WS_BK = WS_BQ + (size_t)T_ * 256 * 2, WS_BKT = WS_BK + (size_t)T_ * 256 * 2, WS_VT = WS_BKT + (size_t)T_ * 256 * 2, WS_DC = WS_VT + (size_t)4 * T_ * 256 * 2,
                 WS_SC = WS_DC + (size_t)8 * 256 * 4160 * 4, WS_SS = WS_SC + 3 * 8 * 256 * 4, WS_END = WS_SS + (size_t)7 * T_ * 4;
static_assert(WS_XN % 256 == 0 && WS_HP % 256 == 0 && WS_BQ % 256 == 0 && WS_DC % 256 == 0 && (size_t)T_ * FF * 2 <= (size_t)T_ * PLD * 2, "ws map");
constexpr int LDS_BYTES = pg8::STAGE_BYTES + 1024;

DI unsigned pk2(float a, float b) { return pg8::cvt_pk_bf16(a, b); }
DI float bf2f(bf16_t h) { return __uint_as_float((unsigned)h << 16); }
DI float bflo(unsigned w) { return __uint_as_float(w << 16); }
DI float bfhi(unsigned w) { return __uint_as_float(w & 0xffff0000u); }
DI float ex2(float x) { return __builtin_amdgcn_exp2f(x); }
DI float lg2(float x) { return __builtin_amdgcn_logf(x); }
DI float rcpf_(float x) { return __builtin_amdgcn_rcpf(x); }
DI int crow(int r, int hi) { return (r & 3) + 8 * (r >> 2) + 4 * hi; }
#define MFMA32(a, b, c) __builtin_amdgcn_mfma_f32_32x32x16_bf16((a), (b), (c), 0, 0, 0)
DI f32x16 splat16(float v) { f32x16 r;
#pragma unroll
  for (int i = 0; i < 16; ++i) r[i] = v; return r; }
DI bf16x8 pack8(const f32x16& s, int kk) {
  u32x4 p; p.x = pk2(s[8 * kk], s[8 * kk + 1]); p.y = pk2(s[8 * kk + 2], s[8 * kk + 3]); p.z = pk2(s[8 * kk + 4], s[8 * kk + 5]); p.w = pk2(s[8 * kk + 6], s[8 * kk + 7]);
  return __builtin_bit_cast(bf16x8, p); }
DI bf16x8 cat4(s16x4 lo, s16x4 hi) { return __builtin_shufflevector(lo, hi, 0, 1, 2, 3, 4, 5, 6, 7); }

struct Args { const float* in[23]; float* out; unsigned char* ws; };

struct TDesc { const float* W0; const float* W1; const float* gk; bf16_t* WT; int kind, K, N, kt, nt; };
DI TDesc tt_decode(const Args& a, int it) {
  constexpr int I_GU = 16 * 88, I_D = 44 * 16, I_IN = 16 * 56, I_OUT = 16 * 16, I_L = 2 * I_GU + 2 * I_D + I_IN + I_OUT;
  const int l = it / I_L; int r = it % I_L; unsigned char* wl = a.ws + WS_W + (size_t)l * LW_SIZE; TDesc d;
  if (r < I_GU) { d.W0 = a.in[2] + (size_t)l * DM * FF; d.W1 = a.in[3] + (size_t)l * DM * FF; d.gk = a.in[1] + l * DM; d.WT = (bf16_t*)(wl + LW_WGU1); d.kind = 0; d.K = DM; d.N = FF; d.kt = r / 88; d.nt = r % 88; return d; } r -= I_GU;
  if (r < I_D) { d.W0 = a.in[4] + (size_t)l * FF * DM; d.W1 = nullptr; d.gk = nullptr; d.WT = (bf16_t*)(wl + LW_WD1); d.kind = 1; d.K = FF; d.N = DM; d.kt = r / 16; d.nt = r % 16; return d; } r -= I_D;
  if (r < I_IN) { d.W0 = a.in[6] + (size_t)l * DM * INC; d.W1 = nullptr; d.gk = a.in[5] + l * DM; d.WT = (bf16_t*)(wl + LW_WIN); d.kind = 2; d.K = DM; d.N = INC; d.kt = r / 56; d.nt = r % 56; return d; } r -= I_IN;
  if (r < I_OUT) { d.W0 = a.in[18] + (size_t)l * DM * DM; d.W1 = nullptr; d.gk = nullptr; d.WT = (bf16_t*)(wl + LW_WOUT); d.kind = 1; d.K = DM; d.N = DM; d.kt = r / 16; d.nt = r % 16; return d; } r -= I_OUT;
  if (r < I_GU) { d.W0 = a.in[20] + (size_t)l * DM * FF; d.W1 = a.in[21] + (size_t)l * DM * FF; d.gk = a.in[19] + l * DM; d.WT = (bf16_t*)(wl + LW_WGU2); d.kind = 0; d.K = DM; d.N = FF; d.kt = r / 88; d.nt = r % 88; return d; } r -= I_GU;
  d.W0 = a.in[22] + (size_t)l * FF * DM; d.W1 = nullptr; d.gk = nullptr; d.WT = (bf16_t*)(wl + LW_WD2); d.kind = 1; d.K = FF; d.N = DM; d.kt = r / 16; d.nt = r % 16; return d;
}
DI void tt_load(const TDesc& d, f32x4 (&v)[2], int tid) {
  const int n4 = tid & 15, np = d.nt * 64 + 4 * n4, k0 = d.kt * 64; const float* src = d.W0; int col;
  if (d.kind == 0) { const int pn = np >> 8, r = np & 255; src = (r < 128) ? d.W0 : d.W1; col = 128 * pn + (r & 127); }
  else if (d.kind == 1) col = np;
  else col = (np < 1792) ? np : (np < 3328) ? np + 8 : (np < 3336) ? 1792 + (np - 3328) : -1;
#pragma unroll
  for (int p = 0; p < 2; ++p) { const int kk = (tid >> 4) + 32 * p;
    v[p] = (col >= 0) ? *(const f32x4*)(src + (size_t)(k0 + kk) * d.N + col) * (d.gk ? d.gk[k0 + kk] : 1.f) : (f32x4){0.f, 0.f, 0.f, 0.f}; }
}
DI void prologue_weights(const Args& a, unsigned char* lds, int tid) {
  LAUNDER(tid);
  constexpr int NI = 6, NITEMS = NLAYER * (2 * 16 * 88 + 2 * 44 * 16 + 16 * 56 + 16 * 16);
  for (int it0 = blockIdx.x; it0 < NITEMS; it0 += NI * gridDim.x) {
    f32x4 v[NI][2]; TDesc d[NI];
#pragma unroll
    for (int q = 0; q < NI; ++q) { const int it = it0 + q * gridDim.x; if (it < NITEMS) { d[q] = tt_decode(a, it); tt_load(d[q], v[q], tid); } }
#pragma unroll
    for (int q = 0; q < NI; ++q) { float* scr = (float*)lds + q * (64 * 65);
#pragma unroll
      for (int p = 0; p < 2; ++p) { float* w = scr + ((tid >> 4) + 32 * p) * 65 + 4 * (tid & 15); w[0] = v[q][p].x; w[1] = v[q][p].y; w[2] = v[q][p].z; w[3] = v[q][p].w; } }
    __syncthreads();
#pragma unroll
    for (int q = 0; q < NI; ++q) { const int it = it0 + q * gridDim.x; if (it < NITEMS) {
      const int n = tid >> 3, kc = tid & 7; const float* sp = (const float*)lds + q * (64 * 65) + (8 * kc) * 65 + n;
      u32x4 o; o.x = pk2(sp[0], sp[65]); o.y = pk2(sp[2 * 65], sp[3 * 65]); o.z = pk2(sp[4 * 65], sp[5 * 65]); o.w = pk2(sp[6 * 65], sp[7 * 65]);
      *(u32x4*)(d[q].WT + (size_t)(d[q].nt * 64 + n) * d[q].K + d[q].kt * 64 + 8 * kc) = o; } }
    __syncthreads();
  }
}

DI float wave_sum(float v) {
#pragma unroll
  for (int o = 1; o < 64; o <<= 1) v += __shfl_xor(v, o);
  return v; }
DI float wave_max(float v) {
#pragma unroll
  for (int o = 1; o < 64; o <<= 1) v = fmaxf(v, __shfl_xor(v, o));
  return v; }
DI void cast_phase(const float* x, bf16_t* xb, float* ss, int tid) {
  LAUNDER(tid);
  const int lane = tid & 63, gw = blockIdx.x * 8 + (tid >> 6), ngw = gridDim.x * 8;
  for (int i = blockIdx.x * 512 + tid; i < 6 * T_; i += gridDim.x * 512) ss[T_ + i] = 0.f;
  for (int m0 = gw; m0 < T_; m0 += 2 * ngw) {
    f32x4 v[2][4];
#pragma unroll
    for (int r = 0; r < 2; ++r) { const int m = m0 + r * ngw; if (m < T_) { const f32x4* xr = (const f32x4*)(x + (size_t)m * DM) + lane;
#pragma unroll
      for (int j = 0; j < 4; ++j) v[r][j] = xr[64 * j]; } }
#pragma unroll
    for (int r = 0; r < 2; ++r) { const int m = m0 + r * ngw; if (m < T_) { float q = 0.f;
#pragma unroll
      for (int j = 0; j < 4; ++j) q += (v[r][j].x * v[r][j].x + v[r][j].y * v[r][j].y) + (v[r][j].z * v[r][j].z + v[r][j].w * v[r][j].w);
      q = wave_sum(q); if (lane == 0) ss[m] = q;
      u32x2* o = (u32x2*)(xb + (size_t)m * DM) + lane;
#pragma unroll
      for (int j = 0; j < 4; ++j) { u32x2 w; w.x = pk2(v[r][j].x, v[r][j].y); w.y = pk2(v[r][j].z, v[r][j].w); o[64 * j] = w; } } }
  }
}

struct PrepParams { const float *aqg, *akg, *cqg, *ckg, *convw, *convb; };
DI void prep_phase(bf16_t* P, bf16_t* BQ, bf16_t* BK, bf16_t* BKt, bf16_t* Vt, const PrepParams& pp, unsigned char* lds, int tid) {
  LAUNDER(tid);
  float* gt = (float*)lds;
  if (tid < 64) { gt[tid] = pp.aqg[tid]; gt[64 + tid] = pp.akg[tid]; gt[128 + tid] = pp.cqg[tid & 31]; gt[192 + tid] = pp.ckg[tid & 31]; gt[256 + tid] = 1.f; }
  __syncthreads();
  for (int tile = blockIdx.x; tile < T_ / 64; tile += gridDim.x) {
    const int tok0 = tile * 64, b = tok0 / SEQ, s0 = tok0 % SEQ;
    for (int id0 = tid; id0 < 64 * 160; id0 += 10 * 512) {
      u32x4 w4[10]; bf16_t* p4[10];
#pragma unroll
      for (int u = 0; u < 10; ++u) { const int id = id0 + 512 * u, tk = id / 160, ci = id % 160, seg = ci >> 5, within = (ci & 31) * 8;
        const int colb = (seg == 0) ? C_AQ : (seg == 1) ? C_AK : (seg == 2) ? C_CQ : (seg == 3) ? C_CK : C_DQ;
        p4[u] = P + (size_t)(tok0 + tk) * PLD + colb + within; w4[u] = *(const u32x4*)p4[u]; }
#pragma unroll
      for (int u = 0; u < 10; ++u) { const int id = id0 + 512 * u, ci = id % 160, seg = ci >> 5, within = (ci & 31) * 8;
        const u32x4 w = w4[u]; float v[8];
        v[0] = bflo(w.x); v[1] = bfhi(w.x); v[2] = bflo(w.y); v[3] = bfhi(w.y); v[4] = bflo(w.z); v[5] = bfhi(w.z); v[6] = bflo(w.w); v[7] = bfhi(w.w);
        float ss = 0.f;
#pragma unroll
        for (int j = 0; j < 8; ++j) ss += v[j] * v[j];
        ss += __shfl_xor(ss, 1); ss += __shfl_xor(ss, 2);
        const float ss32 = ss; ss += __shfl_xor(ss, 4);
        float sc;
        if (seg < 2) { sc = rsqrtf(ss * (1.f / 64.f) + EPS_) * (seg == 0 ? 0.125f * LOG2E : 1.f); }
        else if (seg < 4) { sc = rsqrtf(ss32 * (1.f / 32.f) + EPS_) * (seg == 2 ? 0.17677669529663687f * LOG2E : 1.f); }
        else { sc = 0.125f * LOG2E; }
        const float* gp = gt + seg * 64 + (within & 63);
        const f32x4 ga = *(const f32x4*)gp, gb = *(const f32x4*)(gp + 4);
        u32x4 o; o.x = pk2(v[0] * sc * ga.x, v[1] * sc * ga.y); o.y = pk2(v[2] * sc * ga.z, v[3] * sc * ga.w); o.z = pk2(v[4] * sc * gb.x, v[5] * sc * gb.y); o.w = pk2(v[6] * sc * gb.z, v[7] * sc * gb.w);
        *(u32x4*)p4[u] = o; }
    }
    bf16_t* Lin = (bf16_t*)(lds + 2048); bf16_t* Lout = Lin + 67 * 264;
    u32x4 r[5];
#define PREP_LOAD_GROUP(G) do { const int col0_ = ((G) == 0) ? C_AV : ((G) == 1) ? C_BV : ((G) == 2) ? C_CV : ((G) == 3) ? C_DV : ((G) == 4) ? C_BQ : C_BK; \
      _Pragma("unroll") for (int u = 0; u < 5; ++u) { const int idx = tid + 512 * u, row = idx >> 5, pc = idx & 31, srow = s0 - 3 + row; \
        r[u] = (u32x4){0u, 0u, 0u, 0u}; \
        if (idx < 67 * 32 && srow >= 0) r[u] = *(const u32x4*)(P + (size_t)(b * SEQ + srow) * PLD + col0_ + 8 * pc); } } while (0)
    PREP_LOAD_GROUP(0);
#pragma unroll
    for (int g = 0; g < 6; ++g) {
      __syncthreads();
#pragma unroll
      for (int u = 0; u < 5; ++u) { const int idx = tid + 512 * u, row = idx >> 5, pc = idx & 31; if (idx < 67 * 32) *(u32x4*)(Lin + row * 264 + 8 * pc) = r[u]; }
      __syncthreads();
      if (g + 1 < 6) PREP_LOAD_GROUP(g + 1);
      const int c = tid & 255, th = tid >> 8; const bf16_t* colp = Lin + (32 * th) * 264 + c;
      if (g < 4) {
        unsigned w[16];
#pragma unroll
        for (int q = 0; q < 16; ++q) { const int p = 2 * q, i = (p & ~12) | ((p & 4) << 1) | ((p & 8) >> 1);
          w[q] = (unsigned)colp[(3 + i) * 264] | ((unsigned)colp[(3 + i + 1) * 264] << 16); }
        bf16_t* vd = Vt + (size_t)g * T_ * 256 + (((size_t)(b * 4 + (c >> 6)) * 256 + (s0 >> 6)) * 64 + (c & 63)) * 64 + 32 * th;
#pragma unroll
        for (int q4 = 0; q4 < 4; ++q4) { u32x4 o; o.x = w[4 * q4]; o.y = w[4 * q4 + 1]; o.z = w[4 * q4 + 2]; o.w = w[4 * q4 + 3]; *(u32x4*)(vd + 8 * q4) = o; }
      } else {
        const int cq = (g - 4) * 256 + c;
        const float w0 = pp.convw[cq], w1 = pp.convw[512 + cq], w2 = pp.convw[1024 + cq], w3 = pp.convw[1536 + cq], bb = pp.convb[cq], sc = (g == 4) ? 1.f : 0.125f;
        float x[35];
#pragma unroll
        for (int i = 0; i < 35; ++i) x[i] = bf2f(colp[i * 264]);
        unsigned short yb[32];
#pragma unroll
        for (int i = 0; i < 32; ++i) { const float y = bb + x[i] * w0 + x[i + 1] * w1 + x[i + 2] * w2 + x[i + 3] * w3; yb[i] = (unsigned short)(pk2(pg8::silu_f(y) * sc, 0.f) & 0xffffu); Lout[(32 * th + i) * 264 + c] = yb[i]; }
        if (g == 5) {
          bf16_t* kd = BKt + (((size_t)(b * 4 + (c >> 6)) * 256 + (s0 >> 6)) * 64 + (c & 63)) * 64 + 32 * th;
#pragma unroll
          for (int q4 = 0; q4 < 4; ++q4) { unsigned w[4];
#pragma unroll
            for (int q = 0; q < 4; ++q) { const int p = 2 * (4 * q4 + q), i = (p & ~12) | ((p & 4) << 1) | ((p & 8) >> 1); w[q] = (unsigned)yb[i] | ((unsigned)yb[i + 1] << 16); }
            u32x4 o; o.x = w[0]; o.y = w[1]; o.z = w[2]; o.w = w[3]; *(u32x4*)(kd + 8 * q4) = o; }
        }
        __syncthreads();
        bf16_t* dst = (g == 4) ? BQ : BK;
#pragma unroll
        for (int u = 0; u < 4; ++u) { const int idx = tid + 512 * u, row = idx >> 5, pc = idx & 31; *(u32x4*)(dst + (size_t)(tok0 + row) * 256 + 8 * pc) = *(const u32x4*)(Lout + row * 264 + 8 * pc); }
      }
    }
    __syncthreads();
  }
}

#undef PREP_LOAD_GROUP
DI float wave_scan_add(float v, int lane) {
#pragma unroll
  for (int o = 1; o < 64; o <<= 1) { const float t = __shfl_up(v, o); if (lane >= o) v += t; }
  return v; }
DI float wave_scan_max(float v, int lane) {
#pragma unroll
  for (int o = 1; o < 64; o <<= 1) { const float t = __shfl_up(v, o); if (lane >= o) v = fmaxf(v, t); }
  return v; }
DI float fexp(float x) { return ex2(x * LOG2E); }
DI float log_sigmoid_f(float x) { return fminf(x, 0.f) - lg2(1.0f + fexp(-fabsf(x))) * 0.6931471805599453f; }
DI void lds_wave_sync() { asm volatile("s_waitcnt lgkmcnt(0)" ::: "memory"); __builtin_amdgcn_wave_barrier(); }

DI void b1_phase(const bf16_t* P, const bf16_t* BKt, const bf16_t* VtB, float* DC, float* SC, const float* gate_bias, unsigned char* lds, int tid) {
  LAUNDER(tid);
  const int lane = tid & 63, wave = tid >> 6, r32 = lane & 31, hi = lane >> 5;
  float* wsc = (float*)(lds + wave * 1024);
  for (int item = blockIdx.x * 8 + wave; item < 2048; item += gridDim.x * 8) {
    const int bh = item >> 8, c = item & 255, b = bh >> 2, h = bh & 3, s0 = c * 64; const size_t tok0 = (size_t)b * SEQ + s0;
    const float gf = bf2f(P[(tok0 + lane) * PLD + C_GF + h]) + gate_bias[4 + h], gi = bf2f(P[(tok0 + lane) * PLD + C_GI + h]) + gate_bias[h];
    const float lf = log_sigmoid_f(gf), bcum = wave_scan_add(lf, lane), btot = __shfl(bcum, 63);
    const float g = btot - bcum + gi, mloc = wave_max(g), w = fexp(g - mloc);
    wsc[lane] = w; lds_wave_sync();
    f32x16 acc[2][2];
#pragma unroll
    for (int i = 0; i < 2; ++i)
#pragma unroll
      for (int j = 0; j < 2; ++j) acc[i][j] = splat16(0.f);
    float dn[2] = {0.f, 0.f};
#pragma unroll
    for (int ks = 0; ks < 4; ++ks) {
      const f32x4 wa = *(const f32x4*)(wsc + 16 * ks + 4 * hi), wb = *(const f32x4*)(wsc + 16 * ks + 8 + 4 * hi);
      bf16x8 vf[2], kf[2];
#pragma unroll
      for (int eb = 0; eb < 2; ++eb) {
        vf[eb] = *(const bf16x8*)(VtB + (((size_t)bh * 256 + c) * 64 + 32 * eb + r32) * 64 + 16 * ks + 8 * hi);
        const u32x4 kw = *(const u32x4*)(BKt + (((size_t)bh * 256 + c) * 64 + 32 * eb + r32) * 64 + 16 * ks + 8 * hi);
        const float k0 = bflo(kw.x) * wa.x, k1 = bfhi(kw.x) * wa.y, k2 = bflo(kw.y) * wa.z, k3 = bfhi(kw.y) * wa.w, k4 = bflo(kw.z) * wb.x, k5 = bfhi(kw.z) * wb.y, k6 = bflo(kw.w) * wb.z, k7 = bfhi(kw.w) * wb.w;
        dn[eb] += ((k0 + k1) + (k2 + k3)) + ((k4 + k5) + (k6 + k7));
        u32x4 o; o.x = pk2(k0, k1); o.y = pk2(k2, k3); o.z = pk2(k4, k5); o.w = pk2(k6, k7); kf[eb] = __builtin_bit_cast(bf16x8, o);
      }
#pragma unroll
      for (int eb = 0; eb < 2; ++eb)
#pragma unroll
        for (int db = 0; db < 2; ++db) acc[eb][db] = MFMA32(vf[eb], kf[db], acc[eb][db]);
    }
    float* dc = DC + ((size_t)bh * 256 + c) * 4160;
#pragma unroll
    for (int eb = 0; eb < 2; ++eb)
#pragma unroll
      for (int db = 0; db < 2; ++db)
#pragma unroll
        for (int i = 0; i < 16; ++i) dc[(32 * eb + crow(i, hi)) * 64 + 32 * db + r32] = acc[eb][db][i];
#pragma unroll
    for (int db = 0; db < 2; ++db) { const float t = dn[db] + __shfl_xor(dn[db], 32); if (hi == 0) dc[4096 + 32 * db + r32] = t; }
    if (lane == 0) { SC[bh * 256 + c] = btot; SC[2048 + bh * 256 + c] = mloc; }
    lds_wave_sync();
  }
}

DI void b2_item(float* DC, float* SC, int j, unsigned char* lds, int tid) {
  LAUNDER(tid);
  float* L = (float*)lds;
  const int ge = j * 512 + tid, bh0 = (j * 512) / 1040, bh1 = (j * 512 + 511) / 1040;
  { const int slot = tid >> 8, c = tid & 255, bh = slot ? bh1 : bh0;
    if (bh < 8) { L[slot * 1024 + c] = SC[bh * 256 + c]; L[slot * 1024 + 256 + c] = SC[2048 + bh * 256 + c]; } }
  __syncthreads();
  if ((tid & 63) == 0 && (tid >> 6) < 2) { const int slot = tid >> 6, bh = slot ? bh1 : bh0;
    if (bh < 8 && (slot == 0 || bh1 != bh0)) { float* q = L + slot * 1024; float m = 0.f; const bool wr = (j * 512 <= bh * 1040) && (bh * 1040 < j * 512 + 512);
      for (int c = 0; c < 256; ++c) { const float b = q[c], l = q[256 + c], mn = fmaxf(b + m, l); q[512 + c] = fexp(b + m - mn); q[768 + c] = fexp(l - mn); if (wr) SC[4096 + bh * 256 + c] = m; m = mn; } } }
  __syncthreads();
  if (ge < 8 * 1040) {
    const int bh = ge / 1040, el = (ge % 1040) * 4; const float* q = L + ((bh == bh0) ? 0 : 1024);
    float* p = DC + (size_t)bh * 256 * 4160 + el; float z0 = 0.f; LAUNDER(z0); f32x4 C = {z0, z0, z0, z0};
    for (int c0 = 0; c0 < 256; c0 += 8) {
      f32x4 d[8];
#pragma unroll
      for (int u = 0; u < 8; ++u) d[u] = *(const f32x4*)(p + (size_t)(c0 + u) * 4160);
#pragma unroll
      for (int u = 0; u < 8; ++u) { *(f32x4*)(p + (size_t)(c0 + u) * 4160) = C; C = C * q[512 + c0 + u] + d[u] * q[768 + c0 + u]; }
    }
  }
}

DI void b3_phase(const bf16_t* P, const bf16_t* BQ, const bf16_t* BK, const bf16_t* VtB, const float* DC, const float* SC, const float* gate_bias, const float* onorm, bf16_t* Y, unsigned char* lds, int tid) {
  LAUNDER(tid);
  const int lane = tid & 63, wave = tid >> 6, r32 = lane & 31, hi = lane >> 5;
  float* R = (float*)(lds + wave * 2048); float* MU = R + 64; float* SI = R + 128; float* EM = R + 192; float* NV = R + 256;
  for (int item = blockIdx.x * 8 + wave; item < 2048; item += gridDim.x * 8) {
    const int bh = item >> 8, c = item & 255, b = bh >> 2, h = bh & 3, s0 = c * 64; const size_t tok0 = (size_t)b * SEQ + s0;
    const float* dc = DC + ((size_t)bh * 256 + c) * 4160;
    {
      const float gf = bf2f(P[(tok0 + lane) * PLD + C_GF + h]) + gate_bias[4 + h], gi = bf2f(P[(tok0 + lane) * PLD + C_GI + h]) + gate_bias[h];
      const float lf = log_sigmoid_f(gf), bcum = wave_scan_add(lf, lane), r = gi - bcum, pmax = wave_scan_max(r, lane);
      const float m_in = SC[4096 + bh * 256 + c], mu = fmaxf(m_in, pmax);
      R[lane] = r; MU[lane] = mu; SI[lane] = fexp(m_in - mu); EM[lane] = fexp(-bcum - mu); NV[lane] = dc[4096 + lane];
    }
    lds_wave_sync();
    bf16x8 cfr[2][4];
#pragma unroll
    for (int eb = 0; eb < 2; ++eb)
#pragma unroll
      for (int ks = 0; ks < 4; ++ks) { const float* cp = dc + (32 * eb + r32) * 64 + 16 * ks + 8 * hi; const f32x4 ca = *(const f32x4*)cp, cb = *(const f32x4*)(cp + 4);
        u32x4 o; o.x = pk2(ca.x, ca.y); o.y = pk2(ca.z, ca.w); o.z = pk2(cb.x, cb.y); o.w = pk2(cb.z, cb.w); cfr[eb][ks] = __builtin_bit_cast(bf16x8, o); }
#pragma unroll
    for (int tq = 0; tq < 2; ++tq) {
      const int t = 32 * tq + r32; const float mu_t = MU[t], si_t = SI[t], em_t = EM[t];
      bf16x8 qf[4]; float qn = 0.f;
#pragma unroll
      for (int ks = 0; ks < 4; ++ks) {
        const u32x4 qw = *(const u32x4*)(BQ + (tok0 + t) * 256 + h * 64 + 16 * ks + 8 * hi); qf[ks] = __builtin_bit_cast(bf16x8, qw);
        const f32x4 na = *(const f32x4*)(NV + 16 * ks + 8 * hi), nb = *(const f32x4*)(NV + 16 * ks + 8 * hi + 4);
        qn += bflo(qw.x) * na.x + bfhi(qw.x) * na.y + bflo(qw.y) * na.z + bfhi(qw.y) * na.w + bflo(qw.z) * nb.x + bfhi(qw.z) * nb.y + bflo(qw.w) * nb.z + bfhi(qw.w) * nb.w;
      }
      qn += __shfl_xor(qn, 32);
      f32x16 G[2], num[2];
#pragma unroll
      for (int eb = 0; eb < 2; ++eb) { G[eb] = splat16(0.f); num[eb] = splat16(0.f);
#pragma unroll
        for (int ks = 0; ks < 4; ++ks) G[eb] = MFMA32(cfr[eb][ks], qf[ks], G[eb]); }
      float dsum = 0.f;
#pragma unroll
      for (int tk = 0; tk < 2; ++tk) {
        if (tk <= tq) {
          f32x16 S = splat16(0.f);
#pragma unroll
          for (int ks = 0; ks < 4; ++ks) { const bf16x8 kf = *(const bf16x8*)(BK + (tok0 + 32 * tk + r32) * 256 + h * 64 + 16 * ks + 8 * hi); S = MFMA32(kf, qf[ks], S); }
          asm volatile("" ::: "memory");
#pragma unroll
          for (int g4 = 0; g4 < 4; ++g4) { const f32x4 rv = *(const f32x4*)(R + 32 * tk + 8 * g4 + 4 * hi);
#pragma unroll
            for (int j = 0; j < 4; ++j) { const int s = 32 * tk + 8 * g4 + 4 * hi + j; const float w = (s <= t) ? fexp(rv[j] - mu_t) : 0.f; const float val = S[4 * g4 + j] * w; dsum += val; S[4 * g4 + j] = val; } }
#pragma unroll
          for (int kk = 0; kk < 2; ++kk) { const bf16x8 pf = pack8(S, kk);
#pragma unroll
            for (int eb = 0; eb < 2; ++eb) { const bf16_t* vp = VtB + (((size_t)bh * 256 + c) * 64 + 32 * eb + r32) * 64 + 32 * tk + 16 * kk + 8 * hi;
              const bf16x8 vf = *(const bf16x8*)vp; num[eb] = MFMA32(vf, pf, num[eb]); } }
          asm volatile("" ::: "memory");
        }
      }
      dsum += __shfl_xor(dsum, 32);
      const float den = si_t * qn + dsum, inv = 1.0f / fmaxf(fabsf(den), em_t);
      float ss = 0.f;
#pragma unroll
      for (int eb = 0; eb < 2; ++eb)
#pragma unroll
        for (int i = 0; i < 16; ++i) { const float hv = (num[eb][i] + si_t * G[eb][i]) * inv; num[eb][i] = hv; ss += hv * hv; }
      ss += __shfl_xor(ss, 32);
      const float rstd = rsqrtf(ss * (1.f / 64.f) + EPS_);
      const bf16_t* bo = P + (tok0 + t) * PLD + C_BO + h * 64; bf16_t* yo = Y + (tok0 + t) * DM + 256 + h * 64;
#pragma unroll
      for (int eb = 0; eb < 2; ++eb)
#pragma unroll
        for (int g4 = 0; g4 < 4; ++g4) { const int e = 32 * eb + 8 * g4 + 4 * hi; const u32x2 bw = *(const u32x2*)(bo + e); const f32x4 gn = *(const f32x4*)(onorm + h * 64 + e);
          const float o0 = num[eb][4 * g4] * rstd * gn.x * rcpf_(1.f + fexp(-bflo(bw.x))), o1 = num[eb][4 * g4 + 1] * rstd * gn.y * rcpf_(1.f + fexp(-bfhi(bw.x)));
          const float o2 = num[eb][4 * g4 + 2] * rstd * gn.z * rcpf_(1.f + fexp(-bflo(bw.y))), o3 = num[eb][4 * g4 + 3] * rstd * gn.w * rcpf_(1.f + fexp(-bfhi(bw.y)));
          u32x2 ow; ow.x = pk2(o0, o1); ow.y = pk2(o2, o3); *(u32x2*)(yo + e) = ow; }
    }
    lds_wave_sync();
  }
}

template <bool DIAG>
DI void d_weights(f32x16 (&z)[2], float& cum, int j, int qpos, int hi) {
  f32x16 sp[2]; float bs[8], ob[8];
#pragma unroll
  for (int kh = 0; kh < 2; ++kh)
#pragma unroll
    for (int g4 = 0; g4 < 4; ++g4) { float t = 0.f;
#pragma unroll
      for (int jj = 0; jj < 4; ++jj) { const int i = 4 * g4 + jj; const bool before = !DIAG || (64 * j + 32 * kh + crow(i, hi) < qpos);
        const float v = before ? lg2(1.0f + ex2(z[kh][i])) : 0.f; sp[kh][i] = v; t += v; }
      bs[4 * kh + g4] = t; }
#pragma unroll
  for (int p = 0; p < 8; ++p) ob[p] = __shfl_xor(bs[p], 32);
  float Rr = 0.f, saf[8];
#pragma unroll
  for (int p = 7; p >= 0; --p) { const float ev = hi ? ob[p] : bs[p], od = hi ? bs[p] : ob[p]; saf[p] = Rr + (hi ? 0.f : od); Rr += ev + od; }
#pragma unroll
  for (int kh = 0; kh < 2; ++kh)
#pragma unroll
    for (int g4 = 0; g4 < 4; ++g4) { float e = saf[4 * kh + g4];
#pragma unroll
      for (int jj = 3; jj >= 0; --jj) { const int i = 4 * g4 + jj; const bool before = !DIAG || (64 * j + 32 * kh + crow(i, hi) < qpos);
        const float a = before ? ex2(z[kh][i] - sp[kh][i] - e + cum) : 0.f; e += sp[kh][i]; z[kh][i] = a; } }
  cum -= Rr;
}
struct AttnParams { const bf16_t* P; const bf16_t* Vt; bf16_t* Y; const float* biasL; float negM; float lam; float oscale; const float* cgain; };
constexpr int NCH = 1;
template <int MODE>
DI void attn_unit(unsigned char* lds, const AttnParams& ap, int b, int h, int qb, int tid) {
  LAUNDER(tid);
  const int wave = tid >> 6, lane = tid & 63, r32 = lane & 31, hi = lane >> 5, bh = b * 4 + h;
  constexpr int qcol0 = (MODE == 0) ? C_AQ : (MODE == 1) ? C_CQ : C_DQ, kcol0 = (MODE == 0) ? C_AK : (MODE == 1) ? C_CK : C_DK, ycol0 = (MODE == 0) ? 0 : (MODE == 1) ? 512 : 768;
  const bf16_t* Vt = ap.Vt + (size_t)((MODE == 0) ? 0 : (MODE == 1) ? 2 : 3) * T_ * 256;
  const size_t tokb = (size_t)b * SEQ;
  const int qpos = qb * 256 + wave * 32 + r32, cw = qb * 4 + (wave >> 1);
  bf16x8 qf[4];
  { const bf16_t* qp = ap.P + (tokb + qpos) * PLD + qcol0 + h * 64 + 8 * hi;
#pragma unroll
    for (int ks = 0; ks < 4; ++ks) qf[ks] = *(const bf16x8*)(qp + 16 * ks); }
  bf16_t* Ks0 = (bf16_t*)lds; bf16_t* Vs0 = Ks0 + NCH * 64 * 72; volatile int* flags = (volatile int*)(lds + 2 * NCH * 64 * 72 * 2);
  const int jhi = 4 * qb + 3, jlo = (MODE == 0) ? ((4 * qb - 8 > 0) ? 4 * qb - 8 : 0) : 0, ntiles = jhi - jlo + 1;
  const int lrow = tid >> 3, lch = tid & 7;
  const bf16_t* kg = ap.P + (tokb + lrow) * PLD + kcol0 + h * 64 + 8 * lch;
  const bf16_t* vg = Vt + (size_t)bh * 256 * 4096 + lrow * 64 + 8 * lch;
  const int j0 = (MODE == 2) ? jhi : jlo;
  u32x4 kreg[NCH], vreg[NCH];
#pragma unroll
  for (int c = 0; c < NCH; ++c) { const int jc = (MODE == 2) ? j0 - c : j0 + c; kreg[c] = *(const u32x4*)(kg + (size_t)jc * 64 * PLD); vreg[c] = *(const u32x4*)(vg + (size_t)jc * 4096); }
  f32x16 O0[2], O1[2]; float l0 = 0.f, l1 = 0.f, cum = 0.f;
#pragma unroll
  for (int eb = 0; eb < 2; ++eb) { O0[eb] = splat16(0.f); O1[eb] = splat16(0.f); }
  bool wdone = false;
  if (MODE == 2 && D_EARLY) { if (tid < 8) flags[tid] = 0; }
  for (int n = 0; n < ntiles; n += NCH) {
    const int jb = (MODE == 2) ? jhi - n : jlo + n;
    __syncthreads();
    if (MODE == 2 && D_EARLY) { int alld = 1;
#pragma unroll
      for (int w = 0; w < 8; ++w) alld &= flags[w];
      if (alld) break; }
#pragma unroll
    for (int c = 0; c < NCH; ++c) { *(u32x4*)(Ks0 + (c * 64 + lrow) * 72 + 8 * lch) = kreg[c]; *(u32x4*)(Vs0 + (c * 64 + lrow) * 72 + 8 * lch) = vreg[c]; }
    __syncthreads();
    if (n + NCH < ntiles) {
#pragma unroll
      for (int c = 0; c < NCH; ++c) { const int jn = (MODE == 2) ? jb - NCH - c : jb + NCH + c; kreg[c] = *(const u32x4*)(kg + (size_t)jn * 64 * PLD); vreg[c] = *(const u32x4*)(vg + (size_t)jn * 4096); } }
#pragma unroll
    for (int c = 0; c < NCH; ++c) {
    const int j = (MODE == 2) ? jb - c : jb + c;
    const bf16_t* Ks = Ks0 + c * 64 * 72; const bf16_t* Vs = Vs0 + c * 64 * 72;
    const bool active = (j <= cw) && (MODE != 0 || j >= cw - 8);
    if (!active) continue;
    if (MODE == 2 && D_EARLY && wdone) continue;
    if (MODE == 1) {
#pragma unroll
      for (int kh = 0; kh < 2; ++kh) {
        const bf16_t* kb = Ks + (32 * kh + r32) * 72 + 8 * hi;
        bf16x8 p0[2], p1[2];
        { f32x16 s0 = splat16(ap.negM);
          s0 = MFMA32(*(const bf16x8*)(kb), qf[0], s0); s0 = MFMA32(*(const bf16x8*)(kb + 16), qf[1], s0);
#pragma unroll
          for (int i = 0; i < 16; ++i) { s0[i] = ex2(s0[i]); l0 += s0[i]; }
          p0[0] = pack8(s0, 0); p0[1] = pack8(s0, 1); }
        { f32x16 s1 = splat16(ap.negM);
          s1 = MFMA32(*(const bf16x8*)(kb + 32), qf[2], s1); s1 = MFMA32(*(const bf16x8*)(kb + 48), qf[3], s1);
#pragma unroll
          for (int i = 0; i < 16; ++i) { s1[i] = ex2(s1[i]); l1 += s1[i]; }
          p1[0] = pack8(s1, 0); p1[1] = pack8(s1, 1); }
#pragma unroll
        for (int kk = 0; kk < 2; ++kk) {
#pragma unroll
          for (int eb = 0; eb < 2; ++eb) { const bf16_t* vb = Vs + (32 * eb + r32) * 72 + 32 * kh + 16 * kk + 8 * hi; const bf16x8 vf = *(const bf16x8*)vb;
            O0[eb] = MFMA32(vf, p0[kk], O0[eb]); O1[eb] = MFMA32(vf, p1[kk], O1[eb]); } }
      }
    } else if (MODE == 0) {
      const int dch = cw - j; const float binit = ap.negM + ((dch >= 3) ? ap.biasL[256] : 0.f);
#pragma unroll
      for (int kh = 0; kh < 2; ++kh) {
        const bf16_t* kb = Ks + (32 * kh + r32) * 72 + 8 * hi;
        f32x16 s0 = splat16(binit);
#pragma unroll
        for (int ks = 0; ks < 4; ++ks) s0 = MFMA32(*(const bf16x8*)(kb + 16 * ks), qf[ks], s0);
        if (dch < 3) {
#pragma unroll
          for (int i = 0; i < 16; ++i) { int rel = qpos - (64 * j + 32 * kh + crow(i, hi)); rel = rel > 128 ? 128 : (rel < -128 ? -128 : rel); s0[i] += ap.biasL[rel + 128]; } }
#pragma unroll
        for (int i = 0; i < 16; ++i) { s0[i] = ex2(s0[i]); l0 += s0[i]; }
#pragma unroll
        for (int kk = 0; kk < 2; ++kk) { const bf16x8 p0 = pack8(s0, kk);
#pragma unroll
          for (int eb = 0; eb < 2; ++eb) { const bf16_t* vb = Vs + (32 * eb + r32) * 72 + 32 * kh + 16 * kk + 8 * hi; const bf16x8 vf = *(const bf16x8*)vb;
            O0[eb] = MFMA32(vf, p0, O0[eb]); } }
      }
    } else {
      f32x16 z[2];
#pragma unroll
      for (int kh = 0; kh < 2; ++kh) { const bf16_t* kb = Ks + (32 * kh + r32) * 72 + 8 * hi; z[kh] = splat16(0.f);
#pragma unroll
        for (int ks = 0; ks < 4; ++ks) z[kh] = MFMA32(*(const bf16x8*)(kb + 16 * ks), qf[ks], z[kh]); }
      if (j == cw) d_weights<true>(z, cum, j, qpos, hi); else d_weights<false>(z, cum, j, qpos, hi);
#pragma unroll
      for (int kh = 0; kh < 2; ++kh)
#pragma unroll
        for (int kk = 0; kk < 2; ++kk) { const bf16x8 p0 = pack8(z[kh], kk);
#pragma unroll
          for (int eb = 0; eb < 2; ++eb) { const bf16_t* vb = Vs + (32 * eb + r32) * 72 + 32 * kh + 16 * kk + 8 * hi; const bf16x8 vf = *(const bf16x8*)vb;
            O0[eb] = MFMA32(vf, p0, O0[eb]); } }
      if (D_EARLY) { const int done = __all(cum <= -151.0f); if (lane == 0) flags[wave] = done; wdone = (done != 0); }
    }
    }
  }
  bf16_t* yo = ap.Y + (tokb + qpos) * DM + ycol0 + h * 64;
  if (MODE == 0) { l0 += __shfl_xor(l0, 32); const float inv = 1.0f / l0;
#pragma unroll
    for (int eb = 0; eb < 2; ++eb)
#pragma unroll
      for (int i = 0; i < 16; ++i) O0[eb][i] *= inv;
  } else if (MODE == 1) { l0 += __shfl_xor(l0, 32); l1 += __shfl_xor(l1, 32); const float i0 = 1.0f / l0, i1 = ap.lam / l1; float ss = 0.f;
#pragma unroll
    for (int eb = 0; eb < 2; ++eb)
#pragma unroll
      for (int i = 0; i < 16; ++i) { const float o = O0[eb][i] * i0 - O1[eb][i] * i1; O0[eb][i] = o; ss += o * o; }
    ss += __shfl_xor(ss, 32); const float rstd = rsqrtf(ss * (1.f / 64.f) + EPS_) * ap.oscale;
#pragma unroll
    for (int eb = 0; eb < 2; ++eb)
#pragma unroll
      for (int i = 0; i < 16; ++i) O0[eb][i] *= rstd * ap.cgain[32 * eb + crow(i, hi)];
  }
#pragma unroll
  for (int eb = 0; eb < 2; ++eb)
#pragma unroll
    for (int g4 = 0; g4 < 4; ++g4) { u32x2 ow; ow.x = pk2(O0[eb][4 * g4], O0[eb][4 * g4 + 1]); ow.y = pk2(O0[eb][4 * g4 + 2], O0[eb][4 * g4 + 3]); *(u32x2*)(yo + 32 * eb + 8 * g4 + 4 * hi) = ow; }
}

struct MixParams { AttnParams ap; float* DC; float* SC; const float* relb; const float *aqg, *akg, *cqg, *ckg, *clam, *cog; float lam_init; unsigned* ctr; };
DI void mix_phase(unsigned char* lds, const MixParams& mp, int tid) {
  LAUNDER(tid);
  volatile int* misc = (volatile int*)(lds + pg8::STAGE_BYTES);
  float* biasT = (float*)(lds + 81920);
  float* red = (float*)(lds + 81920 + 4 * 260 * 4);
  for (int i = tid; i < 4 * 257; i += 512) biasT[(i / 257) * 260 + (i % 257)] = mp.relb[i] * LOG2E;
  if (tid < 64) {
    const int lane = tid;
    const float aq = wave_max(fabsf(mp.aqg[lane])), ak = wave_max(fabsf(mp.akg[lane]));
    const float cq = wave_max(fabsf(mp.cqg[lane & 31])), ck = wave_max(fabsf(mp.ckg[lane & 31]));
    const float d1 = wave_sum(lane < 32 ? mp.clam[lane] * mp.clam[32 + lane] : 0.f), d2 = wave_sum(lane < 32 ? mp.clam[64 + lane] * mp.clam[96 + lane] : 0.f);
    if (lane == 0) { red[0] = 8.0f * aq * ak * LOG2E * 1.02f; red[1] = 5.656854249f * cq * ck * LOG2E * 1.02f; red[2] = fexp(d1) - fexp(d2) + mp.lam_init; }
  }
  __syncthreads();
  if (tid < 256) { const int hh = tid >> 6, ln = tid & 63; float m = -1e30f;
#pragma unroll
    for (int i = 0; i < 5; ++i) { const int e = ln + 64 * i; if (e < 257) m = fmaxf(m, biasT[hh * 260 + e]); }
    m = wave_max(m); if (ln == 0) red[4 + hh] = m; }
  __syncthreads();
  const float MA = red[0], MC = red[1], lam = red[2];
  AttnParams ap = mp.ap;
  for (;;) {
    __syncthreads();
    if (tid == 0) misc[0] = (int)atomicAdd(mp.ctr, 1u);
    __syncthreads();
    const int it = misc[0];
    constexpr int NB2 = 17;
    if (it >= NB2 + 3 * 512) break;
    if (it < NB2) { b2_item(mp.DC, mp.SC, it, lds, tid); continue; }
    const int r = (it - NB2) & 511, kind = (it - NB2) >> 9, qb = 63 - (r >> 3), bh = r & 7, b = bh >> 2, h = bh & 3;
    if (kind == 0) { ap.negM = -MC; ap.lam = lam; ap.oscale = 1.0f - mp.lam_init; ap.cgain = mp.cog; attn_unit<1>(lds, ap, b, h, qb, tid); }
    else if (kind == 1) { attn_unit<2>(lds, ap, b, h, qb, tid); }
    else { ap.negM = -(MA + red[4 + h]); ap.biasL = biasT + h * 260; attn_unit<0>(lds, ap, b, h, qb, tid); }
  }
}

DI const float* ldp(const unsigned char* lds, int i) {
  const volatile __attribute__((address_space(3))) unsigned* t = (const volatile __attribute__((address_space(3))) unsigned*)(lds + pg8::STAGE_BYTES + 64);
  const unsigned lo = __builtin_amdgcn_readfirstlane(t[2 * i]), hi = __builtin_amdgcn_readfirstlane(t[2 * i + 1]);
  return (const float*)(const __attribute__((address_space(1))) float*)(((unsigned long long)hi << 32) | lo); }
DI int fresh_tid(int wave_s) { int lane; asm volatile("v_mbcnt_lo_u32_b32 %0, -1, 0\n\tv_mbcnt_hi_u32_b32 %0, -1, %0" : "=v"(lane)); return wave_s * 64 + lane; }

DI void gbar(unsigned* bw, unsigned& k, int tid) {
  ++k;
  asm volatile("s_waitcnt vmcnt(0)" ::: "memory");
  __syncthreads();
  if (tid == 0) {
    __builtin_amdgcn_fence(__ATOMIC_RELEASE, "agent");
    const unsigned G = gridDim.x, x = blockIdx.x & 7u, nloc = (G - x + 7u) >> 3, ngrp = G < 8u ? G : 8u;
    unsigned* xcnt = bw + 64 * x; unsigned* xgen = bw + 64 * (8 + x); unsigned* top = bw + 64 * 16; unsigned* topgen = bw + 64 * 17;
    const unsigned old = __hip_atomic_fetch_add(xcnt, 1u, __ATOMIC_RELAXED, __HIP_MEMORY_SCOPE_AGENT);
    if (old + 1u == k * nloc) {
      const unsigned o2 = __hip_atomic_fetch_add(top, 1u, __ATOMIC_RELAXED, __HIP_MEMORY_SCOPE_AGENT);
      if (o2 + 1u == k * ngrp) __hip_atomic_store(topgen, k, __ATOMIC_RELAXED, __HIP_MEMORY_SCOPE_AGENT);
      else while (__hip_atomic_load(topgen, __ATOMIC_RELAXED, __HIP_MEMORY_SCOPE_AGENT) < k) __builtin_amdgcn_s_sleep(1);
      __hip_atomic_store(xgen, k, __ATOMIC_RELAXED, __HIP_MEMORY_SCOPE_AGENT);
    } else {
      while (__hip_atomic_load(xgen, __ATOMIC_RELAXED, __HIP_MEMORY_SCOPE_AGENT) < k) __builtin_amdgcn_s_sleep(1);
    }
    __builtin_amdgcn_fence(__ATOMIC_ACQUIRE, "agent");
  }
  __syncthreads();
}
#define WSP(off) ((unsigned char*)ldp(lds, 24) + (off))
__global__ void __launch_bounds__(512) fwd_kernel(Args a) {
  extern __shared__ __attribute__((aligned(16))) unsigned char lds[];
  cg::grid_group grid = cg::this_grid();
  const int wave_s = __builtin_amdgcn_readfirstlane(threadIdx.x >> 6);
  if (threadIdx.x == 0) {
    const float** t = (const float**)(lds + pg8::STAGE_BYTES + 64);
#pragma unroll
    for (int i = 0; i < 23; ++i) t[i] = a.in[i];
    t[23] = a.out; t[24] = (const float*)a.ws;
  }
  if (blockIdx.x == 0) { unsigned* ctl = (unsigned*)(a.ws + WS_CTL); for (int i = threadIdx.x; i < 2048; i += 512) ctl[i] = 0u; }
  __syncthreads();
  unsigned bk = 0u;
  PG8_LAS unsigned char* ldsL = (PG8_LAS unsigned char*)lds;
  typedef pg8::StaticOrder SO;

  { Args a2;
#pragma unroll
    for (int i = 0; i < 23; ++i) a2.in[i] = ldp(lds, i);
    a2.out = nullptr; a2.ws = WSP(0);
    prologue_weights(a2, lds, fresh_tid(wave_s)); }
  cast_phase(ldp(lds, 0), (bf16_t*)WSP(WS_XN), (float*)WSP(WS_SS), fresh_tid(wave_s));
  grid.sync();
  for (int l = 0; l < NLAYER; ++l) {
    const size_t wlo = WS_W + (size_t)l * LW_SIZE;
    { const float* xin = (l == 0) ? ldp(lds, 0) : ldp(lds, 23); (void)xin;
      pg8::Gemm g{(bf16_t*)WSP(WS_XN), (const bf16_t*)WSP(wlo + LW_WGU1), T_, 2 * FF, DM}; SO S; S.init(T_, 2 * FF, gridDim.x, blockIdx.x); pg8::EpiSwiGLU E{(bf16_t*)WSP(WS_HP), FF, (const float*)WSP(WS_SS) + (size_t)(3 * l) * T_};
      pg8::gemm_phase<pg8::EpiSwiGLU, SO, true, true>(ldsL, g, S, E, fresh_tid(wave_s)); }
    gbar((unsigned*)WSP(WS_CTL) + 64, bk, fresh_tid(wave_s));
    { const float* xin = (l == 0) ? ldp(lds, 0) : ldp(lds, 23);
      pg8::Gemm g{(bf16_t*)WSP(WS_HP), (const bf16_t*)WSP(wlo + LW_WD1), T_, DM, FF}; SO S; S.init(T_, DM, gridDim.x, blockIdx.x); pg8::EpiResid E{xin, (float*)ldp(lds, 23), DM, 0.5f, (bf16_t*)WSP(WS_XN), (float*)WSP(WS_SS) + (size_t)(3 * l + 1) * T_};
      pg8::gemm_phase<pg8::EpiResid, SO, true, true>(ldsL, g, S, E, fresh_tid(wave_s)); }
    gbar((unsigned*)WSP(WS_CTL) + 64, bk, fresh_tid(wave_s));
    { pg8::Gemm g{(bf16_t*)WSP(WS_XN), (const bf16_t*)WSP(wlo + LW_WIN), T_, INP, DM}; SO S; S.init(T_, INP, gridDim.x, blockIdx.x); pg8::EpiBf16Lim E{(bf16_t*)WSP(WS_HP), PLD, PLD, (const float*)WSP(WS_SS) + (size_t)(3 * l + 1) * T_};
      pg8::gemm_phase<pg8::EpiBf16Lim, SO, true, true>(ldsL, g, S, E, fresh_tid(wave_s)); }
    gbar((unsigned*)WSP(WS_CTL) + 64, bk, fresh_tid(wave_s));
    { PrepParams pp{ldp(lds, 7) + l * 64, ldp(lds, 8) + l * 64, ldp(lds, 14) + l * 32, ldp(lds, 15) + l * 32, ldp(lds, 10) + l * 2048, ldp(lds, 11) + l * 512};
      prep_phase((bf16_t*)WSP(WS_HP), (bf16_t*)WSP(WS_BQ), (bf16_t*)WSP(WS_BK), (bf16_t*)WSP(WS_BKT), (bf16_t*)WSP(WS_VT), pp, lds, fresh_tid(wave_s)); }
    gbar((unsigned*)WSP(WS_CTL) + 64, bk, fresh_tid(wave_s));
    b1_phase((bf16_t*)WSP(WS_HP), (bf16_t*)WSP(WS_BKT), (bf16_t*)WSP(WS_VT) + (size_t)T_ * 256, (float*)WSP(WS_DC), (float*)WSP(WS_SC), ldp(lds, 12) + l * 8, lds, fresh_tid(wave_s));
    gbar((unsigned*)WSP(WS_CTL) + 64, bk, fresh_tid(wave_s));
    { const float lam_init = (l == 0) ? 0.2f : (0.8f - 0.6f * 0.7408182206817179f);
      MixParams mp; mp.ap.P = (bf16_t*)WSP(WS_HP); mp.ap.Vt = (bf16_t*)WSP(WS_VT); mp.ap.Y = (bf16_t*)WSP(WS_XN); mp.ap.biasL = nullptr; mp.ap.negM = 0.f; mp.ap.lam = 0.f; mp.ap.oscale = 1.f; mp.ap.cgain = nullptr;
      mp.DC = (float*)WSP(WS_DC); mp.SC = (float*)WSP(WS_SC); mp.relb = ldp(lds, 9) + l * 4 * 257; mp.aqg = ldp(lds, 7) + l * 64; mp.akg = ldp(lds, 8) + l * 64; mp.cqg = ldp(lds, 14) + l * 32; mp.ckg = ldp(lds, 15) + l * 32;
      mp.clam = ldp(lds, 16) + l * 128; mp.cog = ldp(lds, 17) + l * 64; mp.lam_init = lam_init; mp.ctr = (unsigned*)WSP(WS_CTL) + l;
      mix_phase(lds, mp, fresh_tid(wave_s)); }
    gbar((unsigned*)WSP(WS_CTL) + 64, bk, fresh_tid(wave_s));
    b3_phase((bf16_t*)WSP(WS_HP), (bf16_t*)WSP(WS_BQ), (bf16_t*)WSP(WS_BK), (bf16_t*)WSP(WS_VT) + (size_t)T_ * 256, (float*)WSP(WS_DC), (float*)WSP(WS_SC), ldp(lds, 12) + l * 8, ldp(lds, 13) + l * 256, (bf16_t*)WSP(WS_XN), lds, fresh_tid(wave_s));
    gbar((unsigned*)WSP(WS_CTL) + 64, bk, fresh_tid(wave_s));
    { float* xo = (float*)ldp(lds, 23);
      pg8::Gemm g{(bf16_t*)WSP(WS_XN), (const bf16_t*)WSP(wlo + LW_WOUT), T_, DM, DM}; SO S; S.init(T_, DM, gridDim.x, blockIdx.x); pg8::EpiResid E{xo, xo, DM, 1.0f, (bf16_t*)WSP(WS_BQ), (float*)WSP(WS_SS) + (size_t)(3 * l + 2) * T_};
      pg8::gemm_phase<pg8::EpiResid, SO, true, true>(ldsL, g, S, E, fresh_tid(wave_s)); }
    gbar((unsigned*)WSP(WS_CTL) + 64, bk, fresh_tid(wave_s));
    { pg8::Gemm g{(bf16_t*)WSP(WS_BQ), (const bf16_t*)WSP(wlo + LW_WGU2), T_, 2 * FF, DM}; SO S; S.init(T_, 2 * FF, gridDim.x, blockIdx.x); pg8::EpiSwiGLU E{(bf16_t*)WSP(WS_HP), FF, (const float*)WSP(WS_SS) + (size_t)(3 * l + 2) * T_};
      pg8::gemm_phase<pg8::EpiSwiGLU, SO, true, true>(ldsL, g, S, E, fresh_tid(wave_s)); }
    gbar((unsigned*)WSP(WS_CTL) + 64, bk, fresh_tid(wave_s));
    { float* xo = (float*)ldp(lds, 23);
      pg8::Gemm g{(bf16_t*)WSP(WS_HP), (const bf16_t*)WSP(wlo + LW_WD2), T_, DM, FF}; SO S; S.init(T_, DM, gridDim.x, blockIdx.x); pg8::EpiResid E{xo, xo, DM, 0.5f, (l + 1 < NLAYER) ? (bf16_t*)WSP(WS_XN) : nullptr, (float*)WSP(WS_SS) + (size_t)(3 * l + 3) * T_};
      pg8::gemm_phase<pg8::EpiResid, SO, true, true>(ldsL, g, S, E, fresh_tid(wave_s)); }
    if (l + 1 < NLAYER) gbar((unsigned*)WSP(WS_CTL) + 64, bk, fresh_tid(wave_s));
  }
}

extern "C" void kernel_launch(void* const* d_in, const int* in_sizes, int n_in, void* d_out, int out_size, void* d_ws, size_t ws_size, hipStream_t stream) {
  static int grid = 0;
  if (grid == 0) {
    if (n_in != 23 || out_size != T_ * DM || ws_size < WS_END) { fprintf(stderr, "kernel_launch: unexpected problem (n_in %d out %d ws %zu need %zu)\n", n_in, out_size, ws_size, (size_t)WS_END); grid = -1; return; }
    int dev = 0, cus = 0, per_cu = 0;
    hipGetDevice(&dev); hipDeviceGetAttribute(&cus, hipDeviceAttributeMultiprocessorCount, dev);
    if (hipFuncSetAttribute((const void*)fwd_kernel, hipFuncAttributeMaxDynamicSharedMemorySize, LDS_BYTES) != hipSuccess) fprintf(stderr, "kernel_launch: hipFuncSetAttribute failed\n");
    if (hipOccupancyMaxActiveBlocksPerMultiprocessor(&per_cu, (const void*)fwd_kernel, 512, LDS_BYTES) != hipSuccess || per_cu < 1) { fprintf(stderr, "kernel_launch: occupancy query gave %d\n", per_cu); per_cu = 1; }
    (void)hipGetLastError();
    grid = cus * per_cu;
  }
  if (grid < 0) return;
  Args a{};
  for (int i = 0; i < 23; ++i) a.in[i] = (const float*)d_in[i];
  a.out = (float*)d_out; a.ws = (unsigned char*)d_ws;
  void* args[] = {&a};
  hipError_t e = hipLaunchCooperativeKernel((const void*)fwd_kernel, dim3(grid), dim3(512), args, LDS_BYTES, stream);
  if (e != hipSuccess) fprintf(stderr, "cooperative launch failed: %s (grid %d)\n", hipGetErrorString(e), grid);
}
```
